# Optimizing an MI355X kernel written in HIP

```python
import jax, jax.numpy as jnp
from jax import lax
import numpy as np

D_MODEL = 1024
BATCH = 4
SEQ = 8192
DEPTH = 2

CHUNK = 64
EPS = 1e-6
ROPE_THETA = 10000.0
A_HEADS = 4
A_DK = 128
A_DV = 128
A_WIDTH = A_HEADS * A_DV
B_HEADS = 4
B_DH = 128
B_WIDTH = B_HEADS * B_DH
Q_LORA = 256
IDX_HEADS = 16
IDX_DIM = 64
TOPK_MAX = 256
Q_BLOCK = 128
D_MIX = A_WIDTH + B_WIDTH
IN_SIZES = (A_WIDTH, A_WIDTH, A_WIDTH, A_WIDTH, Q_LORA, B_WIDTH, B_WIDTH, IDX_DIM, IDX_HEADS)
D_IN = 4 * A_WIDTH + Q_LORA + 2 * B_WIDTH + IDX_DIM + IDX_HEADS
N_MEM = 256
X_HEADS = 4
X_DH = 128
X_WIDTH = X_HEADS * X_DH
N_GROUPS = 4
EXP_PER_GROUP = 4
TOP_K_IN_GROUP = 2
D_EXPERT = 256

kernel_name = "hybrid_hgrn2_dsa_hmoe_block"


def rms_norm(x, gain):
    xf = x.astype(jnp.float32)
    y = xf * lax.rsqrt(jnp.mean(xf * xf, axis=-1, keepdims=True) + EPS)
    return (y * gain.astype(jnp.float32)).astype(x.dtype)


def rope_tables(positions, dim):
    inv = ROPE_THETA ** (-jnp.arange(0, dim, 2, dtype=jnp.float32) / dim)
    ang = positions.astype(jnp.float32)[..., None] * inv
    return jnp.cos(ang), jnp.sin(ang)


def apply_rope(x, cos, sin):
    d2 = x.shape[-1] // 2
    xf = x.astype(jnp.float32)
    x1, x2 = xf[..., :d2], xf[..., d2:]
    c, s = cos[:, :, None, :], sin[:, :, None, :]
    return jnp.concatenate([x1 * c - x2 * s, x2 * c + x1 * s], axis=-1).astype(x.dtype)


def hgrn2_mixer(q_raw, f_raw, i_raw, g_raw, lb, gnorm_gain):
    f32 = jnp.float32
    bsz, seq = q_raw.shape[:2]
    n_chunks = seq // CHUNK
    q = jax.nn.silu(q_raw.astype(f32))
    z = f_raw.astype(f32)
    log_f = jnp.logaddexp(jnp.log(lb), jnp.log1p(-lb) + jax.nn.log_sigmoid(z))
    k = (1.0 - lb) * jax.nn.sigmoid(-z)
    v = i_raw.astype(f32)

    def to_chunks(t):
        return t.reshape(bsz, n_chunks, CHUNK, A_HEADS, t.shape[-1]).transpose(1, 0, 3, 2, 4)

    causal = jnp.tril(jnp.ones((CHUNK, CHUNK), dtype=bool))[:, :, None]

    def step(state, inp):
        qb, kb, vb, lfb = inp
        b = jnp.cumsum(lfb, axis=2)
        o_inter = jnp.einsum('bhtk,bhkv->bhtv', qb * jnp.exp(b), state)
        diff = b[:, :, :, None, :] - b[:, :, None, :, :]
        decay = jnp.exp(jnp.where(causal, diff, -jnp.inf))
        scores = jnp.einsum('bhtk,bhsk,bhtsk->bhts', qb, kb, decay)
        o_intra = jnp.einsum('bhts,bhsv->bhtv', scores, vb)
        b_last = b[:, :, -1:, :]
        new_state = (jnp.exp(b_last[:, :, 0, :])[..., None] * state
                     + jnp.einsum('bhsk,bhsv->bhkv', kb * jnp.exp(b_last - b), vb))
        return new_state, o_inter + o_intra

    s0 = jnp.zeros((bsz, A_HEADS, A_DK, A_DV), f32)
    _, o = lax.scan(step, s0, tuple(map(to_chunks, (q, k, v, log_f))))
    o = o.transpose(1, 0, 3, 2, 4).reshape(bsz, seq, A_HEADS, A_DV)
    g = g_raw.reshape(bsz, seq, A_HEADS, A_DV).astype(f32)
    o = rms_norm(o, gnorm_gain) * jax.nn.silu(g)
    return o.reshape(bsz, seq, A_WIDTH).astype(q_raw.dtype)


def dsa_mixer(q_lat, k_raw, v_raw, kidx_raw, widx, cos_m, sin_m, cos_i, sin_i,
              q_lat_gain, w_qb, w_qidx, qn_gain, kn_gain, kidx_gain):
    f32 = jnp.float32
    bsz, seq = q_lat.shape[:2]
    c = rms_norm(q_lat, q_lat_gain)
    q = rms_norm((c @ w_qb).reshape(bsz, seq, B_HEADS, B_DH), qn_gain)
    q = apply_rope(q, cos_m, sin_m)
    k = apply_rope(rms_norm(k_raw.reshape(bsz, seq, B_HEADS, B_DH), kn_gain), cos_m, sin_m)
    v = v_raw.reshape(bsz, seq, B_HEADS, B_DH)
    q_idx = apply_rope((c @ w_qidx).reshape(bsz, seq, IDX_HEADS, IDX_DIM), cos_i, sin_i)
    k_idx = apply_rope(rms_norm(kidx_raw, kidx_gain)[:, :, None, :], cos_i, sin_i)[:, :, 0, :]
    w_h = widx.astype(f32) * (IDX_HEADS ** -0.5 * IDX_DIM ** -0.5)
    top_k = min(TOPK_MAX, seq // 4)
    n_blocks = seq // Q_BLOCK
    key_pos = jnp.arange(seq, dtype=jnp.int32)
    scale = B_DH ** -0.5
    gather = jax.vmap(lambda kb, ib: kb[ib])

    def block(i):
        start = i * Q_BLOCK
        qi = lax.dynamic_slice_in_dim(q_idx, start, Q_BLOCK, axis=1)
        wi = lax.dynamic_slice_in_dim(w_h, start, Q_BLOCK, axis=1)
        qb = lax.dynamic_slice_in_dim(q, start, Q_BLOCK, axis=1)
        qpos = start + jnp.arange(Q_BLOCK, dtype=jnp.int32)
        limit = (qpos // CHUNK + 1) * CHUNK
        admissible = key_pos[None, :] < limit[:, None]
        idx_logits = jnp.einsum('bqhd,bsd->bqhs', qi, k_idx).astype(f32)
        score = jnp.einsum('bqhs,bqh->bqs', jax.nn.relu(idx_logits), wi)
        score = jnp.where(admissible[None], score, -jnp.inf)
        _, sel = lax.top_k(score, top_k)
        sel_ok = sel < limit[None, :, None]
        k_sel = gather(k, sel)
        v_sel = gather(v, sel)
        logits = jnp.einsum('bqhd,bqkhd->bhqk', qb, k_sel).astype(f32) * scale
        logits = jnp.where(sel_ok[:, None], logits, -jnp.inf)
        p = jax.nn.softmax(logits, axis=-1)
        out = jnp.einsum('bhqk,bqkhd->bqhd', p.astype(v.dtype), v_sel)
        return out.reshape(bsz, Q_BLOCK, B_WIDTH)

    out = lax.map(block, jnp.arange(n_blocks, dtype=jnp.int32))
    return out.transpose(1, 0, 2, 3).reshape(bsz, seq, B_WIDTH)


def memory_cross_attention(h, m, w_q, w_k, w_v, w_o, qn_gain, kn_gain):
    bsz, seq = h.shape[:2]
    n_mem = m.shape[1]
    q = rms_norm((h @ w_q).reshape(bsz, seq, X_HEADS, X_DH), qn_gain)
    k = rms_norm((m @ w_k).reshape(bsz, n_mem, X_HEADS, X_DH), kn_gain)
    v = (m @ w_v).reshape(bsz, n_mem, X_HEADS, X_DH)
    logits = jnp.einsum('bshd,bmhd->bhsm', q, k).astype(jnp.float32) * (X_DH ** -0.5)
    p = jax.nn.softmax(logits, axis=-1)
    o = jnp.einsum('bhsm,bmhd->bshd', p.astype(v.dtype), v).reshape(bsz, seq, X_WIDTH)
    return o @ w_o


def hierarchical_moe(h, w_rg, b_rg, w_re, b_re, w_gu, w_dn):
    f32 = jnp.float32
    bsz, seq, d = h.shape
    t = h.reshape(-1, d)
    g_logits = (t @ w_rg).astype(f32) + b_rg.astype(f32)
    g_prob = jax.nn.softmax(g_logits, axis=-1)
    g_sel = jnp.argmax(g_logits, axis=-1)
    g_w = jnp.take_along_axis(g_prob, g_sel[:, None], axis=-1)
    e_all = jnp.einsum('nd,dge->nge', t, w_re).astype(f32) + b_re.astype(f32)
    e_logits = jnp.take_along_axis(e_all, g_sel[:, None, None], axis=1)[:, 0]
    top_v, top_i = lax.top_k(e_logits, TOP_K_IN_GROUP)
    top_w = jax.nn.softmax(top_v, axis=-1)
    gate_e = jnp.sum(jax.nn.one_hot(top_i, EXP_PER_GROUP, dtype=f32) * top_w[..., None], axis=1)
    gate = (jax.nn.one_hot(g_sel, N_GROUPS, dtype=f32)[:, :, None]
            * gate_e[:, None, :] * g_w[:, :, None])
    out = jnp.zeros_like(t)
    for g in range(N_GROUPS):
        gu = jnp.einsum('nd,edf->nef', t, w_gu[g])
        act = jax.nn.silu(gu[..., :D_EXPERT]) * gu[..., D_EXPERT:]
        act = act * gate[:, g, :, None].astype(act.dtype)
        out = out + jnp.einsum('nef,efd->nd', act, w_dn[g])
    return out.reshape(bsz, seq, d)


def setup_inputs(seed: int = 0) -> dict:
    key = jax.random.key(seed)
    ks = iter(jax.random.split(key, 48))
    f32 = jnp.float32

    def nrm(shape, fan_in):
        return jax.random.normal(next(ks), shape, f32) * (fan_in ** -0.5)

    def gain(shape):
        return 1.0 + 0.02 * jax.random.normal(next(ks), shape, f32)

    L = DEPTH
    x = jax.random.normal(next(ks), (BATCH, SEQ, D_MODEL), f32)
    mem = jax.random.normal(next(ks), (BATCH, N_MEM, D_MODEL), f32)
    offsets = jax.random.randint(next(ks), (BATCH, 1), 0, 16, dtype=jnp.int32) * CHUNK
    positions = (offsets + jnp.arange(SEQ, dtype=jnp.int32)[None, :]).astype(jnp.int32)
    return {
        "x": x,
        "mem": mem,
        "positions": positions,
        "norm_mix": gain((L, D_MODEL)),
        "w_in": nrm((L, D_MODEL, D_IN), D_MODEL),
        "lb_raw": 0.5 * jax.random.normal(next(ks), (L, A_WIDTH), f32),
        "a_gnorm": gain((L, A_DV)),
        "b_qlat_gain": gain((L, Q_LORA)),
        "b_wqb": nrm((L, Q_LORA, B_WIDTH), Q_LORA),
        "b_wqidx": nrm((L, Q_LORA, IDX_HEADS * IDX_DIM), Q_LORA),
        "b_qnorm": gain((L, B_DH)),
        "b_knorm": gain((L, B_DH)),
        "b_kidx_norm": gain((L, IDX_DIM)),
        "w_out": nrm((L, D_MIX, D_MODEL), D_MIX),
        "norm_x": gain((L, D_MODEL)),
        "norm_mem": gain((L, D_MODEL)),
        "x_wq": nrm((L, D_MODEL, X_WIDTH), D_MODEL),
        "x_wk": nrm((L, D_MODEL, X_WIDTH), D_MODEL),
        "x_wv": nrm((L, D_MODEL, X_WIDTH), D_MODEL),
        "x_wo": nrm((L, X_WIDTH, D_MODEL), X_WIDTH),
        "x_qnorm": gain((L, X_DH)),
        "x_knorm": gain((L, X_DH)),
        "norm_ffn": gain((L, D_MODEL)),
        "w_rg": nrm((L, D_MODEL, N_GROUPS), D_MODEL),
        "b_rg": 0.01 * jax.random.normal(next(ks), (L, N_GROUPS), f32),
        "w_re": nrm((L, D_MODEL, N_GROUPS, EXP_PER_GROUP), D_MODEL),
        "b_re": 0.01 * jax.random.normal(next(ks), (L, N_GROUPS, EXP_PER_GROUP), f32),
        "w_gu": nrm((L, N_GROUPS, EXP_PER_GROUP, D_MODEL, 2 * D_EXPERT), D_MODEL),
        "w_dn": nrm((L, N_GROUPS, EXP_PER_GROUP, D_EXPERT, D_MODEL), D_EXPERT),
    }


def reference(x, mem, positions, norm_mix, w_in, lb_raw, a_gnorm, b_qlat_gain, b_wqb,
              b_wqidx, b_qnorm, b_knorm, b_kidx_norm, w_out, norm_x, norm_mem, x_wq, x_wk,
              x_wv, x_wo, x_qnorm, x_knorm, norm_ffn, w_rg, b_rg, w_re, b_re, w_gu, w_dn):
    bsz, seq, _ = x.shape
    cos_m, sin_m = rope_tables(positions, B_DH)
    cos_i, sin_i = rope_tables(positions, IDX_DIM)
    lb_all = jnp.cumsum(jax.nn.softmax(lb_raw.astype(jnp.float32), axis=0), axis=0)
    lb_all = lb_all - lb_all[0:1]
    split_at = np.cumsum(IN_SIZES)[:-1].tolist()
    for l in range(DEPTH):
        h = rms_norm(x, norm_mix[l])
        u = h @ w_in[l]
        a_q, a_f, a_i, a_g, b_ql, b_k, b_v, b_kidx, b_widx = jnp.split(u, split_at, axis=-1)
        heads4 = lambda t: t.reshape(bsz, seq, A_HEADS, A_DK)
        o_a = hgrn2_mixer(heads4(a_q), heads4(a_f), heads4(a_i), a_g,
                          lb_all[l].reshape(A_HEADS, A_DK), a_gnorm[l])
        o_b = dsa_mixer(b_ql, b_k, b_v, b_kidx, b_widx, cos_m, sin_m, cos_i, sin_i,
                        b_qlat_gain[l], b_wqb[l], b_wqidx[l], b_qnorm[l], b_knorm[l],
                        b_kidx_norm[l])
        x = x + jnp.concatenate([o_a, o_b], axis=-1) @ w_out[l]
        h = rms_norm(x, norm_x[l])
        m = rms_norm(mem, norm_mem[l])
        x = x + memory_cross_attention(h, m, x_wq[l], x_wk[l], x_wv[l], x_wo[l],
                                       x_qnorm[l], x_knorm[l])
        h = rms_norm(x, norm_ffn[l])
        x = x + hierarchical_moe(h, w_rg[l], b_rg[l], w_re[l], b_re[l], w_gu[l], w_dn[l])
    return x
```

```cpp
#include <hip/hip_runtime.h>
#include <stdint.h>
#include <stdio.h>
#include <string.h>

#ifndef PROBE_MASK
#define PROBE_MASK 0u
#endif
#ifndef PROBE_DRY6
#define PROBE_DRY6 1
#endif
#ifndef PROBE_X
#define PROBE_X 0
#endif
#ifndef MK_LAUNCHES
#define MK_LAUNCHES 1
#endif

typedef unsigned short bf16_t;
typedef unsigned short tile_t_fwd;
#define DEVI __device__ __forceinline__
#define LAS __attribute__((address_space(3)))

constexpr int NB = 4, SEQ = 8192, NTOK = NB * SEQ, DM = 1024, DIN = 3408;
constexpr int NT = 512;
constexpr int LDS_BYTES = 153600;
constexpr float EPS = 1e-6f;
constexpr float QSCALE = 0.08838834764831845f * 1.4426950408889634f;
constexpr int TLD = 264;

struct P {
    const float *x, *mem; const int* pos;
    const float *norm_mix, *w_in, *lb_raw, *a_gnorm, *b_qlat_gain, *b_wqb, *b_wqidx, *b_qnorm, *b_knorm, *b_kidx_norm,
                *w_out, *norm_x, *norm_mem, *x_wq, *x_wk, *x_wv, *x_wo, *x_qnorm, *x_knorm, *norm_ffn, *w_rg, *b_rg, *w_re, *b_re, *w_gu, *w_dn;
    float* out;
    bf16_t *H, *QA, *VAT, *GA, *UT, *QL, *KB, *VT, *KIDX, *QB, *QIDX, *QX, *OX, *ACT, *XK, *XVT, *MEMN;
    bf16_t* ZF; float *WIDX, *DEC, *COS128, *SIN128, *COS64, *SIN64, *LB, *LGATE;
    unsigned* MASK; int *LTOK, *CNT; unsigned* bar;
    bf16_t *WIN, *WQ, *WOUT, *XWQ, *XWO, *WGU, *WDN, *XWK, *XWV;
    bf16_t* Y; int* LSLOT;
    float* out_dry; int dry;
};


constexpr size_t MiB = 1u << 20;
constexpr size_t WS_BAR = 0, WS_CNT = 16 * 1024, WS_LB = 20 * 1024, WS_DEC = 1 * MiB, WS_COS128 = 2 * MiB, WS_SIN128 = 10 * MiB, WS_COS64 = 18 * MiB, WS_SIN64 = 22 * MiB,
                 WS_XK = 26 * MiB, WS_XVT = 28 * MiB, WS_H = 30 * MiB, WS_QL = 94 * MiB, WS_KB = 110 * MiB, WS_VT = 142 * MiB, WS_KIDX = 174 * MiB, WS_WIDX = 178 * MiB,
                 WS_R1 = 180 * MiB, WS_WIN = 436 * MiB, WS_WQ = WS_WIN + 14 * MiB, WS_WOUT = WS_WQ + 1 * MiB + 512 * 1024, WS_XWQ = WS_WOUT + 4 * MiB,
                 WS_XWO = WS_XWQ + 2 * MiB, WS_WGU = WS_XWO + 2 * MiB, WS_WDN = WS_WGU + 32 * MiB, WS_END = WS_WDN + 16 * MiB;
static_assert(WS_END <= 512 * MiB, "workspace map exceeds the guaranteed 512 MiB");
struct KArgs { const void* in[29]; float* out; char* ws; };
typedef const __attribute__((address_space(4))) KArgs* KArgsPtr;
DEVI KArgsPtr kargs() { KArgsPtr k = (KArgsPtr)__builtin_amdgcn_kernarg_segment_ptr(); asm volatile("" : "+s"(k)); return k; }
DEVI P make_P(KArgsPtr ap) {
    P p;
    p.x = (const float*)ap->in[0]; p.mem = (const float*)ap->in[1]; p.pos = (const int*)ap->in[2];
    p.norm_mix = (const float*)ap->in[3]; p.w_in = (const float*)ap->in[4]; p.lb_raw = (const float*)ap->in[5]; p.a_gnorm = (const float*)ap->in[6]; p.b_qlat_gain = (const float*)ap->in[7];
    p.b_wqb = (const float*)ap->in[8]; p.b_wqidx = (const float*)ap->in[9]; p.b_qnorm = (const float*)ap->in[10]; p.b_knorm = (const float*)ap->in[11]; p.b_kidx_norm = (const float*)ap->in[12];
    p.w_out = (const float*)ap->in[13]; p.norm_x = (const float*)ap->in[14]; p.norm_mem = (const float*)ap->in[15]; p.x_wq = (const float*)ap->in[16]; p.x_wk = (const float*)ap->in[17];
    p.x_wv = (const float*)ap->in[18]; p.x_wo = (const float*)ap->in[19]; p.x_qnorm = (const float*)ap->in[20]; p.x_knorm = (const float*)ap->in[21]; p.norm_ffn = (const float*)ap->in[22];
    p.w_rg = (const float*)ap->in[23]; p.b_rg = (const float*)ap->in[24]; p.w_re = (const float*)ap->in[25]; p.b_re = (const float*)ap->in[26]; p.w_gu = (const float*)ap->in[27]; p.w_dn = (const float*)ap->in[28];
    p.out = ap->out; char* ws = ap->ws;
    p.bar = (unsigned*)(ws + WS_BAR); p.CNT = (int*)(ws + WS_CNT); p.LB = (float*)(ws + WS_LB); p.DEC = (float*)(ws + WS_DEC);
    p.COS128 = (float*)(ws + WS_COS128); p.SIN128 = (float*)(ws + WS_SIN128); p.COS64 = (float*)(ws + WS_COS64); p.SIN64 = (float*)(ws + WS_SIN64);
    p.XK = (bf16_t*)(ws + WS_XK); p.XVT = (bf16_t*)(ws + WS_XVT); p.H = (bf16_t*)(ws + WS_H);
    p.QL = (bf16_t*)(ws + WS_QL); p.KB = (bf16_t*)(ws + WS_KB); p.VT = (bf16_t*)(ws + WS_VT); p.KIDX = (bf16_t*)(ws + WS_KIDX); p.WIDX = (float*)(ws + WS_WIDX);
    char* r1 = ws + WS_R1;
    p.QA = (bf16_t*)(r1); p.ZF = (bf16_t*)(r1 + 32 * MiB); p.VAT = (bf16_t*)(r1 + 128 * MiB); p.GA = (bf16_t*)(r1 + 160 * MiB); p.UT = (bf16_t*)(r1 + 192 * MiB);
    p.QB = (bf16_t*)(r1); p.QIDX = (bf16_t*)(r1 + 32 * MiB); p.MASK = (unsigned*)(r1 + 96 * MiB);
    p.QX = (bf16_t*)(r1); p.OX = (bf16_t*)(r1 + 32 * MiB); p.ACT = (bf16_t*)(r1 + 64 * MiB); p.LTOK = (int*)(r1 + 100 * MiB); p.LGATE = (float*)(r1 + 104 * MiB);
    p.MEMN = (bf16_t*)(r1 + 128 * MiB); p.XWK = (bf16_t*)(r1 + 132 * MiB); p.XWV = (bf16_t*)(r1 + 134 * MiB);
    p.WIN = (bf16_t*)(ws + WS_WIN); p.WQ = (bf16_t*)(ws + WS_WQ); p.WOUT = (bf16_t*)(ws + WS_WOUT); p.XWQ = (bf16_t*)(ws + WS_XWQ); p.XWO = (bf16_t*)(ws + WS_XWO);
    p.WGU = (bf16_t*)(ws + WS_WGU); p.WDN = (bf16_t*)(ws + WS_WDN);
    p.Y = (bf16_t*)(r1 + 128 * MiB); p.LSLOT = (int*)(r1 + 108 * MiB);
    p.out_dry = (float*)(r1 + 128 * MiB); p.dry = 0;
    return p;
}

DEVI int tidx() { int t = (int)threadIdx.x; asm volatile("" : "+v"(t)); return t; }
DEVI float bf2f(bf16_t v) { return __uint_as_float((uint32_t)v << 16); }
DEVI bf16_t f2bf(float f) { uint32_t u = __float_as_uint(f); u += 0x7FFFu + ((u >> 16) & 1u); return (bf16_t)(u >> 16); }
typedef __bf16 hbf16x2 __attribute__((ext_vector_type(2)));
typedef float hf32x2 __attribute__((ext_vector_type(2)));
DEVI uint32_t pack2(float a, float b) { const hf32x2 f = {a, b}; return __builtin_bit_cast(uint32_t, __builtin_convertvector(f, hbf16x2)); }
DEVI float bflo(uint32_t u) { return __uint_as_float(u << 16); }
DEVI float bfhi(uint32_t u) { return __uint_as_float(u & 0xFFFF0000u); }
#define DPP_F(old_, v_, ctrl, rm) __int_as_float(__builtin_amdgcn_update_dpp(__float_as_int(old_), __float_as_int(v_), ctrl, rm, 0xF, false))
#define DPP_I(old_, v_, ctrl, rm) __builtin_amdgcn_update_dpp(old_, v_, ctrl, rm, 0xF, false)
DEVI float wsum(float v) {
    v += DPP_F(0.f, v, 0xB1, 0xF); v += DPP_F(0.f, v, 0x4E, 0xF); v += DPP_F(0.f, v, 0x141, 0xF); v += DPP_F(0.f, v, 0x140, 0xF);
    v += DPP_F(0.f, v, 0x142, 0xA); v += DPP_F(0.f, v, 0x143, 0xC);
    return __int_as_float(__builtin_amdgcn_readlane(__float_as_int(v), 63));
}
DEVI float wmax(float v) {
    v = fmaxf(v, DPP_F(v, v, 0xB1, 0xF)); v = fmaxf(v, DPP_F(v, v, 0x4E, 0xF)); v = fmaxf(v, DPP_F(v, v, 0x141, 0xF)); v = fmaxf(v, DPP_F(v, v, 0x140, 0xF));
    v = fmaxf(v, DPP_F(v, v, 0x142, 0xA)); v = fmaxf(v, DPP_F(v, v, 0x143, 0xC));
    return __int_as_float(__builtin_amdgcn_readlane(__float_as_int(v), 63));
}
DEVI int wsumi(int v) {
    v += DPP_I(0, v, 0xB1, 0xF); v += DPP_I(0, v, 0x4E, 0xF); v += DPP_I(0, v, 0x141, 0xF); v += DPP_I(0, v, 0x140, 0xF);
    v += DPP_I(0, v, 0x142, 0xA); v += DPP_I(0, v, 0x143, 0xC);
    return __builtin_amdgcn_readlane(v, 63);
}
DEVI int wscan_incl(int v) {
    v += DPP_I(0, v, 0x111, 0xF); v += DPP_I(0, v, 0x112, 0xF); v += DPP_I(0, v, 0x114, 0xF); v += DPP_I(0, v, 0x118, 0xF);
    v += DPP_I(0, v, 0x142, 0xA); v += DPP_I(0, v, 0x143, 0xC);
    return v;
}
DEVI float quad_sum(float s) { s += DPP_F(0.f, s, 0xB1, 0xF); s += DPP_F(0.f, s, 0x4E, 0xF); return s; }
DEVI float oct_sum(float s) { s = quad_sum(s); s += DPP_F(0.f, s, 0x141, 0xF); return s; }
DEVI float siluf(float v) { return v / (1.0f + __expf(-v)); }
DEVI int kperm(int k) { return (k & ~12) | ((k & 4) << 1) | ((k & 8) >> 1); }
DEVI long vt_index(long r, int col) { return ((r >> 6) * 512 + col) * 64 + kperm((int)(r & 63)); }
DEVI unsigned ordf(float f) { unsigned u = __float_as_uint(f); return (u & 0x80000000u) ? ~u : (u | 0x80000000u); }

#define XB_TMO      128
#define XB_XCNT(j)  (256  + 64 * (j))
#define XB_XSUB(j)  (1280 + 64 * (j))
#define XB_XGEN(j)  (2304 + 64 * (j))
#define XB_TOP      3328
#define XB_TOPGEN   3392
#define XCD_BAR_WORDS 3456
#define XB_SPIN_CAP (1u << 27)
DEVI unsigned xb_ld(unsigned* p)              { return __hip_atomic_load(p, __ATOMIC_RELAXED, __HIP_MEMORY_SCOPE_AGENT); }
DEVI unsigned xb_add(unsigned* p, unsigned v) { return __hip_atomic_fetch_add(p, v, __ATOMIC_RELAXED, __HIP_MEMORY_SCOPE_AGENT); }
DEVI unsigned xb_xcc_id() { return (unsigned)__builtin_amdgcn_s_getreg((3 << 11) | 20) & 0xFu; }
#define XB_SPIN(cond, bar) do { unsigned _sp = 0; while (cond) { __builtin_amdgcn_s_sleep(1); \
    if ((++_sp & 255u) == 0u) { if (xb_ld(&(bar)[XB_TMO])) break; if (_sp > XB_SPIN_CAP) { atomicAdd(&(bar)[XB_TMO], 1u); break; } } } } while (0)
struct XcdBarrier { unsigned* bar; unsigned x; volatile LAS unsigned* st; };
DEVI XcdBarrier xcd_barrier_post(unsigned* bar, volatile LAS unsigned* st) {
    XcdBarrier b; b.bar = bar; b.x = xb_xcc_id(); b.st = st;
    if (threadIdx.x == 0) (void)xb_add(&bar[XB_XCNT(b.x)], 1u);
    return b;
}
DEVI void xcd_barrier_complete(unsigned* bar, unsigned x, unsigned& nloc, unsigned& nx) {
    const unsigned G = gridDim.x * gridDim.y * gridDim.z;
    unsigned sum, cnt, mine, sp = 0u;
    for (;;) {
        sum = 0u; cnt = 0u; mine = 0u;
#pragma unroll
        for (unsigned j = 0; j < 16; ++j) { const unsigned c = xb_ld(&bar[XB_XCNT(j)]); sum += c; cnt += (c > 0u) ? 1u : 0u; mine = (j == x) ? c : mine; }
        if (sum == G) break;
        __builtin_amdgcn_s_sleep(1);
        if ((++sp & 255u) == 0u) { if (xb_ld(&bar[XB_TMO])) break; if (sp > XB_SPIN_CAP) { atomicAdd(&bar[XB_TMO], 1u); break; } }
    }
    nloc = mine > 0u ? mine : 1u; nx = cnt > 0u ? cnt : 1u;
}
DEVI void xcd_barrier(const XcdBarrier& b) {
    asm volatile("s_waitcnt vmcnt(0)" ::: "memory");
    __syncthreads();
    if (threadIdx.x == 0) {
        unsigned* bar = b.bar;
        __builtin_amdgcn_s_waitcnt(0);
        unsigned nloc = b.st[0], nx = b.st[1];
        if (nloc == 0u) { xcd_barrier_complete(bar, b.x, nloc, nx); b.st[0] = nloc; b.st[1] = nx; }
        const unsigned old = xb_add(&bar[XB_XSUB(b.x)], 1u);
        const unsigned gen = old / nloc;
        if (old + 1u == (gen + 1u) * nloc) {
            __builtin_amdgcn_fence(__ATOMIC_RELEASE, "agent");
            asm volatile("s_waitcnt vmcnt(0)" ::: "memory");
            const unsigned og = xb_add(&bar[XB_TOP], 1u);
            const unsigned tg = og / nx;
            if (og + 1u == (tg + 1u) * nx) xb_add(&bar[XB_TOPGEN], 1u);
            else XB_SPIN(xb_ld(&bar[XB_TOPGEN]) == tg, bar);
            __builtin_amdgcn_fence(__ATOMIC_ACQUIRE, "agent");
            xb_add(&bar[XB_XGEN(b.x)], 1u);
            asm volatile("s_waitcnt vmcnt(0)" ::: "memory");
        } else {
            XB_SPIN(xb_ld(&bar[XB_XGEN(b.x)]) == gen, bar);
            __builtin_amdgcn_fence(__ATOMIC_ACQUIRE, "agent");
            asm volatile("s_waitcnt vmcnt(0)" ::: "memory");
        }
    }
    __syncthreads();
}

struct ATile { const bf16_t* a; int lda; const int* rowmap; int mvalid; };
typedef short bf16x8 __attribute__((ext_vector_type(8)));
typedef float f32x16 __attribute__((ext_vector_type(16)));
DEVI int swz(int row, int chunk) { return row * 128 + ((chunk ^ ((row >> 1) & 7)) << 4); }

#define GLDS16(gp, lp) __builtin_amdgcn_global_load_lds((const __attribute__((address_space(1))) unsigned*)(gp), (__attribute__((address_space(3))) unsigned*)(lp), 16, 0, 0)
DEVI int swz32(int row, int chunk) { return row * 64 + ((chunk ^ ((row >> 2) & 3)) << 4); }
template <class Epi>
DEVI void gemm_unit256(const ATile& at, int m0, const bf16_t* Bt, int K, float* lds, Epi&& epi, int& tn_ref, int tn_base, int skip_epi = 0, bool whole = false) {
    char* base = (char*)lds;
    const int tid = tidx(), lane = tid & 63, wv = tid >> 6, wm = wv >> 1, wn = wv & 1, l31 = lane & 31, h = lane >> 5;
    const bf16_t* ap[2]; const bf16_t* bp[2];
#pragma unroll
    for (int i = 0; i < 2; ++i) { const int row = 32 * wv + 16 * i + (lane >> 2), ch = (lane & 3) ^ ((row >> 2) & 3), grow = m0 + row;
        long srow = 0; if (grow < at.mvalid) srow = at.rowmap ? (long)at.rowmap[grow] : (long)grow;
        ap[i] = at.a + srow * at.lda + ch * 8; bp[i] = Bt + (long)row * K + ch * 8; }
    const int aoffw = wv * 2048 + lane * 16, boffw = 16384 + wv * 2048 + lane * 16;
    int ra[2], rb[2];
#pragma unroll
    for (int ks = 0; ks < 2; ++ks) { ra[ks] = swz32(wm * 64 + l31, 2 * ks + h); rb[ks] = 16384 + swz32(wn * 128 + l31, 2 * ks + h); }
    f32x16 c00, c01, c02, c03, c10, c11, c12, c13;
#pragma unroll
    for (int r = 0; r < 16; ++r) { c00[r] = 0.f; c01[r] = 0.f; c02[r] = 0.f; c03[r] = 0.f; c10[r] = 0.f; c11[r] = 0.f; c12[r] = 0.f; c13[r] = 0.f; }
    const int nk = K >> 5;
#define D_ISSUE(ST, KO) { GLDS16(ap[0] + (KO), base + (ST) + aoffw); GLDS16(ap[1] + (KO), base + (ST) + aoffw + 1024); \
                          GLDS16(bp[0] + (KO), base + (ST) + boffw); GLDS16(bp[1] + (KO), base + (ST) + boffw + 1024); }
    __syncthreads();
    D_ISSUE(0, 0) D_ISSUE(32768, 32) D_ISSUE(65536, 64)
    asm volatile("s_waitcnt vmcnt(8)\n\ts_barrier" ::: "memory");
#pragma unroll 1
    for (int k = 0; k < nk; ++k) {
        const int kn = (k + 3 < nk) ? (k + 3) * 32 : K - 32;
        const int s0 = (k & 3) * 32768, s3 = ((k + 3) & 3) * 32768;
        if (skip_epi < 3) D_ISSUE(s3, kn)
        const bf16x8 a0 = *(const bf16x8*)(base + s0 + ra[0]), a1 = *(const bf16x8*)(base + s0 + ra[0] + 2048);
        const bf16x8 b0 = *(const bf16x8*)(base + s0 + rb[0]), b1 = *(const bf16x8*)(base + s0 + rb[0] + 2048);
        const bf16x8 b2 = *(const bf16x8*)(base + s0 + rb[0] + 4096), b3 = *(const bf16x8*)(base + s0 + rb[0] + 6144);
        const bf16x8 e0 = *(const bf16x8*)(base + s0 + ra[1]), e1 = *(const bf16x8*)(base + s0 + ra[1] + 2048);
        const bf16x8 f0 = *(const bf16x8*)(base + s0 + rb[1]), f1 = *(const bf16x8*)(base + s0 + rb[1] + 2048);
        const bf16x8 f2 = *(const bf16x8*)(base + s0 + rb[1] + 4096), f3 = *(const bf16x8*)(base + s0 + rb[1] + 6144);
        __builtin_amdgcn_sched_barrier(0);
        __builtin_amdgcn_s_setprio(1);
        c00 = __builtin_amdgcn_mfma_f32_32x32x16_bf16(b0, a0, c00, 0, 0, 0); c01 = __builtin_amdgcn_mfma_f32_32x32x16_bf16(b1, a0, c01, 0, 0, 0);
        c02 = __builtin_amdgcn_mfma_f32_32x32x16_bf16(b2, a0, c02, 0, 0, 0); c03 = __builtin_amdgcn_mfma_f32_32x32x16_bf16(b3, a0, c03, 0, 0, 0);
        c10 = __builtin_amdgcn_mfma_f32_32x32x16_bf16(b0, a1, c10, 0, 0, 0); c11 = __builtin_amdgcn_mfma_f32_32x32x16_bf16(b1, a1, c11, 0, 0, 0);
        c12 = __builtin_amdgcn_mfma_f32_32x32x16_bf16(b2, a1, c12, 0, 0, 0); c13 = __builtin_amdgcn_mfma_f32_32x32x16_bf16(b3, a1, c13, 0, 0, 0);
        c00 = __builtin_amdgcn_mfma_f32_32x32x16_bf16(f0, e0, c00, 0, 0, 0); c01 = __builtin_amdgcn_mfma_f32_32x32x16_bf16(f1, e0, c01, 0, 0, 0);
        c02 = __builtin_amdgcn_mfma_f32_32x32x16_bf16(f2, e0, c02, 0, 0, 0); c03 = __builtin_amdgcn_mfma_f32_32x32x16_bf16(f3, e0, c03, 0, 0, 0);
        c10 = __builtin_amdgcn_mfma_f32_32x32x16_bf16(f0, e1, c10, 0, 0, 0); c11 = __builtin_amdgcn_mfma_f32_32x32x16_bf16(f1, e1, c11, 0, 0, 0);
        c12 = __builtin_amdgcn_mfma_f32_32x32x16_bf16(f2, e1, c12, 0, 0, 0); c13 = __builtin_amdgcn_mfma_f32_32x32x16_bf16(f3, e1, c13, 0, 0, 0);
        __builtin_amdgcn_s_setprio(0);
        if (skip_epi < 4) asm volatile("s_waitcnt vmcnt(8) lgkmcnt(0)\n\ts_barrier" ::: "memory");
    }
#undef D_ISSUE
    asm volatile("s_waitcnt vmcnt(0)\n\ts_barrier" ::: "memory");
    unsigned short* T = (unsigned short*)lds;
    {
        unsigned short* t0 = T + (wm * 64 + l31) * TLD + wn * 128 + 4 * h;
#define T_PUT(C, RO, CO) { _Pragma("unroll") for (int g = 0; g < 4; ++g) *(uint2*)(t0 + (RO) * TLD + (CO) + 8 * g) = make_uint2(pack2(C[4 * g], C[4 * g + 1]), pack2(C[4 * g + 2], C[4 * g + 3])); }
        T_PUT(c00, 0, 0) T_PUT(c01, 0, 32) T_PUT(c02, 0, 64) T_PUT(c03, 0, 96) T_PUT(c10, 32, 0) T_PUT(c11, 32, 32) T_PUT(c12, 32, 64) T_PUT(c13, 32, 96)
#undef T_PUT
    }
    __syncthreads();
    if (whole) { tn_ref = tn_base; if (!skip_epi) epi(T, m0); return; }
#pragma unroll 1
    for (int sub = 0; sub < 4 && !skip_epi; ++sub) { const int rh = sub >> 1, ch = sub & 1; tn_ref = tn_base + ch; epi(T + rh * 128 * TLD + 128 * ch, m0 + 128 * rh); }
}

typedef float f32x4 __attribute__((ext_vector_type(4)));
constexpr int PG_HTB = 128 * 64 * 2;
DEVI int pg_lds_byte(int r, int c) { const int st = (r >> 4) * 2 + (c >> 5), rr = r & 15, cc = c & 31, ob = rr * 64 + cc * 2; return st * 1024 + (ob ^ (((ob >> 9) & 1) << 5)); }
DEVI void pg_stage_rc(int b, int& R, int& C) { const int st = b / 1024, sb = b % 1024, sw = sb ^ (((sb >> 9) & 1) << 5); R = (st >> 1) * 16 + sw / 64; C = (st & 1) * 32 + (sw % 64) / 2; }
template <class Epi>
DEVI void gemm_unit8(const ATile& at, int m0, const bf16_t* Bt, int K, float* ldsf, Epi&& epi, int& tn_ref, int tn_base, int skip_epi = 0, bool whole = false) {
    LAS unsigned char* lds = (LAS unsigned char*)ldsf;
    const int tid = tidx(), wid = __builtin_amdgcn_readfirstlane(tid >> 6), lane = tid & 63, wr = wid >> 2, wc = wid & 3, fr = lane & 15, fq = lane >> 4;
    const int nt = K >> 6;
    const char* ap00; const char* ap01; const char* ap10; const char* ap11;
    unsigned vb0, vb1;
    {   int R, C;
        pg_stage_rc(tid * 16, R, C);
        { const int g0 = m0 + R, g1 = m0 + 128 + R;
          const long s0 = (g0 < at.mvalid) ? (at.rowmap ? (long)at.rowmap[g0] : (long)g0) : 0, s1 = (g1 < at.mvalid) ? (at.rowmap ? (long)at.rowmap[g1] : (long)g1) : 0;
          ap00 = (const char*)(at.a + s0 * at.lda + C); ap10 = (const char*)(at.a + s1 * at.lda + C); vb0 = (unsigned)(R * K + C) * 2u; }
        pg_stage_rc(tid * 16 + 8192, R, C);
        { const int g0 = m0 + R, g1 = m0 + 128 + R;
          const long s0 = (g0 < at.mvalid) ? (at.rowmap ? (long)at.rowmap[g0] : (long)g0) : 0, s1 = (g1 < at.mvalid) ? (at.rowmap ? (long)at.rowmap[g1] : (long)g1) : 0;
          ap01 = (const char*)(at.a + s0 * at.lda + C); ap11 = (const char*)(at.a + s1 * at.lda + C); vb1 = (unsigned)(R * K + C) * 2u; }
    }
    const size_t kstep = 128, hstep = (size_t)128 * K * 2;
    const unsigned ldsw = (unsigned)wid * 1024u;
    const int aoff = pg_lds_byte(wr * 64 + fr, fq * 8), boff = pg_lds_byte(wc * 32 + fr, fq * 8);
#define PG_SA(b, h) (((b) * 2 + (h)) * PG_HTB)
#define PG_SB(b, h) ((4 + (b) * 2 + (h)) * PG_HTB)
#define PG_DMA(gp, lo) __builtin_amdgcn_global_load_lds((const __attribute__((address_space(1))) unsigned*)(gp), (LAS unsigned*)(lds + (lo)), 16, 0, 0)
#define PG_STAGE_A0(bufoff, ko) do { PG_DMA(ap00 + (ko), (bufoff) + ldsw); PG_DMA(ap01 + (ko), (bufoff) + ldsw + 8192); } while (0)
#define PG_STAGE_A1(bufoff, ko) do { PG_DMA(ap10 + (ko), (bufoff) + ldsw); PG_DMA(ap11 + (ko), (bufoff) + ldsw + 8192); } while (0)
#define PG_STAGE_B(bufoff, gbase) do { PG_DMA((const char*)(gbase) + vb0, (bufoff) + ldsw); PG_DMA((const char*)(gbase) + vb1, (bufoff) + ldsw + 8192); } while (0)
#define PG_LDA(dst, b, h) do { _Pragma("unroll") for (int m = 0; m < 4; ++m) _Pragma("unroll") for (int k = 0; k < 2; ++k) dst[m][k] = *(const LAS bf16x8*)(lds + PG_SA(b, h) + aoff + m * 2048 + k * 1024); } while (0)
#define PG_LDB(dst, b, h) do { _Pragma("unroll") for (int n = 0; n < 2; ++n) _Pragma("unroll") for (int k = 0; k < 2; ++k) dst[n][k] = *(const LAS bf16x8*)(lds + PG_SB(b, h) + boff + n * 2048 + k * 1024); } while (0)
#define PG_MMA(ai, bj, At_, Bt_) do { __builtin_amdgcn_s_setprio(1); _Pragma("unroll") for (int m = 0; m < 4; ++m) _Pragma("unroll") for (int n = 0; n < 2; ++n) _Pragma("unroll") for (int k = 0; k < 2; ++k) \
        acc[ai][bj][m][n] = __builtin_amdgcn_mfma_f32_16x16x32_bf16(Bt_[n][k], At_[m][k], acc[ai][bj][m][n], 0, 0, 0); __builtin_amdgcn_s_setprio(0); } while (0)
#define PG_WAIT_V(n) asm volatile("s_waitcnt vmcnt(" #n ")" ::: "memory")
#define PG_WAIT_L(n) asm volatile("s_waitcnt lgkmcnt(" #n ")" ::: "memory")
#define PG_BAR __builtin_amdgcn_s_barrier()
#define PG_SCHED __builtin_amdgcn_sched_barrier(0)
    f32x4 acc[2][2][4][2];
#pragma unroll
    for (int a = 0; a < 2; ++a)
#pragma unroll
        for (int b = 0; b < 2; ++b)
#pragma unroll
            for (int m = 0; m < 4; ++m)
#pragma unroll
                for (int n = 0; n < 2; ++n) acc[a][b][m][n] = (f32x4){0.f, 0.f, 0.f, 0.f};
    bf16x8 At[4][2], B0[2][2], B1[2][2];
    const char* cB = (const char*)Bt;
    __syncthreads();
    PG_STAGE_B(PG_SB(0, 0), cB); PG_STAGE_A0(PG_SA(0, 0), 0); PG_STAGE_B(PG_SB(0, 1), cB + hstep); PG_STAGE_A1(PG_SA(0, 1), 0);
    if (wr == 1) PG_BAR;
    PG_WAIT_V(4); PG_BAR;
    PG_STAGE_B(PG_SB(1, 0), cB + kstep); PG_STAGE_A0(PG_SA(1, 0), kstep); PG_STAGE_B(PG_SB(1, 1), cB + hstep + kstep);
    PG_WAIT_V(6); PG_BAR;
#pragma unroll 1
    for (int t = 0; t < nt; t += 2) {
        const bool last = (t == nt - 2);
        const size_t a1 = (size_t)(t + 1) * kstep, a2 = last ? 0 : (size_t)(t + 2) * kstep, a3 = a2 + kstep;
        const char* b2 = cB + a2; const char* b3 = cB + a3;
        PG_LDB(B0, 0, 0); PG_SCHED; PG_LDA(At, 0, 0); PG_STAGE_A1(PG_SA(1, 1), a1);
        PG_WAIT_L(8); PG_BAR; PG_WAIT_L(0); PG_MMA(0, 0, At, B0); PG_BAR; PG_SCHED;
        PG_LDB(B1, 0, 1); PG_STAGE_B(PG_SB(0, 0), b2);
        PG_BAR; PG_WAIT_L(0); PG_MMA(0, 1, At, B1); PG_BAR;
        PG_LDA(At, 0, 1); PG_STAGE_A0(PG_SA(0, 0), a2);
        PG_BAR; PG_WAIT_L(0); PG_MMA(1, 0, At, B0); PG_BAR; PG_SCHED;
        PG_STAGE_B(PG_SB(0, 1), b2 + hstep);
        PG_WAIT_V(6); PG_BAR; PG_MMA(1, 1, At, B1); PG_BAR;
        PG_LDB(B0, 1, 0); PG_SCHED; PG_LDA(At, 1, 0); PG_STAGE_A1(PG_SA(0, 1), a2);
        PG_WAIT_L(8); PG_BAR; PG_WAIT_L(0); PG_MMA(0, 0, At, B0); PG_BAR; PG_SCHED;
        PG_LDB(B1, 1, 1); PG_STAGE_B(PG_SB(1, 0), b3);
        PG_BAR; PG_WAIT_L(0); PG_MMA(0, 1, At, B1); PG_BAR;
        PG_LDA(At, 1, 1); PG_STAGE_A0(PG_SA(1, 0), a3);
        PG_BAR; PG_WAIT_L(0); PG_MMA(1, 0, At, B0); PG_BAR; PG_SCHED;
        PG_STAGE_B(PG_SB(1, 1), b3 + hstep);
        PG_WAIT_V(6); PG_BAR; PG_MMA(1, 1, At, B1); PG_BAR;
    }
    PG_WAIT_V(0);
    if (wr == 0) PG_BAR;
    PG_BAR;
    unsigned short* T = (unsigned short*)ldsf;
#pragma unroll
    for (int ai = 0; ai < 2; ++ai)
#pragma unroll
        for (int m = 0; m < 4; ++m) { unsigned short* tr = T + (ai * 128 + wr * 64 + m * 16 + fr) * TLD + wc * 32 + 4 * fq;
#pragma unroll
            for (int bj = 0; bj < 2; ++bj)
#pragma unroll
                for (int n = 0; n < 2; ++n) { const f32x4 v = acc[ai][bj][m][n]; *(uint2*)(tr + bj * 128 + n * 16) = make_uint2(pack2(v[0], v[1]), pack2(v[2], v[3])); } }
    __syncthreads();
    if (whole) { tn_ref = tn_base; if (!skip_epi) epi(T, m0); return; }
#pragma unroll 1
    for (int sub = 0; sub < 4 && !skip_epi; ++sub) { const int rh = sub >> 1, ch = sub & 1; tn_ref = tn_base + ch; epi(T + rh * 128 * TLD + 128 * ch, m0 + 128 * rh); }
#undef PG_SA
#undef PG_SB
#undef PG_DMA
#undef PG_STAGE_A0
#undef PG_STAGE_A1
#undef PG_STAGE_B
#undef PG_LDA
#undef PG_LDB
#undef PG_MMA
#undef PG_WAIT_V
#undef PG_WAIT_L
#undef PG_BAR
#undef PG_SCHED
}

DEVI void tr_job(const float* src, long mat_stride, int gpm, int nmat, int ld, int K, int nvalid, int mode, bf16_t* dst, float* lds) {
    const int tid = tidx(), kt = K >> 6, total = nmat * gpm * kt;
    const int i = tid >> 3, j8 = (tid & 7) * 8;
#define TR_LOAD(U, X0, X1) { const int G_ = (U) / kt, k0_ = ((U) % kt) * 64, mat_ = G_ / gpm, g_ = G_ % gpm; \
        const int col0_ = (mode == 0) ? g_ * 64 : ((g_ & 1) ? 256 + (g_ >> 1) * 64 : (g_ >> 1) * 64); \
        const float* rp_ = src + mat_ * mat_stride + (long)(k0_ + i) * ld + col0_ + j8; \
        if (col0_ + j8 + 7 < nvalid) { X0 = *(const float4*)rp_; X1 = *(const float4*)(rp_ + 4); } \
        else { float t_[8]; _Pragma("unroll") for (int e = 0; e < 8; ++e) t_[e] = (col0_ + j8 + e < nvalid) ? rp_[e] : 0.f; \
               X0 = make_float4(t_[0], t_[1], t_[2], t_[3]); X1 = make_float4(t_[4], t_[5], t_[6], t_[7]); } }
    float4 x0 = make_float4(0.f, 0.f, 0.f, 0.f), x1 = x0, y0 = x0, y1 = x0;
    int u = blockIdx.x;
    if (u < total) TR_LOAD(u, x0, x1)
    for (; u < total; u += gridDim.x) {
        const int un = u + gridDim.x;
        if (un < total) TR_LOAD(un, y0, y1)
        const int G = u / kt, k0 = (u % kt) * 64;
        __syncthreads();
        lds[i * 65 + j8] = x0.x; lds[i * 65 + j8 + 1] = x0.y; lds[i * 65 + j8 + 2] = x0.z; lds[i * 65 + j8 + 3] = x0.w;
        lds[i * 65 + j8 + 4] = x1.x; lds[i * 65 + j8 + 5] = x1.y; lds[i * 65 + j8 + 6] = x1.z; lds[i * 65 + j8 + 7] = x1.w;
        __syncthreads();
        { const int n = tid >> 3, kc = (tid & 7) * 8; float f[8];
#pragma unroll
          for (int e = 0; e < 8; ++e) f[e] = lds[(kc + e) * 65 + n];
          uint4 w; w.x = pack2(f[0], f[1]); w.y = pack2(f[2], f[3]); w.z = pack2(f[4], f[5]); w.w = pack2(f[6], f[7]);
          *(uint4*)(dst + ((long)G * 64 + n) * K + k0 + kc) = w; }
        x0 = y0; x1 = y1;
    }
#undef TR_LOAD
}

typedef bf16_t tile_t;
DEVI float4 t_ld4(const tile_t* T, int idx) { const uint2 u = *(const uint2*)(T + idx); return make_float4(bflo(u.x), bfhi(u.x), bflo(u.y), bfhi(u.y)); }
DEVI void epi_load(const tile_t* T, float (&v)[8][4]) {
    const int row = tidx() >> 2, q = tidx() & 3;
#pragma unroll
    for (int j = 0; j < 8; ++j) { const float4 t = t_ld4(T, row * TLD + 16 * j + 4 * q); v[j][0] = t.x; v[j][1] = t.y; v[j][2] = t.z; v[j][3] = t.w; }
}
DEVI void epi_store_bf16(const float (&v)[8][4], bf16_t* rowp  ) {
    const int q = tidx() & 3;
#pragma unroll
    for (int j = 0; j < 8; ++j) *(uint2*)(rowp + 16 * j + 4 * q) = make_uint2(pack2(v[j][0], v[j][1]), pack2(v[j][2], v[j][3]));
}
DEVI void rope_cs(float posf, int c, float fscale, float& cs, float& sn) {
    const float inv = __builtin_amdgcn_exp2f(-(float)c * fscale);
    const float rev = __builtin_amdgcn_fractf((posf * inv) * 0.15915494309189535f);
    sn = __builtin_amdgcn_sinf(rev); cs = __builtin_amdgcn_cosf(rev);
}
constexpr float ROPE_FS128 = 13.287712379549449f * 2.0f / 128.0f, ROPE_FS64 = 13.287712379549449f * 2.0f / 64.0f;
DEVI void norm_rope128(float (&v)[8][4], const float* gain, float posf, float post, bool do_rope) {
    const int q = tidx() & 3;
    float ss = 0.f;
#pragma unroll
    for (int j = 0; j < 8; ++j)
#pragma unroll
        for (int i = 0; i < 4; ++i) ss += v[j][i] * v[j][i];
    ss = quad_sum(ss);
    const float rstd = rsqrtf(ss * (1.0f / 128.0f) + EPS);
#pragma unroll
    for (int j = 0; j < 8; ++j) { const float4 g = *(const float4*)(gain + 16 * j + 4 * q); v[j][0] *= rstd * g.x; v[j][1] *= rstd * g.y; v[j][2] *= rstd * g.z; v[j][3] *= rstd * g.w; }
    if (do_rope) {
#pragma unroll
        for (int j = 0; j < 4; ++j) {
#pragma unroll
            for (int i = 0; i < 4; ++i) { float c_, s_; rope_cs(posf, 16 * j + 4 * q + i, ROPE_FS128, c_, s_);
                const float x1 = v[j][i], x2 = v[j + 4][i]; v[j][i] = x1 * c_ - x2 * s_; v[j + 4][i] = x2 * c_ + x1 * s_; }
        }
    }
#pragma unroll
    for (int j = 0; j < 8; ++j)
#pragma unroll
        for (int i = 0; i < 4; ++i) v[j][i] *= post;
}
DEVI void rope64(float (&v)[8][4], int jb, float posf) {
    const int q = tidx() & 3;
#pragma unroll
    for (int jj = 0; jj < 2; ++jj) {
#pragma unroll
        for (int i = 0; i < 4; ++i) { float c_, s_; rope_cs(posf, 16 * jj + 4 * q + i, ROPE_FS64, c_, s_);
            const float x1 = v[jb + jj][i], x2 = v[jb + jj + 2][i]; v[jb + jj][i] = x1 * c_ - x2 * s_; v[jb + jj + 2][i] = x2 * c_ + x1 * s_; }
    }
}
DEVI void epi_store_vt(const tile_t* T, bf16_t* dst, long r0  , int col0) {
    const int col = tidx() & 127, sg = tidx() >> 7, kt = sg >> 1;
#pragma unroll
    for (int g = 0; g < 2; ++g) {
        const int kb = 32 * (sg & 1) + 16 * g;
#pragma unroll
        for (int half = 0; half < 2; ++half) {
            uint32_t f[8];
#pragma unroll
            for (int e = 0; e < 8; ++e) { const int key = kb + kperm(8 * half + e); f[e] = T[(64 * kt + key) * TLD + col]; }
            uint4 w; w.x = f[0] | (f[1] << 16); w.y = f[2] | (f[3] << 16); w.z = f[4] | (f[5] << 16); w.w = f[6] | (f[7] << 16);
            *(uint4*)(dst + (((r0 >> 6) + kt) * 512 + col0 + col) * 64 + kb + 8 * half) = w;
        }
    }
}

DEVI void sincos_acc(float ang, float& s, float& c) {
    const double a = (double)ang * 0.15915494309189535; const double n = rint(a); const float fr = (float)(a - n);
    s = __builtin_amdgcn_sinf(fr); c = __builtin_amdgcn_cosf(fr);
}
DEVI void ph_pro_w(const P& p, float* lds);
DEVI void ph_pro_a(const P& p, float* lds) {
    const long gt = (long)blockIdx.x * NT + tidx(), gs = (long)gridDim.x * NT;
    for (long i = gt; i < 1024; i += gs) { const int l = (int)(i >> 9), c = (int)(i & 511); p.LB[i] = (l == 0) ? 0.f : 1.0f / (1.0f + expf(p.lb_raw[c] - p.lb_raw[512 + c])); }
    for (long i = gt; i < 64; i += gs) p.CNT[i] = 0;
    ph_pro_w(p, lds);
    const int lane = tidx() & 63, gw = blockIdx.x * 8 + (tidx() >> 6), nw = gridDim.x * 8;
    for (int r = gw; r < 2 * 1024; r += nw) {
        const int l = r >> 10, rr = r & 1023;
        const float4* xr = (const float4*)(p.mem + (long)rr * DM); const float4* gr = (const float4*)(p.norm_mem + l * DM);
        float4 v[4]; float ss = 0.f;
#pragma unroll
        for (int j = 0; j < 4; ++j) { v[j] = xr[lane + 64 * j]; ss += v[j].x * v[j].x + v[j].y * v[j].y + v[j].z * v[j].z + v[j].w * v[j].w; }
        ss = wsum(ss); const float rstd = rsqrtf(ss * (1.0f / 1024.0f) + EPS);
#pragma unroll
        for (int j = 0; j < 4; ++j) { const float4 g = gr[lane + 64 * j];
            *(uint2*)(p.MEMN + (long)r * DM + 4 * (lane + 64 * j)) = make_uint2(pack2(v[j].x * rstd * g.x, v[j].y * rstd * g.y), pack2(v[j].z * rstd * g.z, v[j].w * rstd * g.w)); }
    }
}
DEVI void ph_pro_w(const P& p, float* lds) {
    tr_job(p.w_in, (long)DM * DIN, 56, 2, DIN, DM, DIN, 0, p.WIN, lds);
    tr_job(p.b_wqb, 256L * 512, 8, 1, 512, 256, 512, 0, p.WQ, lds);
    tr_job(p.b_wqb + 256L * 512, 256L * 512, 8, 1, 512, 256, 512, 0, p.WQ + 1536L * 256, lds);
    tr_job(p.b_wqidx, 256L * 1024, 16, 1, 1024, 256, 1024, 0, p.WQ + 512L * 256, lds);
    tr_job(p.b_wqidx + 256L * 1024, 256L * 1024, 16, 1, 1024, 256, 1024, 0, p.WQ + (1536L + 512) * 256, lds);
    tr_job(p.w_out, (long)DM * DM, 16, 2, DM, DM, DM, 0, p.WOUT, lds);
    tr_job(p.x_wq, (long)DM * 512, 8, 2, 512, DM, 512, 0, p.XWQ, lds);
    tr_job(p.x_wk, (long)DM * 512, 8, 2, 512, DM, 512, 0, p.XWK, lds);
    tr_job(p.x_wv, (long)DM * 512, 8, 2, 512, DM, 512, 0, p.XWV, lds);
    tr_job(p.x_wo, 512L * DM, 16, 2, DM, 512, DM, 0, p.XWO, lds);
    tr_job(p.w_gu, (long)DM * 512, 8, 32, 512, DM, 512, 1, p.WGU, lds);
    tr_job(p.w_dn, 256L * DM, 16, 32, DM, 256, DM, 0, p.WDN, lds);
}
DEVI void ph_pro_b(const P& p, float* lds) {
    for (int u = blockIdx.x; u < 2 * 4 * 4; u += gridDim.x) {
        const int l = u >> 4, tm = (u >> 2) & 3, tn2 = u & 3; int tn;
        ATile at{p.MEMN + (long)l * 1024 * DM, DM, nullptr, 1024};
        gemm_unit8(at, tm * 256, ((tn2 >> 1) ? p.XWV : p.XWK) + ((long)l * 512 + (tn2 & 1) * 256) * DM, DM, lds, [&](const tile_t* T, int mr0) __attribute__((always_inline)) {
            const int isv = tn >> 2, hn = tn & 3;
            if (!isv) {
                float v[8][4]; epi_load(T, v);
                norm_rope128(v, p.x_knorm + l * 128, 0.f, 1.0f, false);
                epi_store_bf16(v, p.XK + ((long)l * 1024 + mr0 + (tidx() >> 2)) * 512 + hn * 128);
            } else {
                epi_store_vt(T, p.XVT + (long)l * 1024 * 512, mr0, hn * 128);
            }
        }, tn, 2 * tn2);
    }
}

#define ST_AGENT(ptr, val) __hip_atomic_store((ptr), (val), __ATOMIC_RELAXED, __HIP_MEMORY_SCOPE_AGENT)
template <bool ROUTER, bool ADDY = false, bool XIN = false>
DEVI void ph_norm(const P& p, const float* gain, int l) {
    const int lane = tidx() & 63, gw = blockIdx.x * 8 + (tidx() >> 6), nw = gridDim.x * 8;
    for (int row = gw; row < NTOK; row += nw) {
        const float4* xr = (const float4*)((XIN ? p.x : p.out) + (long)row * DM); const float4* gr = (const float4*)gain;
        float4 v0 = xr[lane], v1 = xr[lane + 64], v2 = xr[lane + 128], v3 = xr[lane + 192];
        if (ADDY) {
            const uint2* y0 = (const uint2*)(p.Y + (long)(2 * row) * DM); const uint2* y1 = (const uint2*)(p.Y + (long)(2 * row + 1) * DM);
#define ADDY_ONE(V, J) { const uint2 a = y0[lane + 64 * J], b = y1[lane + 64 * J]; V.x = (V.x + bflo(a.x)) + bflo(b.x); V.y = (V.y + bfhi(a.x)) + bfhi(b.x); \
                         V.z = (V.z + bflo(a.y)) + bflo(b.y); V.w = (V.w + bfhi(a.y)) + bfhi(b.y); ((float4*)(p.out + (long)row * DM))[lane + 64 * J] = V; }
            ADDY_ONE(v0, 0) ADDY_ONE(v1, 1) ADDY_ONE(v2, 2) ADDY_ONE(v3, 3)
#undef ADDY_ONE
        }
        float ss = v0.x * v0.x + v0.y * v0.y + v0.z * v0.z + v0.w * v0.w + v1.x * v1.x + v1.y * v1.y + v1.z * v1.z + v1.w * v1.w
                 + v2.x * v2.x + v2.y * v2.y + v2.z * v2.z + v2.w * v2.w + v3.x * v3.x + v3.y * v3.y + v3.z * v3.z + v3.w * v3.w;
        ss = wsum(ss); const float rstd = rsqrtf(ss * (1.0f / 1024.0f) + EPS);
#define NORM_ONE(V, J) { const float4 g = gr[lane + 64 * J]; V.x *= rstd * g.x; V.y *= rstd * g.y; V.z *= rstd * g.z; V.w *= rstd * g.w; \
            *(uint2*)(p.H + (long)row * DM + 4 * (lane + 64 * J)) = make_uint2(pack2(V.x, V.y), pack2(V.z, V.w)); }
        NORM_ONE(v0, 0) NORM_ONE(v1, 1) NORM_ONE(v2, 2) NORM_ONE(v3, 3)
#undef NORM_ONE
        if (ROUTER) {
            float4 ag = make_float4(0.f, 0.f, 0.f, 0.f), ae0 = ag, ae1 = ag, ae2 = ag, ae3 = ag;
#define RT_ONE(HH, D) { const float hh = HH; const int d = D; \
                    const float4 wg = *(const float4*)(p.w_rg + ((long)l * DM + d) * 4); \
                    ag.x += hh * wg.x; ag.y += hh * wg.y; ag.z += hh * wg.z; ag.w += hh * wg.w; \
                    const float4* we = (const float4*)(p.w_re + ((long)l * DM + d) * 16); \
                    const float4 w0 = we[0], w1 = we[1], w2 = we[2], w3 = we[3]; \
                    ae0.x += hh * w0.x; ae0.y += hh * w0.y; ae0.z += hh * w0.z; ae0.w += hh * w0.w; \
                    ae1.x += hh * w1.x; ae1.y += hh * w1.y; ae1.z += hh * w1.z; ae1.w += hh * w1.w; \
                    ae2.x += hh * w2.x; ae2.y += hh * w2.y; ae2.z += hh * w2.z; ae2.w += hh * w2.w; \
                    ae3.x += hh * w3.x; ae3.y += hh * w3.y; ae3.z += hh * w3.z; ae3.w += hh * w3.w; }
#define RT_VEC(V, J) RT_ONE(V.x, 4 * (lane + 64 * J)) RT_ONE(V.y, 4 * (lane + 64 * J) + 1) RT_ONE(V.z, 4 * (lane + 64 * J) + 2) RT_ONE(V.w, 4 * (lane + 64 * J) + 3)
            RT_VEC(v0, 0) RT_VEC(v1, 1) RT_VEC(v2, 2) RT_VEC(v3, 3)
#undef RT_VEC
#undef RT_ONE
            ag.x = wsum(ag.x); ag.y = wsum(ag.y); ag.z = wsum(ag.z); ag.w = wsum(ag.w);
            ae0.x = wsum(ae0.x); ae0.y = wsum(ae0.y); ae0.z = wsum(ae0.z); ae0.w = wsum(ae0.w);
            ae1.x = wsum(ae1.x); ae1.y = wsum(ae1.y); ae1.z = wsum(ae1.z); ae1.w = wsum(ae1.w);
            ae2.x = wsum(ae2.x); ae2.y = wsum(ae2.y); ae2.z = wsum(ae2.z); ae2.w = wsum(ae2.w);
            ae3.x = wsum(ae3.x); ae3.y = wsum(ae3.y); ae3.z = wsum(ae3.z); ae3.w = wsum(ae3.w);
            if (lane == 0) {
                const float g0 = ag.x + p.b_rg[l * 4 + 0], g1 = ag.y + p.b_rg[l * 4 + 1], g2 = ag.z + p.b_rg[l * 4 + 2], g3 = ag.w + p.b_rg[l * 4 + 3];
                int gsel = 0; float gm = g0;
                if (g1 > gm) { gm = g1; gsel = 1; }
                if (g2 > gm) { gm = g2; gsel = 2; }
                if (g3 > gm) { gm = g3; gsel = 3; }
                const float gw_ = 1.0f / (expf(g0 - gm) + expf(g1 - gm) + expf(g2 - gm) + expf(g3 - gm));
                const float m0 = (gsel == 0) ? 1.f : 0.f, m1 = (gsel == 1) ? 1.f : 0.f, m2 = (gsel == 2) ? 1.f : 0.f, m3 = (gsel == 3) ? 1.f : 0.f;
                float4 es; es.x = m0 * ae0.x + m1 * ae1.x + m2 * ae2.x + m3 * ae3.x; es.y = m0 * ae0.y + m1 * ae1.y + m2 * ae2.y + m3 * ae3.y;
                es.z = m0 * ae0.z + m1 * ae1.z + m2 * ae2.z + m3 * ae3.z; es.w = m0 * ae0.w + m1 * ae1.w + m2 * ae2.w + m3 * ae3.w;
                const float4 be = *(const float4*)(p.b_re + l * 16 + gsel * 4);
                const float x0 = es.x + be.x, x1 = es.y + be.y, x2 = es.z + be.z, x3 = es.w + be.w;
                int i1 = 0; float e1 = x0;
                if (x1 > e1) { e1 = x1; i1 = 1; }
                if (x2 > e1) { e1 = x2; i1 = 2; }
                if (x3 > e1) { e1 = x3; i1 = 3; }
                int i2 = -1; float e2 = -3.0e38f;
                if (i1 != 0 && x0 > e2) { e2 = x0; i2 = 0; }
                if (i1 != 1 && x1 > e2) { e2 = x1; i2 = 1; }
                if (i1 != 2 && x2 > e2) { e2 = x2; i2 = 2; }
                if (i1 != 3 && x3 > e2) { e2 = x3; i2 = 3; }
                const float z = expf(e2 - e1); const float w1 = 1.0f / (1.0f + z), w2 = z / (1.0f + z);
                const int ex1 = gsel * 4 + i1, ex2 = gsel * 4 + i2;
                if (!p.dry) {
                const int p1 = atomicAdd(&p.CNT[l * 16 + ex1], 1); ST_AGENT(&p.LTOK[(long)ex1 * NTOK + p1], row); ST_AGENT(&p.LSLOT[(long)ex1 * NTOK + p1], 2 * row); ST_AGENT((int*)&p.LGATE[(long)ex1 * NTOK + p1], __float_as_int(w1 * gw_));
                const int p2 = atomicAdd(&p.CNT[l * 16 + ex2], 1); ST_AGENT(&p.LTOK[(long)ex2 * NTOK + p2], row); ST_AGENT(&p.LSLOT[(long)ex2 * NTOK + p2], 2 * row + 1); ST_AGENT((int*)&p.LGATE[(long)ex2 * NTOK + p2], __float_as_int(w2 * gw_)); }
            }
        }
    }
}

DEVI bool xcd_unit(int i, int tilesN, int& tm, int& tn) {
    if ((gridDim.x & 7) != 0) { const int u = blockIdx.x + i * gridDim.x; if (u >= 128 * tilesN) return false; tm = u / tilesN; tn = u % tilesN; return true; }
    const int xcd = blockIdx.x & 7, slot = blockIdx.x >> 3, nslots = gridDim.x >> 3, ul = slot + nslots * i;
    if (ul >= 16 * tilesN) return false;
    tm = xcd + 8 * (ul / tilesN); tn = ul % tilesN; return true;
}
DEVI void epi_inproj(const P& p, int l, const tile_t* T, int m0, int tn) {
    const int row = tidx() >> 2, q = tidx() & 3; const long t = m0 + row;
    if ((tn >= 8 && tn < 12) || (tn >= 22 && tn < 26)) {
        epi_store_vt(T, (tn < 12) ? p.VAT : p.VT, m0, ((tn < 12) ? (tn - 8) : (tn - 22)) * 128);
        return;
    }
    float v[8][4]; epi_load(T, v);
    if (tn < 4 || (tn >= 12 && tn < 16)) {
#pragma unroll
        for (int j = 0; j < 8; ++j)
#pragma unroll
            for (int i = 0; i < 4; ++i) v[j][i] = siluf(v[j][i]);
        epi_store_bf16(v, ((tn < 4) ? p.QA : p.GA) + t * 512 + (tn & 3) * 128);
    } else if (tn < 8) {
        epi_store_bf16(v, p.ZF + t * 512 + (tn - 4) * 128);
    } else if (tn < 18) {
        epi_store_bf16(v, p.QL + t * 256 + (tn - 16) * 128);
    } else if (tn < 22) {
        norm_rope128(v, p.b_knorm + l * 128, (float)p.pos[t], 1.0f, true);
        epi_store_bf16(v, p.KB + t * 512 + (tn - 18) * 128);
    } else {
        float ss = 0.f;
#pragma unroll
        for (int j = 0; j < 4; ++j)
#pragma unroll
            for (int i = 0; i < 4; ++i) ss += v[j][i] * v[j][i];
        ss = quad_sum(ss); const float rstd = rsqrtf(ss * (1.0f / 64.0f) + EPS);
#pragma unroll
        for (int j = 0; j < 4; ++j) { const float4 g = *(const float4*)(p.b_kidx_norm + l * 64 + 16 * j + 4 * q); v[j][0] *= rstd * g.x; v[j][1] *= rstd * g.y; v[j][2] *= rstd * g.z; v[j][3] *= rstd * g.w; }
        rope64(v, 0, (float)p.pos[t]);
#pragma unroll
        for (int j = 0; j < 4; ++j) *(uint2*)(p.KIDX + t * 64 + 16 * j + 4 * q) = make_uint2(pack2(v[j][0], v[j][1]), pack2(v[j][2], v[j][3]));
        *(float4*)(p.WIDX + t * 16 + 4 * q) = make_float4(v[4][0] * 0.03125f, v[4][1] * 0.03125f, v[4][2] * 0.03125f, v[4][3] * 0.03125f);
    }
}
DEVI void ph_inproj(const P& p, int l, float* lds) {
    for (int i = 0;; ++i) {
        int tm, tn2, tn; if (!xcd_unit(i, 14, tm, tn2)) break;
        ATile at{p.H, DM, nullptr, NTOK};
        gemm_unit8(at, tm * 256, p.WIN + ((long)l * 3584 + tn2 * 256) * DM, DM, lds, [&](const tile_t* T, int mr0) __attribute__((always_inline)) { if (tn < 27) epi_inproj(p, l, T, mr0, tn); }, tn, 2 * tn2, p.dry >= 2 ? p.dry : 0);
    }
}

DEVI void hgrn_state_units(const P& p, int l, float* lds);
DEVI void ph_h1(const P& p, int l, float* lds) {
    const int tid = tidx(), lane = tid & 63;
    if (!p.dry) {
        const int gw = blockIdx.x * 8 + (tid >> 6), nw = gridDim.x * 8;
        for (int row = gw; row < NTOK; row += nw) {
            bf16_t* rp = p.QL + (long)row * 256 + 4 * lane; const uint2 u = *(const uint2*)rp;
            float a = bflo(u.x), b = bfhi(u.x), c = bflo(u.y), d = bfhi(u.y);
            float ss = wsum(a * a + b * b + c * c + d * d); const float rstd = rsqrtf(ss * (1.0f / 256.0f) + EPS);
            const float4 g = *(const float4*)(p.b_qlat_gain + l * 256 + 4 * lane);
            *(uint2*)rp = make_uint2(pack2(a * rstd * g.x, b * rstd * g.y), pack2(c * rstd * g.z, d * rstd * g.w));
        }
    }
    hgrn_state_units(p, l, lds);
}
struct HgCol { float b[16]; float kg[16]; float m, bl; };
DEVI void hgrn_cumsum(const P& p, int l, long t0, int h, float* tot  , HgCol& c) {
    const int tid = tidx(), k = tid & 127, sg = tid >> 7;
    const bf16_t* zp = p.ZF + (t0 + 16 * sg) * 512 + h * 128 + k;
    const float lb = p.LB[l * 512 + h * 128 + k];
    bf16_t zr[16];
#pragma unroll
    for (int i = 0; i < 16; ++i) zr[i] = zp[(long)i * 512];
    float run = 0.f;
#pragma unroll
    for (int i = 0; i < 16; ++i) {
        const float z = bf2f(zr[i]);
        const float e = __expf(-fabsf(z)), r1 = __builtin_amdgcn_rcpf(1.0f + e);
        const float sp = (z >= 0.f) ? r1 : e * r1, sn = (z >= 0.f) ? e * r1 : r1;
        const float lf = (lb > 0.f) ? __logf(lb + (1.0f - lb) * sp) : (fminf(z, 0.f) - __logf(1.0f + e));
        c.kg[i] = (1.0f - lb) * sn;
        run += lf; c.b[i] = run;
    }
    __syncthreads();
    tot[sg * 128 + k] = run;
    __syncthreads();
    const float t0_ = tot[k], t1_ = tot[128 + k], t2_ = tot[256 + k], t3_ = tot[384 + k];
    const float off = (sg > 0 ? t0_ : 0.f) + (sg > 1 ? t1_ : 0.f) + (sg > 2 ? t2_ : 0.f);
#pragma unroll
    for (int i = 0; i < 16; ++i) c.b[i] += off;
    c.m = t0_ + t1_; c.bl = (t0_ + t1_) + (t2_ + t3_);
}
DEVI void hgrn_state_units(const P& p, int l, float* lds) {
    char* base = (char*)lds;
    const int tid = tidx(), lane = tid & 63, wv = tid >> 6, l31 = lane & 31, hl = lane >> 5, k = tid & 127, sg = tid >> 7;
    float* tot = (float*)(base + 16384);
    for (int u = blockIdx.x; u < 2048; u += gridDim.x) {
        const int bh = u >> 7, c = u & 127, b = bh >> 2, h = bh & 3; const long t0 = (long)b * SEQ + c * 64;
        const bf16_t* vp = p.VAT + (((long)(b * 128 + c) * 512 + h * 128 + 32 * (wv >> 1) + l31) * 64 + 8 * hl);
        const bf16x8 vf0 = *(const bf16x8*)vp, vf1 = *(const bf16x8*)(vp + 16), vf2 = *(const bf16x8*)(vp + 32), vf3 = *(const bf16x8*)(vp + 48);
        HgCol col; hgrn_cumsum(p, l, t0, h, tot, col);
        {
            float kv[16];
#pragma unroll
            for (int i = 0; i < 16; ++i) kv[i] = col.kg[i] * __expf(col.bl - col.b[i]);
            uint4 w0, w1;
            w0.x = pack2(kv[0], kv[1]); w0.y = pack2(kv[2], kv[3]); w0.z = pack2(kv[8], kv[9]); w0.w = pack2(kv[10], kv[11]);
            w1.x = pack2(kv[4], kv[5]); w1.y = pack2(kv[6], kv[7]); w1.z = pack2(kv[12], kv[13]); w1.w = pack2(kv[14], kv[15]);
            *(uint4*)(base + swz(k, 2 * sg)) = w0; *(uint4*)(base + swz(k, 2 * sg + 1)) = w1;
            if (sg == 0) p.DEC[u * 128 + k] = __expf(col.bl);
        }
        __syncthreads();
        {
            const int vt = wv >> 1, kt0 = 2 * (wv & 1);
            f32x16 a0, a1;
#pragma unroll
            for (int r = 0; r < 16; ++r) { a0[r] = 0.f; a1[r] = 0.f; }
#pragma unroll
            for (int ks = 0; ks < 4; ++ks) {
                const bf16x8 vf = (ks == 0) ? vf0 : (ks == 1) ? vf1 : (ks == 2) ? vf2 : vf3;
                const bf16x8 k0 = *(const bf16x8*)(base + swz(32 * kt0 + l31, 2 * ks + hl)), k1 = *(const bf16x8*)(base + swz(32 * kt0 + 32 + l31, 2 * ks + hl));
                a0 = __builtin_amdgcn_mfma_f32_32x32x16_bf16(k0, vf, a0, 0, 0, 0);
                a1 = __builtin_amdgcn_mfma_f32_32x32x16_bf16(k1, vf, a1, 0, 0, 0);
            }
            bf16_t* up = p.UT + (long)u * 16384 + (32 * vt + l31) * 128 + 32 * kt0 + 4 * hl;
#pragma unroll
            for (int g = 0; g < 4; ++g) {
                *(uint2*)(up + 8 * g)      = make_uint2(pack2(a0[4 * g], a0[4 * g + 1]), pack2(a0[4 * g + 2], a0[4 * g + 3]));
                *(uint2*)(up + 32 + 8 * g) = make_uint2(pack2(a1[4 * g], a1[4 * g + 1]), pack2(a1[4 * g + 2], a1[4 * g + 3]));
            }
        }
    }
}
DEVI void ph_h2(const P& p) {
    const long gt = (long)blockIdx.x * NT + tidx(), gs = (long)gridDim.x * NT;
    for (long e = gt; e < 16 * 8192; e += gs) {
        const int bh = (int)(e >> 13), vk = (int)(e & 8191) * 2, k = vk & 127; float s0 = 0.f, s1 = 0.f;
        uint32_t* up = (uint32_t*)(p.UT + (long)bh * 128 * 16384 + vk); uint32_t* wp_ = p.dry ? (uint32_t*)(p.H + (long)bh * 128 * 16384 + vk) : up; const float* dp = p.DEC + (long)bh * 128 * 128 + k;
#pragma unroll 1
        for (int c0 = 0; c0 < 128; c0 += 16) {
            uint32_t uu[16]; float2 dd[16];
#pragma unroll
            for (int j = 0; j < 16; ++j) { uu[j] = up[(long)(c0 + j) * 8192]; dd[j] = *(const float2*)(dp + (c0 + j) * 128); }
#pragma unroll
            for (int j = 0; j < 16; ++j) { wp_[(long)(c0 + j) * 8192] = pack2(s0, s1); s0 = dd[j].x * s0 + bflo(uu[j]); s1 = dd[j].y * s1 + bfhi(uu[j]); }
        }
    }
}
DEVI void ph_h3(const P& p, int l, float* lds) {
    char* base = (char*)lds;
    const int tid = tidx(), lane = tid & 63, wv = tid >> 6, l31 = lane & 31, hl = lane >> 5, k = tid & 127, sg = tid >> 7;
    float* tot = (float*)(base + 49152); float* part = (float*)(base + 51200);
    for (int u = blockIdx.x; u < 2048; u += gridDim.x) {
        const int bh = u >> 7, c = u & 127, b = bh >> 2, h = bh & 3; const long t0 = (long)b * SEQ + c * 64;
        bf16_t qraw[16];
#pragma unroll
        for (int i = 0; i < 16; ++i) { const long gi = (t0 + 16 * sg + i) * 512 + h * 128 + k; qraw[i] = p.QA[gi]; }
        const int vt = wv >> 1, tt = wv & 1;
        const bf16_t* vp = p.VAT + (((long)(b * 128 + c) * 512 + h * 128 + 32 * vt + l31) * 64 + 8 * hl);
        const bf16_t* sp = p.UT + (long)u * 16384 + (32 * vt + l31) * 128 + 8 * hl;
        bf16x8 vfr[4], sfr[8];
        uint2 ggr[4]; float4 gnr[4];
#pragma unroll
        for (int g = 0; g < 4; ++g) { const int v0 = 32 * vt + 8 * g + 4 * hl; ggr[g] = *(const uint2*)(p.GA + (t0 + 32 * tt + l31) * 512 + h * 128 + v0); gnr[g] = *(const float4*)(p.a_gnorm + l * 128 + v0); }
#pragma unroll
        for (int i = 0; i < 4; ++i) vfr[i] = *(const bf16x8*)(vp + 16 * i);
#pragma unroll
        for (int i = 0; i < 8; ++i) sfr[i] = *(const bf16x8*)(sp + 16 * i);
        HgCol col; hgrn_cumsum(p, l, t0, h, tot, col);
#pragma unroll
        for (int i = 0; i < 16; ++i) {
            const int s = 16 * sg + i;
            const float q = bf2f(qraw[i]), ka = col.kg[i];
            const int o = s * 256 + ((((k >> 3) ^ (s & 15)) << 4) | ((k & 7) << 1));
            *(bf16_t*)(base + o)         = f2bf(q * __expf(col.b[i] - col.m));
            *(bf16_t*)(base + 16384 + o) = f2bf(ka * __expf(col.m - col.b[i]));
            *(bf16_t*)(base + 32768 + o) = f2bf(q * __expf(col.b[i]));
        }
        __syncthreads();
        f32x16 o;
#pragma unroll
        for (int r = 0; r < 16; ++r) o[r] = 0.f;
        const int tro = (32 * tt + l31) * 256, trx = l31 & 15;
#pragma unroll
        for (int st = 0; st < 2; ++st) {
            if (st <= tt) {
                f32x16 sacc;
#pragma unroll
                for (int r = 0; r < 16; ++r) sacc[r] = 0.f;
#pragma unroll
                for (int ks = 0; ks < 8; ++ks) {
                    const bf16x8 kf = *(const bf16x8*)(base + 16384 + (32 * st + l31) * 256 + (((2 * ks + hl) ^ trx) << 4));
                    const bf16x8 qf = *(const bf16x8*)(base + tro + (((2 * ks + hl) ^ trx) << 4));
                    sacc = __builtin_amdgcn_mfma_f32_32x32x16_bf16(kf, qf, sacc, 0, 0, 0);
                }
                float ps[16];
#pragma unroll
                for (int r = 0; r < 16; ++r) { const int sl = (r & 3) + 8 * (r >> 2) + 4 * hl; ps[r] = (st < tt || sl <= l31) ? sacc[r] : 0.f; }
#pragma unroll
                for (int s_ = 0; s_ < 2; ++s_) {
                    union { bf16x8 v; uint32_t w[4]; } pf;
#pragma unroll
                    for (int e = 0; e < 4; ++e) pf.w[e] = pack2(ps[8 * s_ + 2 * e], ps[8 * s_ + 2 * e + 1]);
                    const bf16x8 vf = vfr[2 * st + s_];
                    o = __builtin_amdgcn_mfma_f32_32x32x16_bf16(vf, pf.v, o, 0, 0, 0);
                }
            }
        }
        {
#pragma unroll
            for (int ks = 0; ks < 8; ++ks) {
                const bf16x8 sf = sfr[ks];
                const bf16x8 qf = *(const bf16x8*)(base + 32768 + tro + (((2 * ks + hl) ^ trx) << 4));
                o = __builtin_amdgcn_mfma_f32_32x32x16_bf16(sf, qf, o, 0, 0, 0);
            }
        }
        float ss = 0.f;
#pragma unroll
        for (int r = 0; r < 16; ++r) ss += o[r] * o[r];
        ss += __int_as_float(__builtin_amdgcn_ds_bpermute((lane ^ 32) << 2, __float_as_int(ss)));
        if (hl == 0) part[vt * 64 + 32 * tt + l31] = ss;
        __syncthreads();
        const int t = 32 * tt + l31;
        const float rstd = rsqrtf((part[t] + part[64 + t] + part[128 + t] + part[192 + t]) * (1.0f / 128.0f) + EPS);
#pragma unroll
        for (int g = 0; g < 4; ++g) {
            const int v0 = 32 * vt + 8 * g + 4 * hl;
            const float4 gn = gnr[g]; const uint2 gg = ggr[g];
            *(uint2*)(p.H + (t0 + t) * 1024 + h * 128 + v0) = make_uint2(pack2(o[4 * g] * rstd * gn.x * bflo(gg.x), o[4 * g + 1] * rstd * gn.y * bfhi(gg.x)),
                                                                        pack2(o[4 * g + 2] * rstd * gn.z * bflo(gg.y), o[4 * g + 3] * rstd * gn.w * bfhi(gg.y)));
        }
    }
}

DEVI void ph_qproj(const P& p, int l, float* lds) {
    for (int i = 0;; ++i) {
        int tm, tn2, tn; if (!xcd_unit(i, 6, tm, tn2)) break;
        ATile at{p.QL, 256, nullptr, NTOK};
        gemm_unit8(at, tm * 256, p.WQ + ((long)l * 1536 + tn2 * 256) * 256, 256, lds, [&](const tile_t* T, int mr0) __attribute__((always_inline)) {
            const int row = tidx() >> 2, q = tidx() & 3; const long t = mr0 + row;
            float v[8][4]; epi_load(T, v);
            if (tn < 4) {
                norm_rope128(v, p.b_qnorm + l * 128, (float)p.pos[t], QSCALE, true);
                epi_store_bf16(v, p.QB + t * 512 + tn * 128);
            } else {
                const float posf = (float)p.pos[t]; rope64(v, 0, posf); rope64(v, 4, posf);
                const int h0 = 2 * (tn - 4); const float w0 = p.WIDX[t * 16 + h0], w1 = p.WIDX[t * 16 + h0 + 1];
#pragma unroll
                for (int j = 0; j < 8; ++j)
#pragma unroll
                    for (int i = 0; i < 4; ++i) v[j][i] *= (j < 4) ? w0 : w1;
                epi_store_bf16(v, p.QIDX + t * 1024 + h0 * 64);
            }
        }, tn, 2 * tn2);
    }
}
constexpr int IXCAP = 624;
constexpr int IX_QP = 0, IX_LIST = 69632, IX_CNT = IX_LIST + 32 * IXCAP * 4, IX_CNTN = IX_CNT + 128, IX_THR = IX_CNTN + 128;
typedef LAS unsigned* lds_u32p;
DEVI unsigned lds_add_rtn(unsigned* p, unsigned v) { return __hip_atomic_fetch_add((lds_u32p)p, v, __ATOMIC_RELAXED, __HIP_MEMORY_SCOPE_WORKGROUP); }
DEVI void lds_add(unsigned* p, unsigned v) { (void)__hip_atomic_fetch_add((lds_u32p)p, v, __ATOMIC_RELAXED, __HIP_MEMORY_SCOPE_WORKGROUP); }
DEVI void lds_or(unsigned* p, unsigned v) { (void)__hip_atomic_fetch_or((lds_u32p)p, v, __ATOMIC_RELAXED, __HIP_MEMORY_SCOPE_WORKGROUP); }
DEVI unsigned wmaxu(unsigned v) {
    v = max(v, (unsigned)DPP_I((int)v, (int)v, 0xB1, 0xF)); v = max(v, (unsigned)DPP_I((int)v, (int)v, 0x4E, 0xF)); v = max(v, (unsigned)DPP_I((int)v, (int)v, 0x141, 0xF)); v = max(v, (unsigned)DPP_I((int)v, (int)v, 0x140, 0xF));
    v = max(v, (unsigned)DPP_I((int)v, (int)v, 0x142, 0xA)); v = max(v, (unsigned)DPP_I((int)v, (int)v, 0x143, 0xC));
    return (unsigned)__builtin_amdgcn_readlane((int)v, 63);
}
DEVI unsigned prune256(unsigned* lst_, int n, int lane, bool exact, int& cnt_out) {
    lds_u32p lst = (lds_u32p)lst_;
    unsigned v[10];
#pragma unroll
    for (int j = 0; j < 10; ++j) v[j] = (lane + 64 * j < n) ? lst[lane + 64 * j] : 0u;
    unsigned mx = 0u, mn = 0u;
#pragma unroll
    for (int j = 0; j < 10; ++j) { mx = max(mx, v[j]); mn = max(mn, (lane + 64 * j < n) ? ~v[j] : 0u); }
    mx = wmaxu(mx); mn = ~wmaxu(mn);
    const unsigned diff = mx ^ mn;
    int bit = 31 - __builtin_clz(diff | 1u);
    unsigned thr = (bit >= 31) ? 0u : (mx & ~((2u << bit) - 1u));
    int cnt = n;
    const int hi = exact ? 256 : 320;
#pragma unroll 1
    for (; bit >= 0 && cnt > hi; --bit) {
        const unsigned trial = thr | (1u << bit); int c = 0;
#pragma unroll
        for (int j = 0; j < 10; ++j) c += __builtin_popcountll(__builtin_amdgcn_ballot_w64(v[j] >= trial));
        if (c >= 256) { thr = trial; cnt = c; }
    }
    int basep = 0;
#pragma unroll
    for (int j = 0; j < 10; ++j) {
        const bool keep = v[j] >= thr; const unsigned long long m = __builtin_amdgcn_ballot_w64(keep);
        const int pos = basep + (int)__builtin_amdgcn_mbcnt_hi((unsigned)(m >> 32), __builtin_amdgcn_mbcnt_lo((unsigned)m, 0u));
        if (keep) lst[pos] = v[j];
        basep += __builtin_popcountll(m);
    }
    cnt_out = basep;
    return thr;
}
constexpr int IX_KEEP = IXCAP - 256;
DEVI unsigned prune_bucket(unsigned* lst_, int n, int lane, unsigned* hist  , int& cnt_out) {
    lds_u32p lst = (lds_u32p)lst_; lds_u32p hs = (lds_u32p)hist;
    unsigned v[10];
#pragma unroll
    for (int j = 0; j < 10; ++j) v[j] = (lane + 64 * j < n) ? lst[lane + 64 * j] : 0u;
    unsigned mx = 0u, mn = 0u;
#pragma unroll
    for (int j = 0; j < 10; ++j) { mx = max(mx, v[j]); mn = max(mn, (lane + 64 * j < n) ? ~v[j] : 0u); }
    mx = wmaxu(mx); mn = ~wmaxu(mn);
    const unsigned range = mx - mn;
    const int sh = max(0, 26 - (int)__builtin_clz(range | 1u));
    hs[lane] = 0u;
    __builtin_amdgcn_wave_barrier();
#pragma unroll
    for (int j = 0; j < 10; ++j) if (lane + 64 * j < n) lds_add((unsigned*)(hist + ((v[j] - mn) >> sh)), 1u);
    __builtin_amdgcn_wave_barrier();
    asm volatile("s_waitcnt lgkmcnt(0)" ::: "memory");
    const int suf = wscan_incl((int)hs[63 - lane]);
    const unsigned long long ok = __builtin_amdgcn_ballot_w64(suf >= 256);
    const int i0 = __builtin_ctzll(ok | (1ull << 63));
    const int kept = __builtin_amdgcn_readlane(suf, i0);
    if (kept > IX_KEEP) { return prune256(lst_, n, lane, false, cnt_out); }
    const unsigned thr = mn + ((unsigned)(63 - i0) << sh);
    int basep = 0;
#pragma unroll
    for (int j = 0; j < 10; ++j) {
        const bool keep = v[j] >= thr && (lane + 64 * j < n); const unsigned long long m = __builtin_amdgcn_ballot_w64(keep);
        const int pos = basep + (int)__builtin_amdgcn_mbcnt_hi((unsigned)(m >> 32), __builtin_amdgcn_mbcnt_lo((unsigned)m, 0u));
        if (keep) lst[pos] = v[j];
        basep += __builtin_popcountll(m);
    }
    cnt_out = basep;
    return thr;
}
#define IX_BAR() do { asm volatile("s_waitcnt lgkmcnt(0)\n\ts_barrier" ::: "memory"); if (PROBE_X == 2) asm volatile("s_waitcnt lgkmcnt(0)\n\ts_barrier" ::: "memory"); } while (0)
DEVI void ix_append(const unsigned (&pk)[16], unsigned* CNT, unsigned* LIST, unsigned* THR, int l31, int dry = 0) {
    if (dry >= 4) return;
    const unsigned thrq = THR[l31]; unsigned c2 = 0;
#pragma unroll
    for (int r = 0; r < 16; ++r) c2 += (pk[r] > thrq) ? 1u : 0u;
    if (c2) { unsigned pos = lds_add_rtn(&CNT[l31], c2); lds_u32p lq = (lds_u32p)(LIST + l31 * IXCAP);
#pragma unroll
        for (int r = 0; r < 16; ++r) if (pk[r] > thrq) { lq[dry ? (pos & 511u) : pos] = pk[r]; ++pos; } }
}
DEVI void index_unit(const P& p, int b, int q0, float* lds) {
    char* base = (char*)lds;
    const int tid = tidx(), lane = tid & 63, wv = tid >> 6, l31 = lane & 31, h = lane >> 5;
    const long t0 = (long)b * SEQ + q0; const int L = ((q0 >> 6) + 1) * 64, nw = L >> 5;
    if (L <= 256) { for (int e = tid; e < 32 * nw; e += NT) p.MASK[(t0 + e / nw) * 256 + (e % nw)] = 0xFFFFFFFFu; return; }
    unsigned* LIST = (unsigned*)(base + IX_LIST); unsigned* CNT = (unsigned*)(base + IX_CNT); unsigned* CNTN = (unsigned*)(base + IX_CNTN); unsigned* THR = (unsigned*)(base + IX_THR);
    unsigned* BIG = THR + 32; unsigned* HIST = THR + 64;
    __syncthreads();
#pragma unroll
    for (int i = 0; i < 8; ++i) { const int c = tid + 512 * i, qy = c >> 7, rem = c & 127, hd = rem >> 3, ch = rem & 7;
        *(uint4*)(base + IX_QP + swz(hd * 32 + qy, ch)) = *(const uint4*)(p.QIDX + (t0 + qy) * 1024 + hd * 64 + ch * 8); }
    if (tid < 256) {
        const int qy = tid >> 3, ch = tid & 7; float a[8];
#pragma unroll
        for (int e = 0; e < 8; ++e) a[e] = 0.f;
#pragma unroll 4
        for (int hd = 0; hd < 16; ++hd) { const uint4 w = *(const uint4*)(p.QIDX + (t0 + qy) * 1024 + hd * 64 + ch * 8);
            a[0] += bflo(w.x); a[1] += bfhi(w.x); a[2] += bflo(w.y); a[3] += bfhi(w.y); a[4] += bflo(w.z); a[5] += bfhi(w.z); a[6] += bflo(w.w); a[7] += bfhi(w.w); }
        uint4 o; o.x = pack2(a[0], a[1]); o.y = pack2(a[2], a[3]); o.z = pack2(a[4], a[5]); o.w = pack2(a[6], a[7]);
        *(uint4*)(base + IX_QP + swz(512 + qy, ch)) = o;
    }
    if (tid < 32) { CNT[tid] = 0u; CNTN[tid] = 0u; THR[tid] = 0u; }
    if (tid == 0) *BIG = 0u;
    unsigned sgbits = 0u;
    { const float4* wp = (const float4*)(p.WIDX + (t0 + l31) * 16);
#pragma unroll
      for (int g = 0; g < 4; ++g) { const float4 w = wp[g]; sgbits |= (w.x < 0.f ? 1u : 0u) << (4 * g); sgbits |= (w.y < 0.f ? 2u : 0u) << (4 * g); sgbits |= (w.z < 0.f ? 4u : 0u) << (4 * g); sgbits |= (w.w < 0.f ? 8u : 0u) << (4 * g); } }
    __syncthreads();
    const int ntile = (L + 511) >> 9;
    const bf16_t* kbase = p.KIDX + ((long)b * SEQ + 64 * wv + l31) * 64 + 8 * h;
    const int boff = IX_QP + l31 * 128, bx = (l31 >> 1) & 7;
    bf16x8 a0, a1, a2, a3, e0, e1, e2, e3;
#define IX_LDA(KP) { const bf16_t* kp_ = (KP); a0 = *(const bf16x8*)kp_; a1 = *(const bf16x8*)(kp_ + 16); a2 = *(const bf16x8*)(kp_ + 32); a3 = *(const bf16x8*)(kp_ + 48); \
                     e0 = *(const bf16x8*)(kp_ + 2048); e1 = *(const bf16x8*)(kp_ + 2064); e2 = *(const bf16x8*)(kp_ + 2080); e3 = *(const bf16x8*)(kp_ + 2096); }
    if (64 * wv < L) IX_LDA(kbase)
#pragma unroll 1
    for (int kt = 0; kt < ntile; ++kt) {
        const int key0 = kt * 512 + 64 * wv; const bool active = key0 < L;
        const bf16x8 c0 = a0, c1 = a1, c2 = a2, c3 = a3, d0 = e0, d1 = e1, d2 = e2, d3 = e3;
        if (key0 + 512 < L) IX_LDA(kbase + (long)(kt + 1) * 512 * 64)
        unsigned pk0[16], pk1[16];
        int boffv = boff; asm volatile("" : "+v"(boffv));
        if (active) {
            f32x16 s0, s1;
#pragma unroll
            for (int r = 0; r < 16; ++r) { s0[r] = 0.f; s1[r] = 0.f; }
#define IX_CHAIN(ACC0, ACC1, BP) { const bf16x8 q0_ = *(const bf16x8*)((BP) + (((0 + h) ^ bx) << 4)), q1_ = *(const bf16x8*)((BP) + (((2 + h) ^ bx) << 4)); \
              const bf16x8 q2_ = *(const bf16x8*)((BP) + (((4 + h) ^ bx) << 4)), q3_ = *(const bf16x8*)((BP) + (((6 + h) ^ bx) << 4)); \
              ACC0 = __builtin_amdgcn_mfma_f32_32x32x16_bf16(c0, q0_, ACC0, 0, 0, 0); ACC1 = __builtin_amdgcn_mfma_f32_32x32x16_bf16(d0, q0_, ACC1, 0, 0, 0); \
              ACC0 = __builtin_amdgcn_mfma_f32_32x32x16_bf16(c1, q1_, ACC0, 0, 0, 0); ACC1 = __builtin_amdgcn_mfma_f32_32x32x16_bf16(d1, q1_, ACC1, 0, 0, 0); \
              ACC0 = __builtin_amdgcn_mfma_f32_32x32x16_bf16(c2, q2_, ACC0, 0, 0, 0); ACC1 = __builtin_amdgcn_mfma_f32_32x32x16_bf16(d2, q2_, ACC1, 0, 0, 0); \
              ACC0 = __builtin_amdgcn_mfma_f32_32x32x16_bf16(c3, q3_, ACC0, 0, 0, 0); ACC1 = __builtin_amdgcn_mfma_f32_32x32x16_bf16(d3, q3_, ACC1, 0, 0, 0); }
            IX_CHAIN(s0, s1, base + boffv + 16 * 4096)
#pragma unroll 2
            for (int hd = 0; hd < 16; ++hd) {
                const float sgf = ((sgbits >> hd) & 1u) ? -1.f : 1.f;
                f32x16 u0, u1;
#pragma unroll
                for (int r = 0; r < 16; ++r) { u0[r] = 0.f; u1[r] = 0.f; }
                IX_CHAIN(u0, u1, base + boffv + hd * 4096)
#pragma unroll
                for (int r = 0; r < 16; ++r) { s0[r] = __builtin_fmaf(sgf, __builtin_fabsf(u0[r]), s0[r]); s1[r] = __builtin_fmaf(sgf, __builtin_fabsf(u1[r]), s1[r]); }
            }
#undef IX_CHAIN
            if (p.dry == 2) { float mxs = s0[0];
#pragma unroll
                for (int r = 1; r < 16; ++r) mxs = fmaxf(mxs, fmaxf(s0[r], s1[r]));
                if (mxs == 1.2345e30f) p.MASK[0] = 1u; }
            const unsigned thrq = (p.dry == 2) ? 0xFFFFFFFFu : THR[l31]; int c = 0;
#pragma unroll
            for (int r = 0; r < 16; ++r) { const unsigned ko = (unsigned)(key0 + (r & 3) + 8 * (r >> 2) + 4 * h);
                pk0[r] = (ordf(s0[r]) & 0xFFFFE000u) | ko; pk1[r] = (ordf(s1[r]) & 0xFFFFE000u) | (ko + 32u);
                c += (pk0[r] > thrq) ? 1 : 0; c += (pk1[r] > thrq) ? 1 : 0; }
            if (c) lds_add(&CNTN[l31], (unsigned)c);
        } else {
#pragma unroll
            for (int r = 0; r < 16; ++r) { pk0[r] = 0u; pk1[r] = 0u; }
        }
        if (p.dry == 2) continue;
        IX_BAR();
#pragma unroll 1
        for (int qq = wv; qq < 32; qq += 8) {
            const int n = (int)CNT[qq], nn = (int)CNTN[qq];
            if (n + nn > IXCAP && p.dry < 3) { int kept; unsigned T = prune_bucket(LIST + qq * IXCAP, n, lane, HIST + 64 * wv, kept); if (PROBE_X == 1) T = prune_bucket(LIST + qq * IXCAP, kept, lane, HIST + 64 * wv, kept); if (lane == 0) { CNT[qq] = (unsigned)kept; THR[qq] = T; if (nn > IXCAP - IX_KEEP) *BIG = 1u; } }
            if (lane == 0) CNTN[qq] = 0u;
        }
        IX_BAR();
        const unsigned big = *BIG;
        if (active) ix_append(pk0, CNT, LIST, THR, l31, p.dry >= 3 ? p.dry : 0);
        if (big) {
            if (active) { const unsigned thrq = THR[l31]; unsigned c = 0;
#pragma unroll
                for (int r = 0; r < 16; ++r) c += (pk1[r] > thrq) ? 1u : 0u;
                if (c) lds_add(&CNTN[l31], c); }
            IX_BAR();
#pragma unroll 1
            for (int qq = wv; qq < 32; qq += 8) {
                const int n = (int)CNT[qq], nn = (int)CNTN[qq];
                if (n + nn > IXCAP && p.dry < 3) { int kept; const unsigned T = prune_bucket(LIST + qq * IXCAP, n, lane, HIST + 64 * wv, kept); if (lane == 0) { CNT[qq] = (unsigned)kept; THR[qq] = T; } }
                if (lane == 0) CNTN[qq] = 0u;
            }
            if (tid == 0) *BIG = 0u;
            IX_BAR();
        }
        if (active) ix_append(pk1, CNT, LIST, THR, l31, p.dry >= 3 ? p.dry : 0);
    }
#undef IX_LDA
    __syncthreads();
    if (p.dry >= 2) return;
    if (p.dry == 1 && PROBE_DRY6 == 1 && (PROBE_MASK & 0x100000u)) return;
#pragma unroll 1
    for (int qq = wv; qq < 32; qq += 8) { const int n = (int)CNT[qq]; if (n > 256) { int kept; (void)prune256(LIST + qq * IXCAP, n, lane, true, kept); } }
    unsigned* MR = (unsigned*)(base + IX_QP);
    for (int e = tid; e < 32 * 256; e += NT) MR[e] = 0u;
    __syncthreads();
#pragma unroll 1
    for (int qq = wv; qq < 32; qq += 8) {
#pragma unroll
        for (int j = 0; j < 4; ++j) { const unsigned idx = LIST[qq * IXCAP + lane + 64 * j] & 0x1FFFu; lds_or(&MR[qq * 256 + (idx >> 5)], 1u << (idx & 31u)); }
    }
    __syncthreads();
    for (int e = tid; e < 32 * nw; e += NT) { const int qy = e / nw, w = e % nw; p.MASK[(t0 + qy) * 256 + w] = MR[qy * 256 + w]; }
}
DEVI void ph_indexer(const P& p, float* lds) {
    for (int w = blockIdx.x; w < 256; w += gridDim.x) {
        const int b = w >> 6, j = w & 63;
#pragma unroll 1
        for (int ui = 0; ui < 4; ++ui) {
            const int blk = (ui == 0) ? j : (ui == 1) ? 127 - j : (ui == 2) ? 128 + j : 255 - j;
            index_unit(p, b, blk * 32, lds);
        }
    }
}
DEVI float gain_bound(const float* gq, const float* gk) {
    float a = 0.f, b = 0.f;
    for (int i = 0; i < 128; ++i) { a = fmaxf(a, fabsf(gq[i])); b = fmaxf(b, fabsf(gk[i])); }
    return -(16.33f * a * b + 0.25f);
}
DEVI void attn_unit(const bf16_t* Qp, int ldq, const bf16_t* Kb, const bf16_t* VTb, const unsigned* maskp, bf16_t* Op, int ldo, int nt, int wave_nt, float negB, float* lds) {
    char* base = (char*)lds;
    const int tid = tidx(), lane = tid & 63, wv = tid >> 6, l31 = lane & 31, h = lane >> 5;
    bf16x8 qf[8];
    { const bf16_t* qr = Qp + (long)(32 * wv + l31) * ldq + 8 * h;
#pragma unroll
      for (int ks = 0; ks < 8; ++ks) qf[ks] = *(const bf16x8*)(qr + 16 * ks); }
    const unsigned* mrow = maskp ? maskp + (long)(32 * wv + l31) * 256 : nullptr;
    const bf16_t* kdp[4]; const bf16_t* vdp[2];
#pragma unroll
    for (int i = 0; i < 4; ++i) { const int row = 16 * wv + 4 * i + (lane >> 4), ch = (lane & 15) ^ (row & 15); kdp[i] = Kb + (long)row * 512 + ch * 8; }
#pragma unroll
    for (int i = 0; i < 2; ++i) { const int row = 16 * wv + 8 * i + (lane >> 3), ch = (lane & 7) ^ ((row >> 1) & 7); vdp[i] = VTb + (long)row * 64 + ch * 8; }
    const int kdo = wv * 4096 + lane * 16, vdo = 32768 + wv * 2048 + lane * 16;
    const int kr = l31 * 256, kx = l31 & 15;
    f32x16 o0, o1, o2, o3;
#pragma unroll
    for (int r = 0; r < 16; ++r) { o0[r] = 0.f; o1[r] = 0.f; o2[r] = 0.f; o3[r] = 0.f; }
    float rsum = 0.f;
    const int ns = nt >> 1;
#define ATT_DMA(S, ST) { const long ko_ = (long)(S) * 128 * 512, vo_ = (long)(S) * 2 * 512 * 64; \
        GLDS16(kdp[0] + ko_, base + (ST) + kdo); GLDS16(kdp[1] + ko_, base + (ST) + kdo + 1024); GLDS16(kdp[2] + ko_, base + (ST) + kdo + 2048); GLDS16(kdp[3] + ko_, base + (ST) + kdo + 3072); \
        GLDS16(vdp[0] + vo_, base + (ST) + vdo); GLDS16(vdp[1] + vo_, base + (ST) + vdo + 1024); \
        GLDS16(vdp[0] + vo_ + 512 * 64, base + (ST) + vdo + 16384); GLDS16(vdp[1] + vo_ + 512 * 64, base + (ST) + vdo + 16384 + 1024); }
    __syncthreads();
    ATT_DMA(0, 0)
    asm volatile("s_waitcnt vmcnt(0)\n\ts_barrier" ::: "memory");
    uint4 mwn = make_uint4(0xFFFFFFFFu, 0xFFFFFFFFu, 0xFFFFFFFFu, 0xFFFFFFFFu);
    if (mrow && wave_nt > 0) mwn = *(const uint4*)mrow;
#pragma unroll 1
    for (int sp = 0; sp < ns; ++sp) {
        const int st = (sp & 1) * 65536, sn = 65536 - st;
        const bool more = (sp + 1) < ns;
        const uint4 mw = mwn;
        if (mrow && 2 * (sp + 1) < wave_nt) mwn = *(const uint4*)(mrow + 4 * (sp + 1));
        if (more) ATT_DMA(sp + 1, sn)
#define ATT_BIAS(S, W) { _Pragma("unroll") for (int r = 0; r < 16; ++r) { const unsigned sel = (unsigned)__builtin_amdgcn_sbfe((int)(W), (r & 3) + 8 * (r >> 2), 1); \
                          S[r] = __uint_as_float((sel & __float_as_uint(negB)) | (~sel & 0xFF800000u)); } }
#define ATT_QK(S, KK, J) { _Pragma("unroll") for (int ks = 0; ks < 8; ++ks) { const bf16x8 kf = *(const bf16x8*)(base + st + (J) * 16384 + (KK) * 8192 + kr + (((2 * ks + h) ^ kx) << 4)); \
                          S = __builtin_amdgcn_mfma_f32_32x32x16_bf16(kf, qf[ks], S, 0, 0, 0); } }
#define ATT_PV(S, KK, J) { float ps[16]; _Pragma("unroll") for (int r = 0; r < 16; ++r) { ps[r] = __builtin_amdgcn_exp2f(S[r]); rsum += ps[r]; } \
                        _Pragma("unroll") for (int s_ = 0; s_ < 2; ++s_) { union { bf16x8 v; uint32_t u[4]; } pf; \
                            _Pragma("unroll") for (int e = 0; e < 4; ++e) pf.u[e] = pack2(ps[8 * s_ + 2 * e], ps[8 * s_ + 2 * e + 1]); \
                            const int vo = st + 32768 + (J) * 16384 + l31 * 128 + ((((2 * (2 * (KK) + s_) + h)) ^ ((l31 >> 1) & 7)) << 4); \
                            o0 = __builtin_amdgcn_mfma_f32_32x32x16_bf16(*(const bf16x8*)(base + vo), pf.v, o0, 0, 0, 0); \
                            o1 = __builtin_amdgcn_mfma_f32_32x32x16_bf16(*(const bf16x8*)(base + vo + 4096), pf.v, o1, 0, 0, 0); \
                            o2 = __builtin_amdgcn_mfma_f32_32x32x16_bf16(*(const bf16x8*)(base + vo + 8192), pf.v, o2, 0, 0, 0); \
                            o3 = __builtin_amdgcn_mfma_f32_32x32x16_bf16(*(const bf16x8*)(base + vo + 12288), pf.v, o3, 0, 0, 0); } }
#define ATT_SUB(J, W0, W1) if (2 * sp + (J) < wave_nt) { f32x16 sa, sb; \
            ATT_BIAS(sa, (W0) >> (4 * h)) ATT_BIAS(sb, (W1) >> (4 * h)) \
            __builtin_amdgcn_s_setprio(1); ATT_QK(sa, 0, J) ATT_QK(sb, 1, J) __builtin_amdgcn_s_setprio(0); \
            __builtin_amdgcn_sched_barrier(0); ATT_PV(sa, 0, J) __builtin_amdgcn_sched_barrier(0); ATT_PV(sb, 1, J) }
        ATT_SUB(0, mw.x, mw.y)
        ATT_SUB(1, mw.z, mw.w)
#undef ATT_SUB
#undef ATT_BIAS
#undef ATT_QK
#undef ATT_PV
        asm volatile("s_waitcnt vmcnt(0) lgkmcnt(0)\n\ts_barrier" ::: "memory");
    }
#undef ATT_DMA
    rsum += __int_as_float(__builtin_amdgcn_ds_bpermute((lane ^ 32) << 2, __float_as_int(rsum)));
    const float inv = 1.0f / rsum;
    bf16_t* orow = Op + (long)(32 * wv + l31) * ldo + 4 * h;
#pragma unroll
    for (int g = 0; g < 4; ++g) {
        *(uint2*)(orow + 8 * g)      = make_uint2(pack2(o0[4 * g] * inv, o0[4 * g + 1] * inv), pack2(o0[4 * g + 2] * inv, o0[4 * g + 3] * inv));
        *(uint2*)(orow + 32 + 8 * g) = make_uint2(pack2(o1[4 * g] * inv, o1[4 * g + 1] * inv), pack2(o1[4 * g + 2] * inv, o1[4 * g + 3] * inv));
        *(uint2*)(orow + 64 + 8 * g) = make_uint2(pack2(o2[4 * g] * inv, o2[4 * g + 1] * inv), pack2(o2[4 * g + 2] * inv, o2[4 * g + 3] * inv));
        *(uint2*)(orow + 96 + 8 * g) = make_uint2(pack2(o3[4 * g] * inv, o3[4 * g + 1] * inv), pack2(o3[4 * g + 2] * inv, o3[4 * g + 3] * inv));
    }
}
DEVI void ph_dsa_attn(const P& p, int l, float* lds) {
    const float negB = gain_bound(p.b_qnorm + l * 128, p.b_knorm + l * 128);
    const int wv = tidx() >> 6;
    for (int w = blockIdx.x; w < 256; w += gridDim.x) {
        const int combo = w & 15, b = combo >> 2, head = combo & 3, pr = w >> 4;
#pragma unroll 1
        for (int side = 0; side < 2; ++side) {
            const int qb = side ? 31 - pr : pr; const long t0 = (long)b * SEQ + qb * 256;
            attn_unit(p.QB + t0 * 512 + head * 128, 512, p.KB + (long)b * SEQ * 512 + head * 128, p.VT + ((long)b * 128 * 512 + head * 128) * 64, p.MASK + t0 * 256,
                      p.H + t0 * 1024 + 512 + head * 128, 1024, 4 * qb + 4, 4 * qb + (wv >> 1) + 1, negB, lds);
        }
    }
}
DEVI void ph_xattn(const P& p, int l, float* lds) {
    const float negB = gain_bound(p.x_qnorm + l * 128, p.x_knorm + l * 128);
    for (int u = blockIdx.x; u < 512; u += gridDim.x) {
        const int combo = u & 15, b = combo >> 2, head = combo & 3, qb = u >> 4; const long t0 = (long)b * SEQ + qb * 256;
        attn_unit(p.QX + t0 * 512 + head * 128, 512, p.XK + ((long)(l * 4 + b) * 256) * 512 + head * 128, p.XVT + ((long)(l * 4 + b) * 4 * 512 + head * 128) * 64, nullptr,
                  p.OX + t0 * 512 + head * 128, 512, 4, 4, negB, lds);
    }
}

DEVI void resid_epi_unit(const float* rsrc, float* dst, const tile_t* T, int m0, int tn_base) {
    const int row = tidx() >> 2, q = tidx() & 3;
    float4 cur[8], nxt[8];
    { const float* rp = rsrc + (long)(m0 + row) * DM + tn_base * 128 + 4 * q;
#pragma unroll
      for (int j = 0; j < 8; ++j) cur[j] = *(const float4*)(rp + 16 * j); }
#pragma unroll
    for (int sub = 0; sub < 4; ++sub) {
        if (sub < 3) { const int ns = sub + 1; const float* np = rsrc + (long)(m0 + 128 * (ns >> 1) + row) * DM + (tn_base + (ns & 1)) * 128 + 4 * q;
#pragma unroll
            for (int j = 0; j < 8; ++j) nxt[j] = *(const float4*)(np + 16 * j); }
        const tile_t* Ts = T + (sub >> 1) * 128 * TLD + 128 * (sub & 1);
        float* op = dst + (long)(m0 + 128 * (sub >> 1) + row) * DM + (tn_base + (sub & 1)) * 128 + 4 * q;
#pragma unroll
        for (int j = 0; j < 8; ++j) { const float4 t = t_ld4(Ts, row * TLD + 16 * j + 4 * q); float4 o = cur[j];
            o.x += t.x; o.y += t.y; o.z += t.z; o.w += t.w; *(float4*)(op + 16 * j) = o; }
#pragma unroll
        for (int j = 0; j < 8; ++j) cur[j] = nxt[j];
    }
}
DEVI void ph_outproj(const P& p, int l, float* lds) {
    for (int i = 0;; ++i) {
        int tm, tn2, tn; if (!xcd_unit(i, 4, tm, tn2)) break;
        ATile at{p.H, DM, nullptr, NTOK};
        gemm_unit8(at, tm * 256, p.WOUT + ((long)l * DM + tn2 * 256) * DM, DM, lds, [&](const tile_t* T, int mr0) __attribute__((always_inline)) {
            resid_epi_unit((l == 0) ? p.x : p.out, p.out, T, mr0, tn);
        }, tn, 2 * tn2, 0, true);
    }
}
DEVI void ph_xq(const P& p, int l, float* lds) {
    for (int i = 0;; ++i) {
        int tm, tn2, tn; if (!xcd_unit(i, 2, tm, tn2)) break;
        ATile at{p.H, DM, nullptr, NTOK};
        gemm_unit8(at, tm * 256, p.XWQ + ((long)l * 512 + tn2 * 256) * DM, DM, lds, [&](const tile_t* T, int mr0) __attribute__((always_inline)) {
            float v[8][4]; epi_load(T, v);
            norm_rope128(v, p.x_qnorm + l * 128, 0.f, QSCALE, false);
            epi_store_bf16(v, p.QX + (long)(mr0 + (tidx() >> 2)) * 512 + tn * 128);
        }, tn, 2 * tn2);
    }
}
DEVI void ph_xo(const P& p, int l, float* lds) {
    for (int i = 0;; ++i) {
        int tm, tn2, tn; if (!xcd_unit(i, 4, tm, tn2)) break;
        ATile at{p.OX, 512, nullptr, NTOK};
        gemm_unit8(at, tm * 256, p.XWO + ((long)l * DM + tn2 * 256) * 512, 512, lds, [&](const tile_t* T, int mr0) __attribute__((always_inline)) {
            resid_epi_unit(p.out, p.out, T, mr0, tn);
        }, tn, 2 * tn2, 0, true);
    }
}
DEVI bool moe_unit(const int* cnt, int u, int tilesN, int& e, int& tm, int& tn, int& base) {
    int acc = 0, rb = 0;
    for (int i = 0; i < 16; ++i) { const int tiles = (cnt[i] + 255) >> 8; if (u < acc + tiles * tilesN) { e = i; const int r = u - acc; tm = r / tilesN; tn = r % tilesN; base = rb; return true; } acc += tiles * tilesN; rb += tiles * 256; }
    return false;
}
DEVI void ph_moe_gu(const P& p, int l, float* lds) {
    const int* cnt = p.CNT + l * 16;
    for (int u = blockIdx.x;; u += gridDim.x) {
        int e, tm, tn2, tn, base; if (!moe_unit(cnt, u, 2, e, tm, tn2, base)) break;
        const int ce = cnt[e];
        ATile at{p.H, DM, p.LTOK + (long)e * NTOK, ce};
        gemm_unit8(at, tm * 256, p.WGU + (((long)l * 16 + e) * 512 + tn2 * 256) * DM, DM, lds, [&](const tile_t* T, int mr0) __attribute__((always_inline)) {
            const int row = tidx() >> 2, q = tidx() & 3, r = mr0 + row;
            const float gate = (r < ce) ? p.LGATE[(long)e * NTOK + r] : 0.f;
            bf16_t* op = p.ACT + (long)(base + r) * 256 + tn * 64;
#pragma unroll
            for (int j = 0; j < 4; ++j) { const float4 g = t_ld4(T, row * TLD + 16 * j + 4 * q), uu = t_ld4(T, row * TLD + 64 + 16 * j + 4 * q);
                *(uint2*)(op + 16 * j + 4 * q) = make_uint2(pack2(siluf(g.x) * uu.x * gate, siluf(g.y) * uu.y * gate), pack2(siluf(g.z) * uu.z * gate, siluf(g.w) * uu.w * gate)); }
        }, tn, 2 * tn2);
    }
}
DEVI void ph_moe_dn(const P& p, int l, float* lds) {
    const int* cnt = p.CNT + l * 16;
    for (int u = blockIdx.x;; u += gridDim.x) {
        int e, tm, tn2, tn, base; if (!moe_unit(cnt, u, 4, e, tm, tn2, base)) break;
        const int ce = cnt[e];
        ATile at{p.ACT + (long)base * 256, 256, nullptr, ((ce + 255) >> 8) * 256};
        gemm_unit8(at, tm * 256, p.WDN + (((long)l * 16 + e) * DM + tn2 * 256) * 256, 256, lds, [&](const tile_t* T, int mr0) __attribute__((always_inline)) {
            const int row = tidx() >> 2, q = tidx() & 3, r = mr0 + row;
            if (r < ce) { bf16_t* op = p.Y + (long)p.LSLOT[(long)e * NTOK + r] * DM + tn * 128;
#pragma unroll
                for (int j = 0; j < 8; ++j) { const float4 t = t_ld4(T, row * TLD + 16 * j + 4 * q);
                    *(uint2*)(op + 16 * j + 4 * q) = make_uint2(pack2(t.x, t.y), pack2(t.z, t.w)); } }
        }, tn, 2 * tn2);
    }
}

DEVI void ph_final(const P& p) {
    const long gt = (long)blockIdx.x * NT + tidx(), gs = (long)gridDim.x * NT;
    for (long i = gt; i < (long)NTOK * DM / 4; i += gs) {
        const long row = i >> 8; const int c4 = (int)(i & 255);
        float4 v = ((const float4*)p.out)[i];
        const uint2 a = ((const uint2*)(p.Y + (2 * row) * DM))[c4], b = ((const uint2*)(p.Y + (2 * row + 1) * DM))[c4];
        v.x = (v.x + bflo(a.x)) + bflo(b.x); v.y = (v.y + bfhi(a.x)) + bfhi(b.x); v.z = (v.z + bflo(a.y)) + bflo(b.y); v.w = (v.w + bfhi(a.y)) + bfhi(b.y);
        ((float4*)p.out)[i] = v;
    }
}
constexpr int NPH_PRO = 2, NPH_LAYER = 15;
#ifndef PHSEL
#define PHSEL 0xFFFFFFFFu
#endif
template <int PH> DEVI void run_phase(int l, float* lds, int dry = 0) {
    if (PH < 32 && !((PHSEL >> PH) & 1u)) return;
    asm volatile("; PHASE_BEGIN %0" :: "n"(PH));
    P p = make_P(kargs()); p.dry = dry; if (dry && (PH == 8 || PH == 12)) p.out = p.out_dry;
    if (PH == 100) ph_pro_a(p, lds);
    if (PH == 101) ph_pro_b(p, lds);
    if (PH == 0) { if (l == 0) ph_norm<false, false, true>(p, p.norm_mix + l * DM, l); else if (p.dry) ph_norm<false, false>(p, p.norm_mix + l * DM, l); else ph_norm<false, true>(p, p.norm_mix + l * DM, l); }
    if (PH == 16) ph_final(p);
    if (PH == 1) ph_inproj(p, l, lds);
    if (PH == 2) ph_h1(p, l, lds);
    if (PH == 3) ph_h2(p);
    if (PH == 4) ph_h3(p, l, lds);
    if (PH == 5) ph_qproj(p, l, lds);
    if (PH == 6) ph_indexer(p, lds);
    if (PH == 7) ph_dsa_attn(p, l, lds);
    if (PH == 8) ph_outproj(p, l, lds);
    if (PH == 9) ph_norm<false>(p, p.norm_x + l * DM, l);
    if (PH == 10) ph_xq(p, l, lds);
    if (PH == 11) ph_xattn(p, l, lds);
    if (PH == 12) ph_xo(p, l, lds);
    if (PH == 13) ph_norm<true>(p, p.norm_ffn + l * DM, l);
    if (PH == 14) ph_moe_gu(p, l, lds);
    if (PH == 15) ph_moe_dn(p, l, lds);
}

DEVI void grid_sync(float* lds) {
    XcdBarrier b; b.bar = (unsigned*)(kargs()->ws + WS_BAR); b.x = xb_xcc_id(); b.st = (volatile LAS unsigned*)(lds + (LDS_BYTES / 4) - 4);
    xcd_barrier(b);
}
#if MK_LAUNCHES == 0
template <int PH> __global__ void __launch_bounds__(NT, 2) k_phase(KArgs a, int l) {
    extern __shared__ __attribute__((aligned(16))) float lds[];
    (void)a;
    run_phase<PH>(l, lds);
}
#else

__global__ void __launch_bounds__(NT, 2) k_mega(KArgs a) {
    extern __shared__ __attribute__((aligned(16))) float lds[];
    (void)a;
    uint4* xbw = (uint4*)(lds + (LDS_BYTES / 4) - 4);
    if (tidx() == 0) *xbw = make_uint4(0u, 0u, 0u, 0u);
    __syncthreads();
    (void)xcd_barrier_post((unsigned*)(kargs()->ws + WS_BAR), (volatile LAS unsigned*)xbw);
    run_phase<100>(0, lds); grid_sync(lds); if (PROBE_MASK & (1u << 16)) { run_phase<100>(0, lds, 0); grid_sync(lds); }
    run_phase<101>(0, lds); if (PROBE_MASK & (1u << 17)) { grid_sync(lds); run_phase<101>(0, lds, 0); }
    for (int l = 0; l < 2; ++l) {
        run_phase<0>(l, lds); grid_sync(lds); if (PROBE_MASK & (1u << 0)) { run_phase<0>(l, lds, 1); grid_sync(lds); }
        run_phase<1>(l, lds); grid_sync(lds); if (PROBE_MASK & (1u << 1)) { run_phase<1>(l, lds, PROBE_DRY6); grid_sync(lds); }
        run_phase<2>(l, lds); grid_sync(lds); if (PROBE_MASK & (1u << 2)) { run_phase<2>(l, lds, 1); grid_sync(lds); }
        run_phase<3>(l, lds); grid_sync(lds); if (PROBE_MASK & (1u << 3)) { run_phase<3>(l, lds, 1); grid_sync(lds); }
        run_phase<4>(l, lds); grid_sync(lds); if (PROBE_MASK & (1u << 4)) { run_phase<4>(l, lds, 1); grid_sync(lds); }
        run_phase<5>(l, lds); grid_sync(lds); if (PROBE_MASK & (1u << 5)) { run_phase<5>(l, lds, 1); grid_sync(lds); }
        run_phase<6>(l, lds); grid_sync(lds); if (PROBE_MASK & (1u << 6)) { run_phase<6>(l, lds, PROBE_DRY6); grid_sync(lds); }
        run_phase<7>(l, lds); grid_sync(lds); if (PROBE_MASK & (1u << 7)) { run_phase<7>(l, lds, 1); grid_sync(lds); }
        run_phase<8>(l, lds); grid_sync(lds); if (PROBE_MASK & (1u << 8)) { run_phase<8>(l, lds, 1); grid_sync(lds); }
        run_phase<9>(l, lds); grid_sync(lds); if (PROBE_MASK & (1u << 9)) { run_phase<9>(l, lds, 1); grid_sync(lds); }
        run_phase<10>(l, lds); grid_sync(lds); if (PROBE_MASK & (1u << 10)) { run_phase<10>(l, lds, 1); grid_sync(lds); }
        run_phase<11>(l, lds); grid_sync(lds); if (PROBE_MASK & (1u << 11)) { run_phase<11>(l, lds, 1); grid_sync(lds); }
        run_phase<12>(l, lds); grid_sync(lds); if (PROBE_MASK & (1u << 12)) { run_phase<12>(l, lds, 1); grid_sync(lds); }
        run_phase<13>(l, lds); grid_sync(lds); if (PROBE_MASK & (1u << 13)) { run_phase<13>(l, lds, 1); grid_sync(lds); }
        run_phase<14>(l, lds); grid_sync(lds); if (PROBE_MASK & (1u << 14)) { run_phase<14>(l, lds, 1); grid_sync(lds); }
        run_phase<15>(l, lds); grid_sync(lds); if (PROBE_MASK & (1u << 15)) { run_phase<15>(l, lds, 1); grid_sync(lds); }
    }
    run_phase<16>(1, lds);
}
#endif

template <int PH> static void launch_phase(const KArgs& p, int l, hipStream_t stream);

extern "C" void kernel_launch(void* const* d_in, const int* in_sizes, int n_in, void* d_out, int out_size, void* d_ws, size_t ws_size, hipStream_t stream) {
    (void)in_sizes; (void)out_size;
    if (n_in != 29) { fprintf(stderr, "kernel_launch: expected 29 inputs, got %d\n", n_in); return; }
    KArgs p; memset(&p, 0, sizeof(p));
    for (int i = 0; i < 29; ++i) p.in[i] = d_in[i];
    p.out = (float*)d_out; p.ws = (char*)d_ws;
    if (WS_END > ws_size) { fprintf(stderr, "kernel_launch: workspace too small: need %zu, have %zu\n", (size_t)WS_END, ws_size); return; }
    (void)hipMemsetAsync((char*)d_ws + WS_BAR, 0, XCD_BAR_WORDS * 4, stream);
#if MK_LAUNCHES == 0
    launch_phase<100>(p, 0, stream); launch_phase<101>(p, 0, stream);
    for (int l = 0; l < 2; ++l) {
        launch_phase<0>(p, l, stream); launch_phase<1>(p, l, stream); launch_phase<2>(p, l, stream); launch_phase<3>(p, l, stream);
        launch_phase<4>(p, l, stream); launch_phase<5>(p, l, stream); launch_phase<6>(p, l, stream); launch_phase<7>(p, l, stream);
        launch_phase<8>(p, l, stream); launch_phase<9>(p, l, stream); launch_phase<10>(p, l, stream); launch_phase<11>(p, l, stream);
        launch_phase<12>(p, l, stream); launch_phase<13>(p, l, stream); launch_phase<14>(p, l, stream); launch_phase<15>(p, l, stream);
    }
    launch_phase<16>(p, 1, stream);
#else
    static int grid = 0;
    if (grid == 0) {
        int dev = 0, cus = 0;
        if (hipGetDevice(&dev) != hipSuccess || hipDeviceGetAttribute(&cus, hipDeviceAttributeMultiprocessorCount, dev) != hipSuccess) { fprintf(stderr, "kernel_launch: device query failed\n"); grid = -1; return; }
        if (hipFuncSetAttribute((const void*)k_mega, hipFuncAttributeMaxDynamicSharedMemorySize, LDS_BYTES) != hipSuccess) { fprintf(stderr, "kernel_launch: hipFuncSetAttribute failed\n"); grid = -1; return; }
        int per_cu = 0;
        if (hipOccupancyMaxActiveBlocksPerMultiprocessor(&per_cu, (const void*)k_mega, NT, LDS_BYTES) != hipSuccess || per_cu < 1) { fprintf(stderr, "kernel_launch: occupancy query says %d blocks per CU\n", per_cu); (void)hipGetLastError(); }
        grid = cus;
    }
    if (grid < 0) return;
    hipLaunchKernelGGL(k_mega, dim3(grid), dim3(NT), LDS_BYTES, stream, p);
#endif
}
#if MK_LAUNCHES == 0
template <int PH> static void launch_phase(const KArgs& p, int l, hipStream_t stream) {
    static bool once = false;
    if (!once) { (void)hipFuncSetAttribute((const void*)k_phase<PH>, hipFuncAttributeMaxDynamicSharedMemorySize, LDS_BYTES); once = true; }
    hipLaunchKernelGGL(k_phase<PH>, dim3(256), dim3(NT), LDS_BYTES, stream, p, l);
}
#endif
```

```cpp
#if defined(__HIP_DEVICE_COMPILE__)
#pragma clang attribute push(__attribute__((target("no-packed-fp32-ops"))), apply_to = function)
#endif
#include <hip/hip_runtime.h>
#define TIDX __builtin_amdgcn_workitem_id_x()
#define BIDX __builtin_amdgcn_workgroup_id_x()
#define GDIMX (__builtin_amdgcn_grid_size_x() / 512u)
#include <stdint.h>
#include <stdio.h>
#include <string.h>

#ifndef PROBE_MASK
#define PROBE_MASK 0u
#endif
#ifndef PROBE_DRY6
#define PROBE_DRY6 1
#endif
#ifndef PROBE_X
#define PROBE_X 0
#endif
#ifndef MK_LAUNCHES
#define MK_LAUNCHES 1
#endif

typedef unsigned short bf16_t;
typedef unsigned short tile_t_fwd;
#define NOPK
#define DEVI __device__ __forceinline__ NOPK
#define LAS __attribute__((address_space(3)))

constexpr int NB = 4, SEQ = 8192, NTOK = NB * SEQ, DM = 1024, DIN = 3408;
constexpr int NT = 512;
constexpr int LDS_BYTES = 153600;
constexpr float EPS = 1e-6f;
constexpr float QSCALE = 0.08838834764831845f * 1.4426950408889634f;
constexpr int TLD = 264;

struct P {
    const float *x, *mem; const int* pos;
    const float *norm_mix, *w_in, *lb_raw, *a_gnorm, *b_qlat_gain, *b_wqb, *b_wqidx, *b_qnorm, *b_knorm, *b_kidx_norm,
                *w_out, *norm_x, *norm_mem, *x_wq, *x_wk, *x_wv, *x_wo, *x_qnorm, *x_knorm, *norm_ffn, *w_rg, *b_rg, *w_re, *b_re, *w_gu, *w_dn;
    float* out;
    bf16_t *H, *QA, *VAT, *GA, *UT, *QL, *KB, *VT, *KIDX, *QB, *QIDX, *QX, *OX, *ACT, *XK, *XVT, *MEMN;
    bf16_t* ZF; float *WIDX, *DEC, *COS128, *SIN128, *COS64, *SIN64, *LB, *LGATE;
    unsigned* MASK; int *LTOK, *CNT; unsigned* bar;
    bf16_t *WIN, *WQ, *WOUT, *XWQ, *XWO, *WGU, *WDN, *XWK, *XWV;
    bf16_t* Y; int* LSLOT;
    float* out_dry; int dry;
};


constexpr size_t MiB = 1u << 20;
constexpr size_t WS_BAR = 0, WS_CNT = 16 * 1024, WS_LB = 20 * 1024, WS_DEC = 1 * MiB, WS_COS128 = 2 * MiB, WS_SIN128 = 10 * MiB, WS_COS64 = 18 * MiB, WS_SIN64 = 22 * MiB,
                 WS_XK = 26 * MiB, WS_XVT = 28 * MiB, WS_H = 30 * MiB, WS_QL = 94 * MiB, WS_KB = 110 * MiB, WS_VT = 142 * MiB, WS_KIDX = 174 * MiB, WS_WIDX = 178 * MiB,
                 WS_R1 = 180 * MiB, WS_WIN = 436 * MiB, WS_WQ = WS_WIN + 14 * MiB, WS_WOUT = WS_WQ + 1 * MiB + 512 * 1024, WS_XWQ = WS_WOUT + 4 * MiB,
                 WS_XWO = WS_XWQ + 2 * MiB, WS_WGU = WS_XWO + 2 * MiB, WS_WDN = WS_WGU + 32 * MiB, WS_END = WS_WDN + 16 * MiB;
static_assert(WS_END <= 512 * MiB, "workspace map exceeds the guaranteed 512 MiB");
struct KArgs { const void* in[29]; float* out; char* ws; };
typedef const __attribute__((address_space(4))) KArgs* KArgsPtr;
DEVI KArgsPtr kargs() { KArgsPtr k = (KArgsPtr)__builtin_amdgcn_kernarg_segment_ptr(); asm volatile("" : "+s"(k)); return k; }
DEVI P make_P(KArgsPtr ap) {
    P p;
    p.x = (const float*)ap->in[0]; p.mem = (const float*)ap->in[1]; p.pos = (const int*)ap->in[2];
    p.norm_mix = (const float*)ap->in[3]; p.w_in = (const float*)ap->in[4]; p.lb_raw = (const float*)ap->in[5]; p.a_gnorm = (const float*)ap->in[6]; p.b_qlat_gain = (const float*)ap->in[7];
    p.b_wqb = (const float*)ap->in[8]; p.b_wqidx = (const float*)ap->in[9]; p.b_qnorm = (const float*)ap->in[10]; p.b_knorm = (const float*)ap->in[11]; p.b_kidx_norm = (const float*)ap->in[12];
    p.w_out = (const float*)ap->in[13]; p.norm_x = (const float*)ap->in[14]; p.norm_mem = (const float*)ap->in[15]; p.x_wq = (const float*)ap->in[16]; p.x_wk = (const float*)ap->in[17];
    p.x_wv = (const float*)ap->in[18]; p.x_wo = (const float*)ap->in[19]; p.x_qnorm = (const float*)ap->in[20]; p.x_knorm = (const float*)ap->in[21]; p.norm_ffn = (const float*)ap->in[22];
    p.w_rg = (const float*)ap->in[23]; p.b_rg = (const float*)ap->in[24]; p.w_re = (const float*)ap->in[25]; p.b_re = (const float*)ap->in[26]; p.w_gu = (const float*)ap->in[27]; p.w_dn = (const float*)ap->in[28];
    p.out = ap->out; char* ws = ap->ws;
    p.bar = (unsigned*)(ws + WS_BAR); p.CNT = (int*)(ws + WS_CNT); p.LB = (float*)(ws + WS_LB); p.DEC = (float*)(ws + WS_DEC);
    p.COS128 = (float*)(ws + WS_COS128); p.SIN128 = (float*)(ws + WS_SIN128); p.COS64 = (float*)(ws + WS_COS64); p.SIN64 = (float*)(ws + WS_SIN64);
    p.XK = (bf16_t*)(ws + WS_XK); p.XVT = (bf16_t*)(ws + WS_XVT); p.H = (bf16_t*)(ws + WS_H);
    p.QL = (bf16_t*)(ws + WS_QL); p.KB = (bf16_t*)(ws + WS_KB); p.VT = (bf16_t*)(ws + WS_VT); p.KIDX = (bf16_t*)(ws + WS_KIDX); p.WIDX = (float*)(ws + WS_WIDX);
    char* r1 = ws + WS_R1;
    p.QA = (bf16_t*)(r1); p.ZF = (bf16_t*)(r1 + 32 * MiB); p.VAT = (bf16_t*)(r1 + 128 * MiB); p.GA = (bf16_t*)(r1 + 160 * MiB); p.UT = (bf16_t*)(r1 + 192 * MiB);
    p.QB = (bf16_t*)(r1); p.QIDX = (bf16_t*)(r1 + 32 * MiB); p.MASK = (unsigned*)(r1 + 96 * MiB);
    p.QX = (bf16_t*)(r1); p.OX = (bf16_t*)(r1 + 32 * MiB); p.ACT = (bf16_t*)(r1 + 64 * MiB); p.LTOK = (int*)(r1 + 100 * MiB); p.LGATE = (float*)(r1 + 104 * MiB);
    p.MEMN = (bf16_t*)(r1 + 128 * MiB); p.XWK = (bf16_t*)(r1 + 132 * MiB); p.XWV = (bf16_t*)(r1 + 134 * MiB);
    p.WIN = (bf16_t*)(ws + WS_WIN); p.WQ = (bf16_t*)(ws + WS_WQ); p.WOUT = (bf16_t*)(ws + WS_WOUT); p.XWQ = (bf16_t*)(ws + WS_XWQ); p.XWO = (bf16_t*)(ws + WS_XWO);
    p.WGU = (bf16_t*)(ws + WS_WGU); p.WDN = (bf16_t*)(ws + WS_WDN);
    p.Y = (bf16_t*)(r1 + 128 * MiB); p.LSLOT = (int*)(r1 + 108 * MiB);
    p.out_dry = (float*)(r1 + 128 * MiB); p.dry = 0;
    return p;
}

DEVI int tidx() { int t = (int)TIDX; asm volatile("" : "+v"(t)); return t; }
DEVI float bf2f(bf16_t v) { return __uint_as_float((uint32_t)v << 16); }
DEVI bf16_t f2bf(float f) { uint32_t u = __float_as_uint(f); u += 0x7FFFu + ((u >> 16) & 1u); return (bf16_t)(u >> 16); }
typedef __bf16 hbf16x2 __attribute__((ext_vector_type(2)));
typedef float hf32x2 __attribute__((ext_vector_type(2)));
DEVI uint32_t pack2(float a, float b) { const hf32x2 f = {a, b}; return __builtin_bit_cast(uint32_t, __builtin_convertvector(f, hbf16x2)); }
DEVI float bflo(uint32_t u) { return __uint_as_float(u << 16); }
DEVI float bfhi(uint32_t u) { return __uint_as_float(u & 0xFFFF0000u); }
#define DPP_F(old_, v_, ctrl, rm) __int_as_float(__builtin_amdgcn_update_dpp(__float_as_int(old_), __float_as_int(v_), ctrl, rm, 0xF, false))
#define DPP_I(old_, v_, ctrl, rm) __builtin_amdgcn_update_dpp(old_, v_, ctrl, rm, 0xF, false)
DEVI float wsum(float v) {
    v += DPP_F(0.f, v, 0xB1, 0xF); v += DPP_F(0.f, v, 0x4E, 0xF); v += DPP_F(0.f, v, 0x141, 0xF); v += DPP_F(0.f, v, 0x140, 0xF);
    v += DPP_F(0.f, v, 0x142, 0xA); v += DPP_F(0.f, v, 0x143, 0xC);
    return __int_as_float(__builtin_amdgcn_readlane(__float_as_int(v), 63));
}
DEVI float wmax(float v) {
    v = fmaxf(v, DPP_F(v, v, 0xB1, 0xF)); v = fmaxf(v, DPP_F(v, v, 0x4E, 0xF)); v = fmaxf(v, DPP_F(v, v, 0x141, 0xF)); v = fmaxf(v, DPP_F(v, v, 0x140, 0xF));
    v = fmaxf(v, DPP_F(v, v, 0x142, 0xA)); v = fmaxf(v, DPP_F(v, v, 0x143, 0xC));
    return __int_as_float(__builtin_amdgcn_readlane(__float_as_int(v), 63));
}
DEVI int wsumi(int v) {
    v += DPP_I(0, v, 0xB1, 0xF); v += DPP_I(0, v, 0x4E, 0xF); v += DPP_I(0, v, 0x141, 0xF); v += DPP_I(0, v, 0x140, 0xF);
    v += DPP_I(0, v, 0x142, 0xA); v += DPP_I(0, v, 0x143, 0xC);
    return __builtin_amdgcn_readlane(v, 63);
}
DEVI int wscan_incl(int v) {
    v += DPP_I(0, v, 0x111, 0xF); v += DPP_I(0, v, 0x112, 0xF); v += DPP_I(0, v, 0x114, 0xF); v += DPP_I(0, v, 0x118, 0xF);
    v += DPP_I(0, v, 0x142, 0xA); v += DPP_I(0, v, 0x143, 0xC);
    return v;
}
DEVI float quad_sum(float s) { s += DPP_F(0.f, s, 0xB1, 0xF); s += DPP_F(0.f, s, 0x4E, 0xF); return s; }
DEVI float oct_sum(float s) { s = quad_sum(s); s += DPP_F(0.f, s, 0x141, 0xF); return s; }
DEVI float siluf(float v) { return v / (1.0f + __expf(-v)); }
DEVI int kperm(int k) { return (k & ~12) | ((k & 4) << 1) | ((k & 8) >> 1); }
DEVI long vt_index(long r, int col) { return ((r >> 6) * 512 + col) * 64 + kperm((int)(r & 63)); }
DEVI unsigned ordf(float f) { unsigned u = __float_as_uint(f); return (u & 0x80000000u) ? ~u : (u | 0x80000000u); }

#define XB_TMO      128
#define XB_XCNT(j)  (256  + 64 * (j))
#define XB_XSUB(j)  (1280 + 64 * (j))
#define XB_XGEN(j)  (2304 + 64 * (j))
#define XB_TOP      3328
#define XB_TOPGEN   3392
#define XCD_BAR_WORDS 3456
#define XB_SPIN_CAP (1u << 27)
DEVI unsigned xb_ld(unsigned* p)              { return __hip_atomic_load(p, __ATOMIC_RELAXED, __HIP_MEMORY_SCOPE_AGENT); }
DEVI unsigned xb_add(unsigned* p, unsigned v) { return __hip_atomic_fetch_add(p, v, __ATOMIC_RELAXED, __HIP_MEMORY_SCOPE_AGENT); }
DEVI unsigned xb_xcc_id() { return (unsigned)__builtin_amdgcn_s_getreg((3 << 11) | 20) & 0xFu; }
#define XB_SPIN(cond, bar) do { unsigned _sp = 0; while (cond) { __builtin_amdgcn_s_sleep(1); \
    if ((++_sp & 255u) == 0u) { if (xb_ld(&(bar)[XB_TMO])) break; if (_sp > XB_SPIN_CAP) { atomicAdd(&(bar)[XB_TMO], 1u); break; } } } } while (0)
struct XcdBarrier { unsigned* bar; unsigned x; volatile LAS unsigned* st; };
DEVI XcdBarrier xcd_barrier_post(unsigned* bar, volatile LAS unsigned* st) {
    XcdBarrier b; b.bar = bar; b.x = xb_xcc_id(); b.st = st;
    if (TIDX == 0) (void)xb_add(&bar[XB_XCNT(b.x)], 1u);
    return b;
}
DEVI void xcd_barrier_complete(unsigned* bar, unsigned x, unsigned& nloc, unsigned& nx) {
    const unsigned G = GDIMX;
    unsigned sum, cnt, mine, sp = 0u;
    for (;;) {
        sum = 0u; cnt = 0u; mine = 0u;
#pragma unroll
        for (unsigned j = 0; j < 16; ++j) { const unsigned c = xb_ld(&bar[XB_XCNT(j)]); sum += c; cnt += (c > 0u) ? 1u : 0u; mine = (j == x) ? c : mine; }
        if (sum == G) break;
        __builtin_amdgcn_s_sleep(1);
        if ((++sp & 255u) == 0u) { if (xb_ld(&bar[XB_TMO])) break; if (sp > XB_SPIN_CAP) { atomicAdd(&bar[XB_TMO], 1u); break; } }
    }
    nloc = mine > 0u ? mine : 1u; nx = cnt > 0u ? cnt : 1u;
}
DEVI void xcd_barrier(const XcdBarrier& b) {
    asm volatile("s_waitcnt vmcnt(0)" ::: "memory");
    __syncthreads();
    if (TIDX == 0) {
        unsigned* bar = b.bar;
        __builtin_amdgcn_s_waitcnt(0);
        unsigned nloc = b.st[0], nx = b.st[1];
        if (nloc == 0u) { xcd_barrier_complete(bar, b.x, nloc, nx); b.st[0] = nloc; b.st[1] = nx; }
        const unsigned old = xb_add(&bar[XB_XSUB(b.x)], 1u);
        const unsigned gen = old / nloc;
        if (old + 1u == (gen + 1u) * nloc) {
            __builtin_amdgcn_fence(__ATOMIC_RELEASE, "agent");
            asm volatile("s_waitcnt vmcnt(0)" ::: "memory");
            const unsigned og = xb_add(&bar[XB_TOP], 1u);
            const unsigned tg = og / nx;
            if (og + 1u == (tg + 1u) * nx) xb_add(&bar[XB_TOPGEN], 1u);
            else XB_SPIN(xb_ld(&bar[XB_TOPGEN]) == tg, bar);
            __builtin_amdgcn_fence(__ATOMIC_ACQUIRE, "agent");
            xb_add(&bar[XB_XGEN(b.x)], 1u);
            asm volatile("s_waitcnt vmcnt(0)" ::: "memory");
        } else {
            XB_SPIN(xb_ld(&bar[XB_XGEN(b.x)]) == gen, bar);
            __builtin_amdgcn_fence(__ATOMIC_ACQUIRE, "agent");
            asm volatile("s_waitcnt vmcnt(0)" ::: "memory");
        }
    }
    __syncthreads();
}

struct ATile { const bf16_t* a; int lda; const int* rowmap; int mvalid; };
typedef short bf16x8 __attribute__((ext_vector_type(8)));
typedef float f32x16 __attribute__((ext_vector_type(16)));
DEVI int swz(int row, int chunk) { return row * 128 + ((chunk ^ ((row >> 1) & 7)) << 4); }

#define GLDS16(gp, lp) __builtin_amdgcn_global_load_lds((const __attribute__((address_space(1))) unsigned*)(gp), (__attribute__((address_space(3))) unsigned*)(lp), 16, 0, 0)
DEVI int swz32(int row, int chunk) { return row * 64 + ((chunk ^ ((row >> 2) & 3)) << 4); }
template <class Epi>
DEVI void gemm_unit256(const ATile& at, int m0, const bf16_t* Bt, int K, float* lds, Epi&& epi, int& tn_ref, int tn_base, int skip_epi = 0, bool whole = false) {
    char* base = (char*)lds;
    const int tid = tidx(), lane = tid & 63, wv = tid >> 6, wm = wv >> 1, wn = wv & 1, l31 = lane & 31, h = lane >> 5;
    const bf16_t* ap[2]; const bf16_t* bp[2];
#pragma unroll
    for (int i = 0; i < 2; ++i) { const int row = 32 * wv + 16 * i + (lane >> 2), ch = (lane & 3) ^ ((row >> 2) & 3), grow = m0 + row;
        long srow = 0; if (grow < at.mvalid) srow = at.rowmap ? (long)at.rowmap[grow] : (long)grow;
        ap[i] = at.a + srow * at.lda + ch * 8; bp[i] = Bt + (long)row * K + ch * 8; }
    const int aoffw = wv * 2048 + lane * 16, boffw = 16384 + wv * 2048 + lane * 16;
    int ra[2], rb[2];
#pragma unroll
    for (int ks = 0; ks < 2; ++ks) { ra[ks] = swz32(wm * 64 + l31, 2 * ks + h); rb[ks] = 16384 + swz32(wn * 128 + l31, 2 * ks + h); }
    f32x16 c00, c01, c02, c03, c10, c11, c12, c13;
#pragma unroll
    for (int r = 0; r < 16; ++r) { c00[r] = 0.f; c01[r] = 0.f; c02[r] = 0.f; c03[r] = 0.f; c10[r] = 0.f; c11[r] = 0.f; c12[r] = 0.f; c13[r] = 0.f; }
    const int nk = K >> 5;
#define D_ISSUE(ST, KO) { GLDS16(ap[0] + (KO), base + (ST) + aoffw); GLDS16(ap[1] + (KO), base + (ST) + aoffw + 1024); \
                          GLDS16(bp[0] + (KO), base + (ST) + boffw); GLDS16(bp[1] + (KO), base + (ST) + boffw + 1024); }
    __syncthreads();
    D_ISSUE(0, 0) D_ISSUE(32768, 32) D_ISSUE(65536, 64)
    asm volatile("s_waitcnt vmcnt(8)\n\ts_barrier" ::: "memory");
#pragma unroll 1
    for (int k = 0; k < nk; ++k) {
        const int kn = (k + 3 < nk) ? (k + 3) * 32 : K - 32;
        const int s0 = (k & 3) * 32768, s3 = ((k + 3) & 3) * 32768;
        if (skip_epi < 3) D_ISSUE(s3, kn)
        const bf16x8 a0 = *(const bf16x8*)(base + s0 + ra[0]), a1 = *(const bf16x8*)(base + s0 + ra[0] + 2048);
        const bf16x8 b0 = *(const bf16x8*)(base + s0 + rb[0]), b1 = *(const bf16x8*)(base + s0 + rb[0] + 2048);
        const bf16x8 b2 = *(const bf16x8*)(base + s0 + rb[0] + 4096), b3 = *(const bf16x8*)(base + s0 + rb[0] + 6144);
        const bf16x8 e0 = *(const bf16x8*)(base + s0 + ra[1]), e1 = *(const bf16x8*)(base + s0 + ra[1] + 2048);
        const bf16x8 f0 = *(const bf16x8*)(base + s0 + rb[1]), f1 = *(const bf16x8*)(base + s0 + rb[1] + 2048);
        const bf16x8 f2 = *(const bf16x8*)(base + s0 + rb[1] + 4096), f3 = *(const bf16x8*)(base + s0 + rb[1] + 6144);
        __builtin_amdgcn_sched_barrier(0);
        __builtin_amdgcn_s_setprio(1);
        c00 = __builtin_amdgcn_mfma_f32_32x32x16_bf16(b0, a0, c00, 0, 0, 0); c01 = __builtin_amdgcn_mfma_f32_32x32x16_bf16(b1, a0, c01, 0, 0, 0);
        c02 = __builtin_amdgcn_mfma_f32_32x32x16_bf16(b2, a0, c02, 0, 0, 0); c03 = __builtin_amdgcn_mfma_f32_32x32x16_bf16(b3, a0, c03, 0, 0, 0);
        c10 = __builtin_amdgcn_mfma_f32_32x32x16_bf16(b0, a1, c10, 0, 0, 0); c11 = __builtin_amdgcn_mfma_f32_32x32x16_bf16(b1, a1, c11, 0, 0, 0);
        c12 = __builtin_amdgcn_mfma_f32_32x32x16_bf16(b2, a1, c12, 0, 0, 0); c13 = __builtin_amdgcn_mfma_f32_32x32x16_bf16(b3, a1, c13, 0, 0, 0);
        c00 = __builtin_amdgcn_mfma_f32_32x32x16_bf16(f0, e0, c00, 0, 0, 0); c01 = __builtin_amdgcn_mfma_f32_32x32x16_bf16(f1, e0, c01, 0, 0, 0);
        c02 = __builtin_amdgcn_mfma_f32_32x32x16_bf16(f2, e0, c02, 0, 0, 0); c03 = __builtin_amdgcn_mfma_f32_32x32x16_bf16(f3, e0, c03, 0, 0, 0);
        c10 = __builtin_amdgcn_mfma_f32_32x32x16_bf16(f0, e1, c10, 0, 0, 0); c11 = __builtin_amdgcn_mfma_f32_32x32x16_bf16(f1, e1, c11, 0, 0, 0);
        c12 = __builtin_amdgcn_mfma_f32_32x32x16_bf16(f2, e1, c12, 0, 0, 0); c13 = __builtin_amdgcn_mfma_f32_32x32x16_bf16(f3, e1, c13, 0, 0, 0);
        __builtin_amdgcn_s_setprio(0);
        if (skip_epi < 4) asm volatile("s_waitcnt vmcnt(8) lgkmcnt(0)\n\ts_barrier" ::: "memory");
    }
#undef D_ISSUE
    asm volatile("s_waitcnt vmcnt(0)\n\ts_barrier" ::: "memory");
    unsigned short* T = (unsigned short*)lds;
    {
        unsigned short* t0 = T + (wm * 64 + l31) * TLD + wn * 128 + 4 * h;
#define T_PUT(C, RO, CO) { _Pragma("unroll") for (int g = 0; g < 4; ++g) *(uint2*)(t0 + (RO) * TLD + (CO) + 8 * g) = make_uint2(pack2(C[4 * g], C[4 * g + 1]), pack2(C[4 * g + 2], C[4 * g + 3])); }
        T_PUT(c00, 0, 0) T_PUT(c01, 0, 32) T_PUT(c02, 0, 64) T_PUT(c03, 0, 96) T_PUT(c10, 32, 0) T_PUT(c11, 32, 32) T_PUT(c12, 32, 64) T_PUT(c13, 32, 96)
#undef T_PUT
    }
    __syncthreads();
    if (whole) { tn_ref = tn_base; if (!skip_epi) epi(T, m0); return; }
#pragma unroll 1
    for (int sub = 0; sub < 4 && !skip_epi; ++sub) { const int rh = sub >> 1, ch = sub & 1; tn_ref = tn_base + ch; epi(T + rh * 128 * TLD + 128 * ch, m0 + 128 * rh); }
}

typedef float f32x4 __attribute__((ext_vector_type(4)));
constexpr int PG_HTB = 128 * 64 * 2;
DEVI int pg_lds_byte(int r, int c) { const int st = (r >> 4) * 2 + (c >> 5), rr = r & 15, cc = c & 31, ob = rr * 64 + cc * 2; return st * 1024 + (ob ^ (((ob >> 9) & 1) << 5)); }
DEVI void pg_stage_rc(int b, int& R, int& C) { const int st = b / 1024, sb = b % 1024, sw = sb ^ (((sb >> 9) & 1) << 5); R = (st >> 1) * 16 + sw / 64; C = (st & 1) * 32 + (sw % 64) / 2; }
template <class Epi>
DEVI void gemm_unit8(const ATile& at, int m0, const bf16_t* Bt, int K, float* ldsf, Epi&& epi, int& tn_ref, int tn_base, int skip_epi = 0, bool whole = false) {
    LAS unsigned char* lds = (LAS unsigned char*)ldsf;
    const int tid = tidx(), wid = __builtin_amdgcn_readfirstlane(tid >> 6), lane = tid & 63, wr = wid >> 2, wc = wid & 3, fr = lane & 15, fq = lane >> 4;
    const int nt = K >> 6;
    const char* ap00; const char* ap01; const char* ap10; const char* ap11;
    unsigned vb0, vb1;
    {   int R, C;
        pg_stage_rc(tid * 16, R, C);
        { const int g0 = m0 + R, g1 = m0 + 128 + R;
          const long s0 = (g0 < at.mvalid) ? (at.rowmap ? (long)at.rowmap[g0] : (long)g0) : 0, s1 = (g1 < at.mvalid) ? (at.rowmap ? (long)at.rowmap[g1] : (long)g1) : 0;
          ap00 = (const char*)(at.a + s0 * at.lda + C); ap10 = (const char*)(at.a + s1 * at.lda + C); vb0 = (unsigned)(R * K + C) * 2u; }
        pg_stage_rc(tid * 16 + 8192, R, C);
        { const int g0 = m0 + R, g1 = m0 + 128 + R;
          const long s0 = (g0 < at.mvalid) ? (at.rowmap ? (long)at.rowmap[g0] : (long)g0) : 0, s1 = (g1 < at.mvalid) ? (at.rowmap ? (long)at.rowmap[g1] : (long)g1) : 0;
          ap01 = (const char*)(at.a + s0 * at.lda + C); ap11 = (const char*)(at.a + s1 * at.lda + C); vb1 = (unsigned)(R * K + C) * 2u; }
    }
    const size_t kstep = 128, hstep = (size_t)128 * K * 2;
    const unsigned ldsw = (unsigned)wid * 1024u;
    const int aoff = pg_lds_byte(wr * 64 + fr, fq * 8), boff = pg_lds_byte(wc * 32 + fr, fq * 8);
#define PG_SA(b, h) (((b) * 2 + (h)) * PG_HTB)
#define PG_SB(b, h) ((4 + (b) * 2 + (h)) * PG_HTB)
#define PG_DMA(gp, lo) __builtin_amdgcn_global_load_lds((const __attribute__((address_space(1))) unsigned*)(gp), (LAS unsigned*)(lds + (lo)), 16, 0, 0)
#define PG_STAGE_A0(bufoff, ko) do { PG_DMA(ap00 + (ko), (bufoff) + ldsw); PG_DMA(ap01 + (ko), (bufoff) + ldsw + 8192); } while (0)
#define PG_STAGE_A1(bufoff, ko) do { PG_DMA(ap10 + (ko), (bufoff) + ldsw); PG_DMA(ap11 + (ko), (bufoff) + ldsw + 8192); } while (0)
#define PG_STAGE_B(bufoff, gbase) do { PG_DMA((const char*)(gbase) + vb0, (bufoff) + ldsw); PG_DMA((const char*)(gbase) + vb1, (bufoff) + ldsw + 8192); } while (0)
#define PG_LDA(dst, b, h) do { _Pragma("unroll") for (int m = 0; m < 4; ++m) _Pragma("unroll") for (int k = 0; k < 2; ++k) dst[m][k] = *(const LAS bf16x8*)(lds + PG_SA(b, h) + aoff + m * 2048 + k * 1024); } while (0)
#define PG_LDB(dst, b, h) do { _Pragma("unroll") for (int n = 0; n < 2; ++n) _Pragma("unroll") for (int k = 0; k < 2; ++k) dst[n][k] = *(const LAS bf16x8*)(lds + PG_SB(b, h) + boff + n * 2048 + k * 1024); } while (0)
#define PG_MMA(ai, bj, At_, Bt_) do { __builtin_amdgcn_s_setprio(1); _Pragma("unroll") for (int m = 0; m < 4; ++m) _Pragma("unroll") for (int n = 0; n < 2; ++n) _Pragma("unroll") for (int k = 0; k < 2; ++k) \
        acc[ai][bj][m][n] = __builtin_amdgcn_mfma_f32_16x16x32_bf16(Bt_[n][k], At_[m][k], acc[ai][bj][m][n], 0, 0, 0); __builtin_amdgcn_s_setprio(0); } while (0)
#define PG_WAIT_V(n) asm volatile("s_waitcnt vmcnt(" #n ")" ::: "memory")
#define PG_WAIT_L(n) asm volatile("s_waitcnt lgkmcnt(" #n ")" ::: "memory")
#define PG_BAR __builtin_amdgcn_s_barrier()
#define PG_SCHED __builtin_amdgcn_sched_barrier(0)
    f32x4 acc[2][2][4][2];
#pragma unroll
    for (int a = 0; a < 2; ++a)
#pragma unroll
        for (int b = 0; b < 2; ++b)
#pragma unroll
            for (int m = 0; m < 4; ++m)
#pragma unroll
                for (int n = 0; n < 2; ++n) acc[a][b][m][n] = (f32x4){0.f, 0.f, 0.f, 0.f};
    bf16x8 At[4][2], B0[2][2], B1[2][2];
    const char* cB = (const char*)Bt;
    __syncthreads();
    PG_STAGE_B(PG_SB(0, 0), cB); PG_STAGE_A0(PG_SA(0, 0), 0); PG_STAGE_B(PG_SB(0, 1), cB + hstep); PG_STAGE_A1(PG_SA(0, 1), 0);
    if (wr == 1) PG_BAR;
    PG_WAIT_V(4); PG_BAR;
    PG_STAGE_B(PG_SB(1, 0), cB + kstep); PG_STAGE_A0(PG_SA(1, 0), kstep); PG_STAGE_B(PG_SB(1, 1), cB + hstep + kstep);
    PG_WAIT_V(6); PG_BAR;
#pragma unroll 1
    for (int t = 0; t < nt; t += 2) {
        const bool last = (t == nt - 2);
        const size_t a1 = (size_t)(t + 1) * kstep, a2 = last ? 0 : (size_t)(t + 2) * kstep, a3 = a2 + kstep;
        const char* b2 = cB + a2; const char* b3 = cB + a3;
        PG_LDB(B0, 0, 0); PG_SCHED; PG_LDA(At, 0, 0); PG_STAGE_A1(PG_SA(1, 1), a1);
        PG_WAIT_L(8); PG_BAR; PG_WAIT_L(0); PG_MMA(0, 0, At, B0); PG_BAR; PG_SCHED;
        PG_LDB(B1, 0, 1); PG_STAGE_B(PG_SB(0, 0), b2);
        PG_BAR; PG_WAIT_L(0); PG_MMA(0, 1, At, B1); PG_BAR;
        PG_LDA(At, 0, 1); PG_STAGE_A0(PG_SA(0, 0), a2);
        PG_BAR; PG_WAIT_L(0); PG_MMA(1, 0, At, B0); PG_BAR; PG_SCHED;
        PG_STAGE_B(PG_SB(0, 1), b2 + hstep);
        PG_WAIT_V(6); PG_BAR; PG_MMA(1, 1, At, B1); PG_BAR;
        PG_LDB(B0, 1, 0); PG_SCHED; PG_LDA(At, 1, 0); PG_STAGE_A1(PG_SA(0, 1), a2);
        PG_WAIT_L(8); PG_BAR; PG_WAIT_L(0); PG_MMA(0, 0, At, B0); PG_BAR; PG_SCHED;
        PG_LDB(B1, 1, 1); PG_STAGE_B(PG_SB(1, 0), b3);
        PG_BAR; PG_WAIT_L(0); PG_MMA(0, 1, At, B1); PG_BAR;
        PG_LDA(At, 1, 1); PG_STAGE_A0(PG_SA(1, 0), a3);
        PG_BAR; PG_WAIT_L(0); PG_MMA(1, 0, At, B0); PG_BAR; PG_SCHED;
        PG_STAGE_B(PG_SB(1, 1), b3 + hstep);
        PG_WAIT_V(6); PG_BAR; PG_MMA(1, 1, At, B1); PG_BAR;
    }
    PG_WAIT_V(0);
    if (wr == 0) PG_BAR;
    PG_BAR;
    unsigned short* T = (unsigned short*)ldsf;
#pragma unroll
    for (int ai = 0; ai < 2; ++ai)
#pragma unroll
        for (int m = 0; m < 4; ++m) { unsigned short* tr = T + (ai * 128 + wr * 64 + m * 16 + fr) * TLD + wc * 32 + 4 * fq;
#pragma unroll
            for (int bj = 0; bj < 2; ++bj)
#pragma unroll
                for (int n = 0; n < 2; ++n) { const f32x4 v = acc[ai][bj][m][n]; *(uint2*)(tr + bj * 128 + n * 16) = make_uint2(pack2(v[0], v[1]), pack2(v[2], v[3])); } }
    __syncthreads();
    if (whole) { tn_ref = tn_base; if (!skip_epi) epi(T, m0); return; }
#pragma unroll 1
    for (int sub = 0; sub < 4 && !skip_epi; ++sub) { const int rh = sub >> 1, ch = sub & 1; tn_ref = tn_base + ch; epi(T + rh * 128 * TLD + 128 * ch, m0 + 128 * rh); }
#undef PG_SA
#undef PG_SB
#undef PG_DMA
#undef PG_STAGE_A0
#undef PG_STAGE_A1
#undef PG_STAGE_B
#undef PG_LDA
#undef PG_LDB
#undef PG_MMA
#undef PG_WAIT_V
#undef PG_WAIT_L
#undef PG_BAR
#undef PG_SCHED
}

DEVI void tr_job(const float* src, long mat_stride, int gpm, int nmat, int ld, int K, int nvalid, int mode, bf16_t* dst, float* lds) {
    const int tid = tidx(), kt = K >> 6, total = nmat * gpm * kt;
    const int i = tid >> 3, j8 = (tid & 7) * 8;
#define TR_LOAD(U, X0, X1) { const int G_ = (U) / kt, k0_ = ((U) % kt) * 64, mat_ = G_ / gpm, g_ = G_ % gpm; \
        const int col0_ = (mode == 0) ? g_ * 64 : ((g_ & 1) ? 256 + (g_ >> 1) * 64 : (g_ >> 1) * 64); \
        const float* rp_ = src + mat_ * mat_stride + (long)(k0_ + i) * ld + col0_ + j8; \
        if (col0_ + j8 + 7 < nvalid) { X0 = *(const float4*)rp_; X1 = *(const float4*)(rp_ + 4); } \
        else { float t_[8]; _Pragma("unroll") for (int e = 0; e < 8; ++e) t_[e] = (col0_ + j8 + e < nvalid) ? rp_[e] : 0.f; \
               X0 = make_float4(t_[0], t_[1], t_[2], t_[3]); X1 = make_float4(t_[4], t_[5], t_[6], t_[7]); } }
    float4 x0 = make_float4(0.f, 0.f, 0.f, 0.f), x1 = x0, y0 = x0, y1 = x0;
    int u = BIDX;
    if (u < total) TR_LOAD(u, x0, x1)
    for (; u < total; u += GDIMX) {
        const int un = u + GDIMX;
        if (un < total) TR_LOAD(un, y0, y1)
        const int G = u / kt, k0 = (u % kt) * 64;
        __syncthreads();
        lds[i * 65 + j8] = x0.x; lds[i * 65 + j8 + 1] = x0.y; lds[i * 65 + j8 + 2] = x0.z; lds[i * 65 + j8 + 3] = x0.w;
        lds[i * 65 + j8 + 4] = x1.x; lds[i * 65 + j8 + 5] = x1.y; lds[i * 65 + j8 + 6] = x1.z; lds[i * 65 + j8 + 7] = x1.w;
        __syncthreads();
        { const int n = tid >> 3, kc = (tid & 7) * 8; float f[8];
#pragma unroll
          for (int e = 0; e < 8; ++e) f[e] = lds[(kc + e) * 65 + n];
          uint4 w; w.x = pack2(f[0], f[1]); w.y = pack2(f[2], f[3]); w.z = pack2(f[4], f[5]); w.w = pack2(f[6], f[7]);
          *(uint4*)(dst + ((long)G * 64 + n) * K + k0 + kc) = w; }
        x0 = y0; x1 = y1;
    }
#undef TR_LOAD
}

typedef bf16_t tile_t;
DEVI float4 t_ld4(const tile_t* T, int idx) { const uint2 u = *(const uint2*)(T + idx); return make_float4(bflo(u.x), bfhi(u.x), bflo(u.y), bfhi(u.y)); }
DEVI void epi_load(const tile_t* T, float (&v)[8][4]) {
    const int row = tidx() >> 2, q = tidx() & 3;
#pragma unroll
    for (int j = 0; j < 8; ++j) { const float4 t = t_ld4(T, row * TLD + 16 * j + 4 * q); v[j][0] = t.x; v[j][1] = t.y; v[j][2] = t.z; v[j][3] = t.w; }
}
DEVI void epi_store_bf16(const float (&v)[8][4], bf16_t* rowp  ) {
    const int q = tidx() & 3;
#pragma unroll
    for (int j = 0; j < 8; ++j) *(uint2*)(rowp + 16 * j + 4 * q) = make_uint2(pack2(v[j][0], v[j][1]), pack2(v[j][2], v[j][3]));
}
DEVI void rope_cs(float posf, int c, float fscale, float& cs, float& sn) {
    const float inv = __builtin_amdgcn_exp2f(-(float)c * fscale);
    const float rev = __builtin_amdgcn_fractf((posf * inv) * 0.15915494309189535f);
    sn = __builtin_amdgcn_sinf(rev); cs = __builtin_amdgcn_cosf(rev);
}
constexpr float ROPE_FS128 = 13.287712379549449f * 2.0f / 128.0f, ROPE_FS64 = 13.287712379549449f * 2.0f / 64.0f;
DEVI void norm_rope128(float (&v)[8][4], const float* gain, float posf, float post, bool do_rope) {
    const int q = tidx() & 3;
    float ss = 0.f;
#pragma unroll
    for (int j = 0; j < 8; ++j)
#pragma unroll
        for (int i = 0; i < 4; ++i) ss += v[j][i] * v[j][i];
    ss = quad_sum(ss);
    const float rstd = rsqrtf(ss * (1.0f / 128.0f) + EPS);
#pragma unroll
    for (int j = 0; j < 8; ++j) { const float4 g = *(const float4*)(gain + 16 * j + 4 * q); v[j][0] *= rstd * g.x; v[j][1] *= rstd * g.y; v[j][2] *= rstd * g.z; v[j][3] *= rstd * g.w; }
    if (do_rope) {
#pragma unroll
        for (int j = 0; j < 4; ++j) {
#pragma unroll
            for (int i = 0; i < 4; ++i) { float c_, s_; rope_cs(posf, 16 * j + 4 * q + i, ROPE_FS128, c_, s_);
                const float x1 = v[j][i], x2 = v[j + 4][i]; v[j][i] = x1 * c_ - x2 * s_; v[j + 4][i] = x2 * c_ + x1 * s_; }
        }
    }
#pragma unroll
    for (int j = 0; j < 8; ++j)
#pragma unroll
        for (int i = 0; i < 4; ++i) v[j][i] *= post;
}
DEVI void rope64(float (&v)[8][4], int jb, float posf) {
    const int q = tidx() & 3;
#pragma unroll
    for (int jj = 0; jj < 2; ++jj) {
#pragma unroll
        for (int i = 0; i < 4; ++i) { float c_, s_; rope_cs(posf, 16 * jj + 4 * q + i, ROPE_FS64, c_, s_);
            const float x1 = v[jb + jj][i], x2 = v[jb + jj + 2][i]; v[jb + jj][i] = x1 * c_ - x2 * s_; v[jb + jj + 2][i] = x2 * c_ + x1 * s_; }
    }
}
DEVI void epi_store_vt(const tile_t* T, bf16_t* dst, long r0  , int col0) {
    const int col = tidx() & 127, sg = tidx() >> 7, kt = sg >> 1;
#pragma unroll
    for (int g = 0; g < 2; ++g) {
        const int kb = 32 * (sg & 1) + 16 * g;
#pragma unroll
        for (int half = 0; half < 2; ++half) {
            uint32_t f[8];
#pragma unroll
            for (int e = 0; e < 8; ++e) { const int key = kb + kperm(8 * half + e); f[e] = T[(64 * kt + key) * TLD + col]; }
            uint4 w; w.x = f[0] | (f[1] << 16); w.y = f[2] | (f[3] << 16); w.z = f[4] | (f[5] << 16); w.w = f[6] | (f[7] << 16);
            *(uint4*)(dst + (((r0 >> 6) + kt) * 512 + col0 + col) * 64 + kb + 8 * half) = w;
        }
    }
}

DEVI void sincos_acc(float ang, float& s, float& c) {
    const double a = (double)ang * 0.15915494309189535; const double n = rint(a); const float fr = (float)(a - n);
    s = __builtin_amdgcn_sinf(fr); c = __builtin_amdgcn_cosf(fr);
}
DEVI void ph_pro_w(const P& p, float* lds);
DEVI void ph_pro_a(const P& p, float* lds) {
    const long gt = (long)BIDX * NT + tidx(), gs = (long)GDIMX * NT;
    for (long i = gt; i < 1024; i += gs) { const int l = (int)(i >> 9), c = (int)(i & 511); p.LB[i] = (l == 0) ? 0.f : 1.0f / (1.0f + expf(p.lb_raw[c] - p.lb_raw[512 + c])); }
    for (long i = gt; i < 64; i += gs) p.CNT[i] = 0;
    ph_pro_w(p, lds);
    const int lane = tidx() & 63, gw = BIDX * 8 + (tidx() >> 6), nw = GDIMX * 8;
    for (int r = gw; r < 2 * 1024; r += nw) {
        const int l = r >> 10, rr = r & 1023;
        const float4* xr = (const float4*)(p.mem + (long)rr * DM); const float4* gr = (const float4*)(p.norm_mem + l * DM);
        float4 v[4]; float ss = 0.f;
#pragma unroll
        for (int j = 0; j < 4; ++j) { v[j] = xr[lane + 64 * j]; ss += v[j].x * v[j].x + v[j].y * v[j].y + v[j].z * v[j].z + v[j].w * v[j].w; }
        ss = wsum(ss); const float rstd = rsqrtf(ss * (1.0f / 1024.0f) + EPS);
#pragma unroll
        for (int j = 0; j < 4; ++j) { const float4 g = gr[lane + 64 * j];
            *(uint2*)(p.MEMN + (long)r * DM + 4 * (lane + 64 * j)) = make_uint2(pack2(v[j].x * rstd * g.x, v[j].y * rstd * g.y), pack2(v[j].z * rstd * g.z, v[j].w * rstd * g.w)); }
    }
}
DEVI void ph_pro_w(const P& p, float* lds) {
    tr_job(p.w_in, (long)DM * DIN, 56, 2, DIN, DM, DIN, 0, p.WIN, lds);
    tr_job(p.b_wqb, 256L * 512, 8, 1, 512, 256, 512, 0, p.WQ, lds);
    tr_job(p.b_wqb + 256L * 512, 256L * 512, 8, 1, 512, 256, 512, 0, p.WQ + 1536L * 256, lds);
    tr_job(p.b_wqidx, 256L * 1024, 16, 1, 1024, 256, 1024, 0, p.WQ + 512L * 256, lds);
    tr_job(p.b_wqidx + 256L * 1024, 256L * 1024, 16, 1, 1024, 256, 1024, 0, p.WQ + (1536L + 512) * 256, lds);
    tr_job(p.w_out, (long)DM * DM, 16, 2, DM, DM, DM, 0, p.WOUT, lds);
    tr_job(p.x_wq, (long)DM * 512, 8, 2, 512, DM, 512, 0, p.XWQ, lds);
    tr_job(p.x_wk, (long)DM * 512, 8, 2, 512, DM, 512, 0, p.XWK, lds);
    tr_job(p.x_wv, (long)DM * 512, 8, 2, 512, DM, 512, 0, p.XWV, lds);
    tr_job(p.x_wo, 512L * DM, 16, 2, DM, 512, DM, 0, p.XWO, lds);
    tr_job(p.w_gu, (long)DM * 512, 8, 32, 512, DM, 512, 1, p.WGU, lds);
    tr_job(p.w_dn, 256L * DM, 16, 32, DM, 256, DM, 0, p.WDN, lds);
}
DEVI void ph_pro_b(const P& p, float* lds) {
    for (int u = BIDX; u < 2 * 4 * 4; u += GDIMX) {
        const int l = u >> 4, tm = (u >> 2) & 3, tn2 = u & 3; int tn;
        ATile at{p.MEMN + (long)l * 1024 * DM, DM, nullptr, 1024};
        gemm_unit8(at, tm * 256, ((tn2 >> 1) ? p.XWV : p.XWK) + ((long)l * 512 + (tn2 & 1) * 256) * DM, DM, lds, [&](const tile_t* T, int mr0) __attribute__((always_inline)) NOPK {
            const int isv = tn >> 2, hn = tn & 3;
            if (!isv) {
                float v[8][4]; epi_load(T, v);
                norm_rope128(v, p.x_knorm + l * 128, 0.f, 1.0f, false);
                epi_store_bf16(v, p.XK + ((long)l * 1024 + mr0 + (tidx() >> 2)) * 512 + hn * 128);
            } else {
                epi_store_vt(T, p.XVT + (long)l * 1024 * 512, mr0, hn * 128);
            }
        }, tn, 2 * tn2);
    }
}

#define ST_AGENT(ptr, val) __hip_atomic_store((ptr), (val), __ATOMIC_RELAXED, __HIP_MEMORY_SCOPE_AGENT)
template <bool ROUTER, bool ADDY = false, bool XIN = false>
DEVI void ph_norm(const P& p, const float* gain, int l) {
    const int lane = tidx() & 63, gw = BIDX * 8 + (tidx() >> 6), nw = GDIMX * 8;
    for (int row = gw; row < NTOK; row += nw) {
        const float4* xr = (const float4*)((XIN ? p.x : p.out) + (long)row * DM); const float4* gr = (const float4*)gain;
        float4 v0 = xr[lane], v1 = xr[lane + 64], v2 = xr[lane + 128], v3 = xr[lane + 192];
        if (ADDY) {
            const uint2* y0 = (const uint2*)(p.Y + (long)(2 * row) * DM); const uint2* y1 = (const uint2*)(p.Y + (long)(2 * row + 1) * DM);
#define ADDY_ONE(V, J) { const uint2 a = y0[lane + 64 * J], b = y1[lane + 64 * J]; V.x = (V.x + bflo(a.x)) + bflo(b.x); V.y = (V.y + bfhi(a.x)) + bfhi(b.x); \
                         V.z = (V.z + bflo(a.y)) + bflo(b.y); V.w = (V.w + bfhi(a.y)) + bfhi(b.y); ((float4*)(p.out + (long)row * DM))[lane + 64 * J] = V; }
            ADDY_ONE(v0, 0) ADDY_ONE(v1, 1) ADDY_ONE(v2, 2) ADDY_ONE(v3, 3)
#undef ADDY_ONE
        }
        float ss = v0.x * v0.x + v0.y * v0.y + v0.z * v0.z + v0.w * v0.w + v1.x * v1.x + v1.y * v1.y + v1.z * v1.z + v1.w * v1.w
                 + v2.x * v2.x + v2.y * v2.y + v2.z * v2.z + v2.w * v2.w + v3.x * v3.x + v3.y * v3.y + v3.z * v3.z + v3.w * v3.w;
        ss = wsum(ss); const float rstd = rsqrtf(ss * (1.0f / 1024.0f) + EPS);
#define NORM_ONE(V, J) { const float4 g = gr[lane + 64 * J]; V.x *= rstd * g.x; V.y *= rstd * g.y; V.z *= rstd * g.z; V.w *= rstd * g.w; \
            *(uint2*)(p.H + (long)row * DM + 4 * (lane + 64 * J)) = make_uint2(pack2(V.x, V.y), pack2(V.z, V.w)); }
        NORM_ONE(v0, 0) NORM_ONE(v1, 1) NORM_ONE(v2, 2) NORM_ONE(v3, 3)
#undef NORM_ONE
        if (ROUTER) {
            float4 ag = make_float4(0.f, 0.f, 0.f, 0.f), ae0 = ag, ae1 = ag, ae2 = ag, ae3 = ag;
#define RT_ONE(HH, D) { const float hh = HH; const int d = D; \
                    const float4 wg = *(const float4*)(p.w_rg + ((long)l * DM + d) * 4); \
                    ag.x += hh * wg.x; ag.y += hh * wg.y; ag.z += hh * wg.z; ag.w += hh * wg.w; \
                    const float4* we = (const float4*)(p.w_re + ((long)l * DM + d) * 16); \
                    const float4 w0 = we[0], w1 = we[1], w2 = we[2], w3 = we[3]; \
                    ae0.x += hh * w0.x; ae0.y += hh * w0.y; ae0.z += hh * w0.z; ae0.w += hh * w0.w; \
                    ae1.x += hh * w1.x; ae1.y += hh * w1.y; ae1.z += hh * w1.z; ae1.w += hh * w1.w; \
                    ae2.x += hh * w2.x; ae2.y += hh * w2.y; ae2.z += hh * w2.z; ae2.w += hh * w2.w; \
                    ae3.x += hh * w3.x; ae3.y += hh * w3.y; ae3.z += hh * w3.z; ae3.w += hh * w3.w; }
#define RT_VEC(V, J) RT_ONE(V.x, 4 * (lane + 64 * J)) RT_ONE(V.y, 4 * (lane + 64 * J) + 1) RT_ONE(V.z, 4 * (lane + 64 * J) + 2) RT_ONE(V.w, 4 * (lane + 64 * J) + 3)
            RT_VEC(v0, 0) RT_VEC(v1, 1) RT_VEC(v2, 2) RT_VEC(v3, 3)
#undef RT_VEC
#undef RT_ONE
            ag.x = wsum(ag.x); ag.y = wsum(ag.y); ag.z = wsum(ag.z); ag.w = wsum(ag.w);
            ae0.x = wsum(ae0.x); ae0.y = wsum(ae0.y); ae0.z = wsum(ae0.z); ae0.w = wsum(ae0.w);
            ae1.x = wsum(ae1.x); ae1.y = wsum(ae1.y); ae1.z = wsum(ae1.z); ae1.w = wsum(ae1.w);
            ae2.x = wsum(ae2.x); ae2.y = wsum(ae2.y); ae2.z = wsum(ae2.z); ae2.w = wsum(ae2.w);
            ae3.x = wsum(ae3.x); ae3.y = wsum(ae3.y); ae3.z = wsum(ae3.z); ae3.w = wsum(ae3.w);
            if (lane == 0) {
                const float g0 = ag.x + p.b_rg[l * 4 + 0], g1 = ag.y + p.b_rg[l * 4 + 1], g2 = ag.z + p.b_rg[l * 4 + 2], g3 = ag.w + p.b_rg[l * 4 + 3];
                int gsel = 0; float gm = g0;
                if (g1 > gm) { gm = g1; gsel = 1; }
                if (g2 > gm) { gm = g2; gsel = 2; }
                if (g3 > gm) { gm = g3; gsel = 3; }
                const float gw_ = 1.0f / (expf(g0 - gm) + expf(g1 - gm) + expf(g2 - gm) + expf(g3 - gm));
                const float m0 = (gsel == 0) ? 1.f : 0.f, m1 = (gsel == 1) ? 1.f : 0.f, m2 = (gsel == 2) ? 1.f : 0.f, m3 = (gsel == 3) ? 1.f : 0.f;
                float4 es; es.x = m0 * ae0.x + m1 * ae1.x + m2 * ae2.x + m3 * ae3.x; es.y = m0 * ae0.y + m1 * ae1.y + m2 * ae2.y + m3 * ae3.y;
                es.z = m0 * ae0.z + m1 * ae1.z + m2 * ae2.z + m3 * ae3.z; es.w = m0 * ae0.w + m1 * ae1.w + m2 * ae2.w + m3 * ae3.w;
                const float4 be = *(const float4*)(p.b_re + l * 16 + gsel * 4);
                const float x0 = es.x + be.x, x1 = es.y + be.y, x2 = es.z + be.z, x3 = es.w + be.w;
                int i1 = 0; float e1 = x0;
                if (x1 > e1) { e1 = x1; i1 = 1; }
                if (x2 > e1) { e1 = x2; i1 = 2; }
                if (x3 > e1) { e1 = x3; i1 = 3; }
                int i2 = -1; float e2 = -3.0e38f;
                if (i1 != 0 && x0 > e2) { e2 = x0; i2 = 0; }
                if (i1 != 1 && x1 > e2) { e2 = x1; i2 = 1; }
                if (i1 != 2 && x2 > e2) { e2 = x2; i2 = 2; }
                if (i1 != 3 && x3 > e2) { e2 = x3; i2 = 3; }
                const float z = expf(e2 - e1); const float w1 = 1.0f / (1.0f + z), w2 = z / (1.0f + z);
                const int ex1 = gsel * 4 + i1, ex2 = gsel * 4 + i2;
                if (!p.dry) {
                const int p1 = atomicAdd(&p.CNT[l * 16 + ex1], 1); ST_AGENT(&p.LTOK[(long)ex1 * NTOK + p1], row); ST_AGENT(&p.LSLOT[(long)ex1 * NTOK + p1], 2 * row); ST_AGENT((int*)&p.LGATE[(long)ex1 * NTOK + p1], __float_as_int(w1 * gw_));
                const int p2 = atomicAdd(&p.CNT[l * 16 + ex2], 1); ST_AGENT(&p.LTOK[(long)ex2 * NTOK + p2], row); ST_AGENT(&p.LSLOT[(long)ex2 * NTOK + p2], 2 * row + 1); ST_AGENT((int*)&p.LGATE[(long)ex2 * NTOK + p2], __float_as_int(w2 * gw_)); }
            }
        }
    }
}

DEVI bool xcd_unit(int i, int tilesN, int& tm, int& tn) {
    if ((GDIMX & 7) != 0) { const int u = BIDX + i * GDIMX; if (u >= 128 * tilesN) return false; tm = u / tilesN; tn = u % tilesN; return true; }
    const int xcd = BIDX & 7, slot = BIDX >> 3, nslots = GDIMX >> 3, ul = slot + nslots * i;
    if (ul >= 16 * tilesN) return false;
    tm = xcd + 8 * (ul / tilesN); tn = ul % tilesN; return true;
}
DEVI void epi_inproj(const P& p, int l, const tile_t* T, int m0, int tn) {
    const int row = tidx() >> 2, q = tidx() & 3; const long t = m0 + row;
    if ((tn >= 8 && tn < 12) || (tn >= 22 && tn < 26)) {
        epi_store_vt(T, (tn < 12) ? p.VAT : p.VT, m0, ((tn < 12) ? (tn - 8) : (tn - 22)) * 128);
        return;
    }
    float v[8][4]; epi_load(T, v);
    if (tn < 4 || (tn >= 12 && tn < 16)) {
#pragma unroll
        for (int j = 0; j < 8; ++j)
#pragma unroll
            for (int i = 0; i < 4; ++i) v[j][i] = siluf(v[j][i]);
        epi_store_bf16(v, ((tn < 4) ? p.QA : p.GA) + t * 512 + (tn & 3) * 128);
    } else if (tn < 8) {
        epi_store_bf16(v, p.ZF + t * 512 + (tn - 4) * 128);
    } else if (tn < 18) {
        epi_store_bf16(v, p.QL + t * 256 + (tn - 16) * 128);
    } else if (tn < 22) {
        norm_rope128(v, p.b_knorm + l * 128, (float)p.pos[t], 1.0f, true);
        epi_store_bf16(v, p.KB + t * 512 + (tn - 18) * 128);
    } else {
        float ss = 0.f;
#pragma unroll
        for (int j = 0; j < 4; ++j)
#pragma unroll
            for (int i = 0; i < 4; ++i) ss += v[j][i] * v[j][i];
        ss = quad_sum(ss); const float rstd = rsqrtf(ss * (1.0f / 64.0f) + EPS);
#pragma unroll
        for (int j = 0; j < 4; ++j) { const float4 g = *(const float4*)(p.b_kidx_norm + l * 64 + 16 * j + 4 * q); v[j][0] *= rstd * g.x; v[j][1] *= rstd * g.y; v[j][2] *= rstd * g.z; v[j][3] *= rstd * g.w; }
        rope64(v, 0, (float)p.pos[t]);
#pragma unroll
        for (int j = 0; j < 4; ++j) *(uint2*)(p.KIDX + t * 64 + 16 * j + 4 * q) = make_uint2(pack2(v[j][0], v[j][1]), pack2(v[j][2], v[j][3]));
        *(float4*)(p.WIDX + t * 16 + 4 * q) = make_float4(v[4][0] * 0.03125f, v[4][1] * 0.03125f, v[4][2] * 0.03125f, v[4][3] * 0.03125f);
    }
}
DEVI void ph_inproj(const P& p, int l, float* lds) {
    for (int i = 0;; ++i) {
        int tm, tn2, tn; if (!xcd_unit(i, 14, tm, tn2)) break;
        ATile at{p.H, DM, nullptr, NTOK};
        gemm_unit8(at, tm * 256, p.WIN + ((long)l * 3584 + tn2 * 256) * DM, DM, lds, [&](const tile_t* T, int mr0) __attribute__((always_inline)) NOPK { if (tn < 27) epi_inproj(p, l, T, mr0, tn); }, tn, 2 * tn2, p.dry >= 2 ? p.dry : 0);
    }
}

DEVI void hgrn_state_units(const P& p, int l, float* lds);
DEVI void ph_h1(const P& p, int l, float* lds) {
    const int tid = tidx(), lane = tid & 63;
    if (!p.dry) {
        const int gw = BIDX * 8 + (tid >> 6), nw = GDIMX * 8;
        for (int row = gw; row < NTOK; row += nw) {
            bf16_t* rp = p.QL + (long)row * 256 + 4 * lane; const uint2 u = *(const uint2*)rp;
            float a = bflo(u.x), b = bfhi(u.x), c = bflo(u.y), d = bfhi(u.y);
            float ss = wsum(a * a + b * b + c * c + d * d); const float rstd = rsqrtf(ss * (1.0f / 256.0f) + EPS);
            const float4 g = *(const float4*)(p.b_qlat_gain + l * 256 + 4 * lane);
            *(uint2*)rp = make_uint2(pack2(a * rstd * g.x, b * rstd * g.y), pack2(c * rstd * g.z, d * rstd * g.w));
        }
    }
    hgrn_state_units(p, l, lds);
}
struct HgCol { float b[16]; float kg[16]; float m, bl; };
DEVI void hgrn_cumsum(const P& p, int l, long t0, int h, float* tot  , HgCol& c) {
    const int tid = tidx(), k = tid & 127, sg = tid >> 7;
    const bf16_t* zp = p.ZF + (t0 + 16 * sg) * 512 + h * 128 + k;
    const float lb = p.LB[l * 512 + h * 128 + k];
    bf16_t zr[16];
#pragma unroll
    for (int i = 0; i < 16; ++i) zr[i] = zp[(long)i * 512];
    float run = 0.f;
#pragma unroll
    for (int i = 0; i < 16; ++i) {
        const float z = bf2f(zr[i]);
        const float e = __expf(-fabsf(z)), r1 = __builtin_amdgcn_rcpf(1.0f + e);
        const float sp = (z >= 0.f) ? r1 : e * r1, sn = (z >= 0.f) ? e * r1 : r1;
        const float lf = (lb > 0.f) ? __logf(lb + (1.0f - lb) * sp) : (fminf(z, 0.f) - __logf(1.0f + e));
        c.kg[i] = (1.0f - lb) * sn;
        run += lf; c.b[i] = run;
    }
    __syncthreads();
    tot[sg * 128 + k] = run;
    __syncthreads();
    const float t0_ = tot[k], t1_ = tot[128 + k], t2_ = tot[256 + k], t3_ = tot[384 + k];
    const float off = (sg > 0 ? t0_ : 0.f) + (sg > 1 ? t1_ : 0.f) + (sg > 2 ? t2_ : 0.f);
#pragma unroll
    for (int i = 0; i < 16; ++i) c.b[i] += off;
    c.m = t0_ + t1_; c.bl = (t0_ + t1_) + (t2_ + t3_);
}
DEVI void hgrn_state_units(const P& p, int l, float* lds) {
    char* base = (char*)lds;
    const int tid = tidx(), lane = tid & 63, wv = tid >> 6, l31 = lane & 31, hl = lane >> 5, k = tid & 127, sg = tid >> 7;
    float* tot = (float*)(base + 16384);
    for (int u = BIDX; u < 2048; u += GDIMX) {
        const int bh = u >> 7, c = u & 127, b = bh >> 2, h = bh & 3; const long t0 = (long)b * SEQ + c * 64;
        const bf16_t* vp = p.VAT + (((long)(b * 128 + c) * 512 + h * 128 + 32 * (wv >> 1) + l31) * 64 + 8 * hl);
        const bf16x8 vf0 = *(const bf16x8*)vp, vf1 = *(const bf16x8*)(vp + 16), vf2 = *(const bf16x8*)(vp + 32), vf3 = *(const bf16x8*)(vp + 48);
        HgCol col; hgrn_cumsum(p, l, t0, h, tot, col);
        {
            float kv[16];
#pragma unroll
            for (int i = 0; i < 16; ++i) kv[i] = col.kg[i] * __expf(col.bl - col.b[i]);
            uint4 w0, w1;
            w0.x = pack2(kv[0], kv[1]); w0.y = pack2(kv[2], kv[3]); w0.z = pack2(kv[8], kv[9]); w0.w = pack2(kv[10], kv[11]);
            w1.x = pack2(kv[4], kv[5]); w1.y = pack2(kv[6], kv[7]); w1.z = pack2(kv[12], kv[13]); w1.w = pack2(kv[14], kv[15]);
            *(uint4*)(base + swz(k, 2 * sg)) = w0; *(uint4*)(base + swz(k, 2 * sg + 1)) = w1;
            if (sg == 0) p.DEC[u * 128 + k] = __expf(col.bl);
        }
        __syncthreads();
        {
            const int vt = wv >> 1, kt0 = 2 * (wv & 1);
            f32x16 a0, a1;
#pragma unroll
            for (int r = 0; r < 16; ++r) { a0[r] = 0.f; a1[r] = 0.f; }
#pragma unroll
            for (int ks = 0; ks < 4; ++ks) {
                const bf16x8 vf = (ks == 0) ? vf0 : (ks == 1) ? vf1 : (ks == 2) ? vf2 : vf3;
                const bf16x8 k0 = *(const bf16x8*)(base + swz(32 * kt0 + l31, 2 * ks + hl)), k1 = *(const bf16x8*)(base + swz(32 * kt0 + 32 + l31, 2 * ks + hl));
                a0 = __builtin_amdgcn_mfma_f32_32x32x16_bf16(k0, vf, a0, 0, 0, 0);
                a1 = __builtin_amdgcn_mfma_f32_32x32x16_bf16(k1, vf, a1, 0, 0, 0);
            }
            bf16_t* up = p.UT + (long)u * 16384 + (32 * vt + l31) * 128 + 32 * kt0 + 4 * hl;
#pragma unroll
            for (int g = 0; g < 4; ++g) {
                *(uint2*)(up + 8 * g)      = make_uint2(pack2(a0[4 * g], a0[4 * g + 1]), pack2(a0[4 * g + 2], a0[4 * g + 3]));
                *(uint2*)(up + 32 + 8 * g) = make_uint2(pack2(a1[4 * g], a1[4 * g + 1]), pack2(a1[4 * g + 2], a1[4 * g + 3]));
            }
        }
    }
}
DEVI void ph_h2(const P& p) {
    const long gt = (long)BIDX * NT + tidx(), gs = (long)GDIMX * NT;
    for (long e = gt; e < 16 * 8192; e += gs) {
        const int bh = (int)(e >> 13), vk = (int)(e & 8191) * 2, k = vk & 127; float s0 = 0.f, s1 = 0.f;
        uint32_t* up = (uint32_t*)(p.UT + (long)bh * 128 * 16384 + vk); uint32_t* wp_ = p.dry ? (uint32_t*)(p.H + (long)bh * 128 * 16384 + vk) : up; const float* dp = p.DEC + (long)bh * 128 * 128 + k;
#pragma unroll 1
        for (int c0 = 0; c0 < 128; c0 += 16) {
            uint32_t uu[16]; float2 dd[16];
#pragma unroll
            for (int j = 0; j < 16; ++j) { uu[j] = up[(long)(c0 + j) * 8192]; dd[j] = *(const float2*)(dp + (c0 + j) * 128); }
#pragma unroll
            for (int j = 0; j < 16; ++j) { wp_[(long)(c0 + j) * 8192] = pack2(s0, s1); s0 = dd[j].x * s0 + bflo(uu[j]); s1 = dd[j].y * s1 + bfhi(uu[j]); }
        }
    }
}
DEVI void ph_h3(const P& p, int l, float* lds) {
    char* base = (char*)lds;
    const int tid = tidx(), lane = tid & 63, wv = tid >> 6, l31 = lane & 31, hl = lane >> 5, k = tid & 127, sg = tid >> 7;
    float* tot = (float*)(base + 49152); float* part = (float*)(base + 51200);
    for (int u = BIDX; u < 2048; u += GDIMX) {
        const int bh = u >> 7, c = u & 127, b = bh >> 2, h = bh & 3; const long t0 = (long)b * SEQ + c * 64;
        bf16_t qraw[16];
#pragma unroll
        for (int i = 0; i < 16; ++i) { const long gi = (t0 + 16 * sg + i) * 512 + h * 128 + k; qraw[i] = p.QA[gi]; }
        const int vt = wv >> 1, tt = wv & 1;
        const bf16_t* vp = p.VAT + (((long)(b * 128 + c) * 512 + h * 128 + 32 * vt + l31) * 64 + 8 * hl);
        const bf16_t* sp = p.UT + (long)u * 16384 + (32 * vt + l31) * 128 + 8 * hl;
        bf16x8 vfr[4], sfr[8];
        uint2 ggr[4]; float4 gnr[4];
#pragma unroll
        for (int g = 0; g < 4; ++g) { const int v0 = 32 * vt + 8 * g + 4 * hl; ggr[g] = *(const uint2*)(p.GA + (t0 + 32 * tt + l31) * 512 + h * 128 + v0); gnr[g] = *(const float4*)(p.a_gnorm + l * 128 + v0); }
#pragma unroll
        for (int i = 0; i < 4; ++i) vfr[i] = *(const bf16x8*)(vp + 16 * i);
#pragma unroll
        for (int i = 0; i < 8; ++i) sfr[i] = *(const bf16x8*)(sp + 16 * i);
        HgCol col; hgrn_cumsum(p, l, t0, h, tot, col);
#pragma unroll
        for (int i = 0; i < 16; ++i) {
            const int s = 16 * sg + i;
            const float q = bf2f(qraw[i]), ka = col.kg[i];
            const int o = s * 256 + ((((k >> 3) ^ (s & 15)) << 4) | ((k & 7) << 1));
            *(bf16_t*)(base + o)         = f2bf(q * __expf(col.b[i] - col.m));
            *(bf16_t*)(base + 16384 + o) = f2bf(ka * __expf(col.m - col.b[i]));
            *(bf16_t*)(base + 32768 + o) = f2bf(q * __expf(col.b[i]));
        }
        __syncthreads();
        f32x16 o;
#pragma unroll
        for (int r = 0; r < 16; ++r) o[r] = 0.f;
        const int tro = (32 * tt + l31) * 256, trx = l31 & 15;
#pragma unroll
        for (int st = 0; st < 2; ++st) {
            if (st <= tt) {
                f32x16 sacc;
#pragma unroll
                for (int r = 0; r < 16; ++r) sacc[r] = 0.f;
#pragma unroll
                for (int ks = 0; ks < 8; ++ks) {
                    const bf16x8 kf = *(const bf16x8*)(base + 16384 + (32 * st + l31) * 256 + (((2 * ks + hl) ^ trx) << 4));
                    const bf16x8 qf = *(const bf16x8*)(base + tro + (((2 * ks + hl) ^ trx) << 4));
                    sacc = __builtin_amdgcn_mfma_f32_32x32x16_bf16(kf, qf, sacc, 0, 0, 0);
                }
                float ps[16];
#pragma unroll
                for (int r = 0; r < 16; ++r) { const int sl = (r & 3) + 8 * (r >> 2) + 4 * hl; ps[r] = (st < tt || sl <= l31) ? sacc[r] : 0.f; }
#pragma unroll
                for (int s_ = 0; s_ < 2; ++s_) {
                    union { bf16x8 v; uint32_t w[4]; } pf;
#pragma unroll
                    for (int e = 0; e < 4; ++e) pf.w[e] = pack2(ps[8 * s_ + 2 * e], ps[8 * s_ + 2 * e + 1]);
                    const bf16x8 vf = vfr[2 * st + s_];
                    o = __builtin_amdgcn_mfma_f32_32x32x16_bf16(vf, pf.v, o, 0, 0, 0);
                }
            }
        }
        {
#pragma unroll
            for (int ks = 0; ks < 8; ++ks) {
                const bf16x8 sf = sfr[ks];
                const bf16x8 qf = *(const bf16x8*)(base + 32768 + tro + (((2 * ks + hl) ^ trx) << 4));
                o = __builtin_amdgcn_mfma_f32_32x32x16_bf16(sf, qf, o, 0, 0, 0);
            }
        }
        float ss = 0.f;
#pragma unroll
        for (int r = 0; r < 16; ++r) ss += o[r] * o[r];
        ss += __int_as_float(__builtin_amdgcn_ds_bpermute((lane ^ 32) << 2, __float_as_int(ss)));
        if (hl == 0) part[vt * 64 + 32 * tt + l31] = ss;
        __syncthreads();
        const int t = 32 * tt + l31;
        const float rstd = rsqrtf((part[t] + part[64 + t] + part[128 + t] + part[192 + t]) * (1.0f / 128.0f) + EPS);
#pragma unroll
        for (int g = 0; g < 4; ++g) {
            const int v0 = 32 * vt + 8 * g + 4 * hl;
            const float4 gn = gnr[g]; const uint2 gg = ggr[g];
            *(uint2*)(p.H + (t0 + t) * 1024 + h * 128 + v0) = make_uint2(pack2(o[4 * g] * rstd * gn.x * bflo(gg.x), o[4 * g + 1] * rstd * gn.y * bfhi(gg.x)),
                                                                        pack2(o[4 * g + 2] * rstd * gn.z * bflo(gg.y), o[4 * g + 3] * rstd * gn.w * bfhi(gg.y)));
        }
    }
}

DEVI void ph_qproj(const P& p, int l, float* lds) {
    for (int i = 0;; ++i) {
        int tm, tn2, tn; if (!xcd_unit(i, 6, tm, tn2)) break;
        ATile at{p.QL, 256, nullptr, NTOK};
        gemm_unit8(at, tm * 256, p.WQ + ((long)l * 1536 + tn2 * 256) * 256, 256, lds, [&](const tile_t* T, int mr0) __attribute__((always_inline)) NOPK {
            const int row = tidx() >> 2, q = tidx() & 3; const long t = mr0 + row;
            float v[8][4]; epi_load(T, v);
            if (tn < 4) {
                norm_rope128(v, p.b_qnorm + l * 128, (float)p.pos[t], QSCALE, true);
                epi_store_bf16(v, p.QB + t * 512 + tn * 128);
            } else {
                const float posf = (float)p.pos[t]; rope64(v, 0, posf); rope64(v, 4, posf);
                const int h0 = 2 * (tn - 4); const float w0 = p.WIDX[t * 16 + h0], w1 = p.WIDX[t * 16 + h0 + 1];
#pragma unroll
                for (int j = 0; j < 8; ++j)
#pragma unroll
                    for (int i = 0; i < 4; ++i) v[j][i] *= (j < 4) ? w0 : w1;
                epi_store_bf16(v, p.QIDX + t * 1024 + h0 * 64);
            }
        }, tn, 2 * tn2);
    }
}
constexpr int IXCAP = 624;
constexpr int IX_QP = 0, IX_LIST = 69632, IX_CNT = IX_LIST + 32 * IXCAP * 4, IX_CNTN = IX_CNT + 128, IX_THR = IX_CNTN + 128;
typedef LAS unsigned* lds_u32p;
DEVI unsigned lds_add_rtn(unsigned* p, unsigned v) { return __hip_atomic_fetch_add((lds_u32p)p, v, __ATOMIC_RELAXED, __HIP_MEMORY_SCOPE_WORKGROUP); }
DEVI void lds_add(unsigned* p, unsigned v) { (void)__hip_atomic_fetch_add((lds_u32p)p, v, __ATOMIC_RELAXED, __HIP_MEMORY_SCOPE_WORKGROUP); }
DEVI void lds_or(unsigned* p, unsigned v) { (void)__hip_atomic_fetch_or((lds_u32p)p, v, __ATOMIC_RELAXED, __HIP_MEMORY_SCOPE_WORKGROUP); }
DEVI unsigned wmaxu(unsigned v) {
    v = max(v, (unsigned)DPP_I((int)v, (int)v, 0xB1, 0xF)); v = max(v, (unsigned)DPP_I((int)v, (int)v, 0x4E, 0xF)); v = max(v, (unsigned)DPP_I((int)v, (int)v, 0x141, 0xF)); v = max(v, (unsigned)DPP_I((int)v, (int)v, 0x140, 0xF));
    v = max(v, (unsigned)DPP_I((int)v, (int)v, 0x142, 0xA)); v = max(v, (unsigned)DPP_I((int)v, (int)v, 0x143, 0xC));
    return (unsigned)__builtin_amdgcn_readlane((int)v, 63);
}
DEVI unsigned prune256(unsigned* lst_, int n, int lane, bool exact, int& cnt_out) {
    lds_u32p lst = (lds_u32p)lst_;
    unsigned v[10];
#pragma unroll
    for (int j = 0; j < 10; ++j) v[j] = (lane + 64 * j < n) ? lst[lane + 64 * j] : 0u;
    unsigned mx = 0u, mn = 0u;
#pragma unroll
    for (int j = 0; j < 10; ++j) { mx = max(mx, v[j]); mn = max(mn, (lane + 64 * j < n) ? ~v[j] : 0u); }
    mx = wmaxu(mx); mn = ~wmaxu(mn);
    const unsigned diff = mx ^ mn;
    int bit = 31 - __builtin_clz(diff | 1u);
    unsigned thr = (bit >= 31) ? 0u : (mx & ~((2u << bit) - 1u));
    int cnt = n;
    const int hi = exact ? 256 : 320;
#pragma unroll 1
    for (; bit >= 0 && cnt > hi; --bit) {
        const unsigned trial = thr | (1u << bit); int c = 0;
#pragma unroll
        for (int j = 0; j < 10; ++j) c += __builtin_popcountll(__builtin_amdgcn_ballot_w64(v[j] >= trial));
        if (c >= 256) { thr = trial; cnt = c; }
    }
    int basep = 0;
#pragma unroll
    for (int j = 0; j < 10; ++j) {
        const bool keep = v[j] >= thr; const unsigned long long m = __builtin_amdgcn_ballot_w64(keep);
        const int pos = basep + (int)__builtin_amdgcn_mbcnt_hi((unsigned)(m >> 32), __builtin_amdgcn_mbcnt_lo((unsigned)m, 0u));
        if (keep) lst[pos] = v[j];
        basep += __builtin_popcountll(m);
    }
    cnt_out = basep;
    return thr;
}
constexpr int IX_KEEP = IXCAP - 256;
DEVI unsigned prune_bucket(unsigned* lst_, int n, int lane, unsigned* hist  , int& cnt_out) {
    lds_u32p lst = (lds_u32p)lst_; lds_u32p hs = (lds_u32p)hist;
    unsigned v[10];
#pragma unroll
    for (int j = 0; j < 10; ++j) v[j] = (lane + 64 * j < n) ? lst[lane + 64 * j] : 0u;
    unsigned mx = 0u, mn = 0u;
#pragma unroll
    for (int j = 0; j < 10; ++j) { mx = max(mx, v[j]); mn = max(mn, (lane + 64 * j < n) ? ~v[j] : 0u); }
    mx = wmaxu(mx); mn = ~wmaxu(mn);
    const unsigned range = mx - mn;
    const int sh = max(0, 26 - (int)__builtin_clz(range | 1u));
    hs[lane] = 0u;
    __builtin_amdgcn_wave_barrier();
#pragma unroll
    for (int j = 0; j < 10; ++j) if (lane + 64 * j < n) lds_add((unsigned*)(hist + ((v[j] - mn) >> sh)), 1u);
    __builtin_amdgcn_wave_barrier();
    asm volatile("s_waitcnt lgkmcnt(0)" ::: "memory");
    const int suf = wscan_incl((int)hs[63 - lane]);
    const unsigned long long ok = __builtin_amdgcn_ballot_w64(suf >= 256);
    const int i0 = __builtin_ctzll(ok | (1ull << 63));
    const int kept = __builtin_amdgcn_readlane(suf, i0);
    if (kept > IX_KEEP) { return prune256(lst_, n, lane, false, cnt_out); }
    const unsigned thr = mn + ((unsigned)(63 - i0) << sh);
    int basep = 0;
#pragma unroll
    for (int j = 0; j < 10; ++j) {
        const bool keep = v[j] >= thr && (lane + 64 * j < n); const unsigned long long m = __builtin_amdgcn_ballot_w64(keep);
        const int pos = basep + (int)__builtin_amdgcn_mbcnt_hi((unsigned)(m >> 32), __builtin_amdgcn_mbcnt_lo((unsigned)m, 0u));
        if (keep) lst[pos] = v[j];
        basep += __builtin_popcountll(m);
    }
    cnt_out = basep;
    return thr;
}
#define IX_BAR() do { asm volatile("s_waitcnt lgkmcnt(0)\n\ts_barrier" ::: "memory"); if (PROBE_X == 2) asm volatile("s_waitcnt lgkmcnt(0)\n\ts_barrier" ::: "memory"); } while (0)
DEVI void ix_append(const unsigned (&pk)[16], unsigned* CNT, unsigned* LIST, unsigned* THR, int l31, int dry = 0) {
    if (dry >= 4) return;
    const unsigned thrq = THR[l31]; unsigned c2 = 0;
#pragma unroll
    for (int r = 0; r < 16; ++r) c2 += (pk[r] > thrq) ? 1u : 0u;
    if (c2) { unsigned pos = lds_add_rtn(&CNT[l31], c2); lds_u32p lq = (lds_u32p)(LIST + l31 * IXCAP);
#pragma unroll
        for (int r = 0; r < 16; ++r) if (pk[r] > thrq) { lq[dry ? (pos & 511u) : pos] = pk[r]; ++pos; } }
}
DEVI void index_unit(const P& p, int b, int q0, float* lds) {
    char* base = (char*)lds;
    const int tid = tidx(), lane = tid & 63, wv = tid >> 6, l31 = lane & 31, h = lane >> 5;
    const long t0 = (long)b * SEQ + q0; const int L = ((q0 >> 6) + 1) * 64, nw = L >> 5;
    if (L <= 256) { for (int e = tid; e < 32 * nw; e += NT) p.MASK[(t0 + e / nw) * 256 + (e % nw)] = 0xFFFFFFFFu; return; }
    unsigned* LIST = (unsigned*)(base + IX_LIST); unsigned* CNT = (unsigned*)(base + IX_CNT); unsigned* CNTN = (unsigned*)(base + IX_CNTN); unsigned* THR = (unsigned*)(base + IX_THR);
    unsigned* BIG = THR + 32; unsigned* HIST = THR + 64;
    __syncthreads();
#pragma unroll
    for (int i = 0; i < 8; ++i) { const int c = tid + 512 * i, qy = c >> 7, rem = c & 127, hd = rem >> 3, ch = rem & 7;
        *(uint4*)(base + IX_QP + swz(hd * 32 + qy, ch)) = *(const uint4*)(p.QIDX + (t0 + qy) * 1024 + hd * 64 + ch * 8); }
    if (tid < 256) {
        const int qy = tid >> 3, ch = tid & 7; float a[8];
#pragma unroll
        for (int e = 0; e < 8; ++e) a[e] = 0.f;
#pragma unroll 4
        for (int hd = 0; hd < 16; ++hd) { const uint4 w = *(const uint4*)(p.QIDX + (t0 + qy) * 1024 + hd * 64 + ch * 8);
            a[0] += bflo(w.x); a[1] += bfhi(w.x); a[2] += bflo(w.y); a[3] += bfhi(w.y); a[4] += bflo(w.z); a[5] += bfhi(w.z); a[6] += bflo(w.w); a[7] += bfhi(w.w); }
        uint4 o; o.x = pack2(a[0], a[1]); o.y = pack2(a[2], a[3]); o.z = pack2(a[4], a[5]); o.w = pack2(a[6], a[7]);
        *(uint4*)(base + IX_QP + swz(512 + qy, ch)) = o;
    }
    if (tid < 32) { CNT[tid] = 0u; CNTN[tid] = 0u; THR[tid] = 0u; }
    if (tid == 0) *BIG = 0u;
    unsigned sgbits = 0u;
    { const float4* wp = (const float4*)(p.WIDX + (t0 + l31) * 16);
#pragma unroll
      for (int g = 0; g < 4; ++g) { const float4 w = wp[g]; sgbits |= (w.x < 0.f ? 1u : 0u) << (4 * g); sgbits |= (w.y < 0.f ? 2u : 0u) << (4 * g); sgbits |= (w.z < 0.f ? 4u : 0u) << (4 * g); sgbits |= (w.w < 0.f ? 8u : 0u) << (4 * g); } }
    __syncthreads();
    const int ntile = (L + 511) >> 9;
    const bf16_t* kbase = p.KIDX + ((long)b * SEQ + 64 * wv + l31) * 64 + 8 * h;
    const int boff = IX_QP + l31 * 128, bx = (l31 >> 1) & 7;
    bf16x8 a0, a1, a2, a3, e0, e1, e2, e3;
#define IX_LDA(KP) { const bf16_t* kp_ = (KP); a0 = *(const bf16x8*)kp_; a1 = *(const bf16x8*)(kp_ + 16); a2 = *(const bf16x8*)(kp_ + 32); a3 = *(const bf16x8*)(kp_ + 48); \
                     e0 = *(const bf16x8*)(kp_ + 2048); e1 = *(const bf16x8*)(kp_ + 2064); e2 = *(const bf16x8*)(kp_ + 2080); e3 = *(const bf16x8*)(kp_ + 2096); }
    if (64 * wv < L) IX_LDA(kbase)
#pragma unroll 1
    for (int kt = 0; kt < ntile; ++kt) {
        const int key0 = kt * 512 + 64 * wv; const bool active = key0 < L;
        const bf16x8 c0 = a0, c1 = a1, c2 = a2, c3 = a3, d0 = e0, d1 = e1, d2 = e2, d3 = e3;
        if (key0 + 512 < L) IX_LDA(kbase + (long)(kt + 1) * 512 * 64)
        unsigned pk0[16], pk1[16];
        int boffv = boff; asm volatile("" : "+v"(boffv));
        if (active) {
            f32x16 s0, s1;
#pragma unroll
            for (int r = 0; r < 16; ++r) { s0[r] = 0.f; s1[r] = 0.f; }
#define IX_CHAIN(ACC0, ACC1, BP) { const bf16x8 q0_ = *(const bf16x8*)((BP) + (((0 + h) ^ bx) << 4)), q1_ = *(const bf16x8*)((BP) + (((2 + h) ^ bx) << 4)); \
              const bf16x8 q2_ = *(const bf16x8*)((BP) + (((4 + h) ^ bx) << 4)), q3_ = *(const bf16x8*)((BP) + (((6 + h) ^ bx) << 4)); \
              ACC0 = __builtin_amdgcn_mfma_f32_32x32x16_bf16(c0, q0_, ACC0, 0, 0, 0); ACC1 = __builtin_amdgcn_mfma_f32_32x32x16_bf16(d0, q0_, ACC1, 0, 0, 0); \
              ACC0 = __builtin_amdgcn_mfma_f32_32x32x16_bf16(c1, q1_, ACC0, 0, 0, 0); ACC1 = __builtin_amdgcn_mfma_f32_32x32x16_bf16(d1, q1_, ACC1, 0, 0, 0); \
              ACC0 = __builtin_amdgcn_mfma_f32_32x32x16_bf16(c2, q2_, ACC0, 0, 0, 0); ACC1 = __builtin_amdgcn_mfma_f32_32x32x16_bf16(d2, q2_, ACC1, 0, 0, 0); \
              ACC0 = __builtin_amdgcn_mfma_f32_32x32x16_bf16(c3, q3_, ACC0, 0, 0, 0); ACC1 = __builtin_amdgcn_mfma_f32_32x32x16_bf16(d3, q3_, ACC1, 0, 0, 0); }
            IX_CHAIN(s0, s1, base + boffv + 16 * 4096)
#pragma unroll 2
            for (int hd = 0; hd < 16; ++hd) {
                const float sgf = ((sgbits >> hd) & 1u) ? -1.f : 1.f;
                f32x16 u0, u1;
#pragma unroll
                for (int r = 0; r < 16; ++r) { u0[r] = 0.f; u1[r] = 0.f; }
                IX_CHAIN(u0, u1, base + boffv + hd * 4096)
#pragma unroll
                for (int r = 0; r < 16; ++r) { s0[r] = __builtin_fmaf(sgf, __builtin_fabsf(u0[r]), s0[r]); s1[r] = __builtin_fmaf(sgf, __builtin_fabsf(u1[r]), s1[r]); }
            }
#undef IX_CHAIN
            if (p.dry == 2) { float mxs = s0[0];
#pragma unroll
                for (int r = 1; r < 16; ++r) mxs = fmaxf(mxs, fmaxf(s0[r], s1[r]));
                if (mxs == 1.2345e30f) p.MASK[0] = 1u; }
            const unsigned thrq = (p.dry == 2) ? 0xFFFFFFFFu : THR[l31]; int c = 0;
#pragma unroll
            for (int r = 0; r < 16; ++r) { const unsigned ko = (unsigned)(key0 + (r & 3) + 8 * (r >> 2) + 4 * h);
                pk0[r] = (ordf(s0[r]) & 0xFFFFE000u) | ko; pk1[r] = (ordf(s1[r]) & 0xFFFFE000u) | (ko + 32u);
                c += (pk0[r] > thrq) ? 1 : 0; c += (pk1[r] > thrq) ? 1 : 0; }
            if (c) lds_add(&CNTN[l31], (unsigned)c);
        } else {
#pragma unroll
            for (int r = 0; r < 16; ++r) { pk0[r] = 0u; pk1[r] = 0u; }
        }
        if (p.dry == 2) continue;
        IX_BAR();
#pragma unroll 1
        for (int qq = wv; qq < 32; qq += 8) {
            const int n = (int)CNT[qq], nn = (int)CNTN[qq];
            if (n + nn > IXCAP && p.dry < 3) { int kept; unsigned T = prune_bucket(LIST + qq * IXCAP, n, lane, HIST + 64 * wv, kept); if (PROBE_X == 1) T = prune_bucket(LIST + qq * IXCAP, kept, lane, HIST + 64 * wv, kept); if (lane == 0) { CNT[qq] = (unsigned)kept; THR[qq] = T; if (nn > IXCAP - IX_KEEP) *BIG = 1u; } }
            if (lane == 0) CNTN[qq] = 0u;
        }
        IX_BAR();
        const unsigned big = *BIG;
        if (active) ix_append(pk0, CNT, LIST, THR, l31, p.dry >= 3 ? p.dry : 0);
        if (big) {
            if (active) { const unsigned thrq = THR[l31]; unsigned c = 0;
#pragma unroll
                for (int r = 0; r < 16; ++r) c += (pk1[r] > thrq) ? 1u : 0u;
                if (c) lds_add(&CNTN[l31], c); }
            IX_BAR();
#pragma unroll 1
            for (int qq = wv; qq < 32; qq += 8) {
                const int n = (int)CNT[qq], nn = (int)CNTN[qq];
                if (n + nn > IXCAP && p.dry < 3) { int kept; const unsigned T = prune_bucket(LIST + qq * IXCAP, n, lane, HIST + 64 * wv, kept); if (lane == 0) { CNT[qq] = (unsigned)kept; THR[qq] = T; } }
                if (lane == 0) CNTN[qq] = 0u;
            }
            if (tid == 0) *BIG = 0u;
            IX_BAR();
        }
        if (active) ix_append(pk1, CNT, LIST, THR, l31, p.dry >= 3 ? p.dry : 0);
    }
#undef IX_LDA
    __syncthreads();
    if (p.dry >= 2) return;
    if (p.dry == 1 && PROBE_DRY6 == 1 && (PROBE_MASK & 0x100000u)) return;
#pragma unroll 1
    for (int qq = wv; qq < 32; qq += 8) { const int n = (int)CNT[qq]; if (n > 256) { int kept; (void)prune256(LIST + qq * IXCAP, n, lane, true, kept); } }
    unsigned* MR = (unsigned*)(base + IX_QP);
    for (int e = tid; e < 32 * 256; e += NT) MR[e] = 0u;
    __syncthreads();
#pragma unroll 1
    for (int qq = wv; qq < 32; qq += 8) {
#pragma unroll
        for (int j = 0; j < 4; ++j) { const unsigned idx = LIST[qq * IXCAP + lane + 64 * j] & 0x1FFFu; lds_or(&MR[qq * 256 + (idx >> 5)], 1u << (idx & 31u)); }
    }
    __syncthreads();
    for (int e = tid; e < 32 * nw; e += NT) { const int qy = e / nw, w = e % nw; p.MASK[(t0 + qy) * 256 + w] = MR[qy * 256 + w]; }
}
DEVI void ph_indexer(const P& p, float* lds) {
    for (int w = BIDX; w < 256; w += GDIMX) {
        const int b = w >> 6, j = w & 63;
#pragma unroll 1
        for (int ui = 0; ui < 4; ++ui) {
            const int blk = (ui == 0) ? j : (ui == 1) ? 127 - j : (ui == 2) ? 128 + j : 255 - j;
            index_unit(p, b, blk * 32, lds);
        }
    }
}
DEVI float gain_bound(const float* gq, const float* gk) {
    float a = 0.f, b = 0.f;
    for (int i = 0; i < 128; ++i) { a = fmaxf(a, fabsf(gq[i])); b = fmaxf(b, fabsf(gk[i])); }
    return -(16.33f * a * b + 0.25f);
}
DEVI void attn_unit(const bf16_t* Qp, int ldq, const bf16_t* Kb, const bf16_t* VTb, const unsigned* maskp, bf16_t* Op, int ldo, int nt, int wave_nt, float negB, float* lds) {
    char* base = (char*)lds;
    const int tid = tidx(), lane = tid & 63, wv = tid >> 6, l31 = lane & 31, h = lane >> 5;
    bf16x8 qf[8];
    { const bf16_t* qr = Qp + (long)(32 * wv + l31) * ldq + 8 * h;
#pragma unroll
      for (int ks = 0; ks < 8; ++ks) qf[ks] = *(const bf16x8*)(qr + 16 * ks); }
    const unsigned* mrow = maskp ? maskp + (long)(32 * wv + l31) * 256 : nullptr;
    const bf16_t* kdp[4]; const bf16_t* vdp[2];
#pragma unroll
    for (int i = 0; i < 4; ++i) { const int row = 16 * wv + 4 * i + (lane >> 4), ch = (lane & 15) ^ (row & 15); kdp[i] = Kb + (long)row * 512 + ch * 8; }
#pragma unroll
    for (int i = 0; i < 2; ++i) { const int row = 16 * wv + 8 * i + (lane >> 3), ch = (lane & 7) ^ ((row >> 1) & 7); vdp[i] = VTb + (long)row * 64 + ch * 8; }
    const int kdo = wv * 4096 + lane * 16, vdo = 32768 + wv * 2048 + lane * 16;
    const int kr = l31 * 256, kx = l31 & 15;
    f32x16 o0, o1, o2, o3;
#pragma unroll
    for (int r = 0; r < 16; ++r) { o0[r] = 0.f; o1[r] = 0.f; o2[r] = 0.f; o3[r] = 0.f; }
    float rsum = 0.f;
    const int ns = nt >> 1;
#define ATT_DMA(S, ST) { const long ko_ = (long)(S) * 128 * 512, vo_ = (long)(S) * 2 * 512 * 64; \
        GLDS16(kdp[0] + ko_, base + (ST) + kdo); GLDS16(kdp[1] + ko_, base + (ST) + kdo + 1024); GLDS16(kdp[2] + ko_, base + (ST) + kdo + 2048); GLDS16(kdp[3] + ko_, base + (ST) + kdo + 3072); \
        GLDS16(vdp[0] + vo_, base + (ST) + vdo); GLDS16(vdp[1] + vo_, base + (ST) + vdo + 1024); \
        GLDS16(vdp[0] + vo_ + 512 * 64, base + (ST) + vdo + 16384); GLDS16(vdp[1] + vo_ + 512 * 64, base + (ST) + vdo + 16384 + 1024); }
    __syncthreads();
    ATT_DMA(0, 0)
    asm volatile("s_waitcnt vmcnt(0)\n\ts_barrier" ::: "memory");
    uint4 mwn = make_uint4(0xFFFFFFFFu, 0xFFFFFFFFu, 0xFFFFFFFFu, 0xFFFFFFFFu);
    if (mrow && wave_nt > 0) mwn = *(const uint4*)mrow;
#pragma unroll 1
    for (int sp = 0; sp < ns; ++sp) {
        const int st = (sp & 1) * 65536, sn = 65536 - st;
        const bool more = (sp + 1) < ns;
        const uint4 mw = mwn;
        if (mrow && 2 * (sp + 1) < wave_nt) mwn = *(const uint4*)(mrow + 4 * (sp + 1));
        if (more) ATT_DMA(sp + 1, sn)
#define ATT_BIAS(S, W) { _Pragma("unroll") for (int r = 0; r < 16; ++r) { const unsigned sel = (unsigned)__builtin_amdgcn_sbfe((int)(W), (r & 3) + 8 * (r >> 2), 1); \
                          S[r] = __uint_as_float((sel & __float_as_uint(negB)) | (~sel & 0xFF800000u)); } }
#define ATT_QK(S, KK, J) { _Pragma("unroll") for (int ks = 0; ks < 8; ++ks) { const bf16x8 kf = *(const bf16x8*)(base + st + (J) * 16384 + (KK) * 8192 + kr + (((2 * ks + h) ^ kx) << 4)); \
                          S = __builtin_amdgcn_mfma_f32_32x32x16_bf16(kf, qf[ks], S, 0, 0, 0); } }
#define ATT_PV(S, KK, J) { float ps[16]; _Pragma("unroll") for (int r = 0; r < 16; ++r) { ps[r] = __builtin_amdgcn_exp2f(S[r]); rsum += ps[r]; } \
                        _Pragma("unroll") for (int s_ = 0; s_ < 2; ++s_) { union { bf16x8 v; uint32_t u[4]; } pf; \
                            _Pragma("unroll") for (int e = 0; e < 4; ++e) pf.u[e] = pack2(ps[8 * s_ + 2 * e], ps[8 * s_ + 2 * e + 1]); \
                            const int vo = st + 32768 + (J) * 16384 + l31 * 128 + ((((2 * (2 * (KK) + s_) + h)) ^ ((l31 >> 1) & 7)) << 4); \
                            o0 = __builtin_amdgcn_mfma_f32_32x32x16_bf16(*(const bf16x8*)(base + vo), pf.v, o0, 0, 0, 0); \
                            o1 = __builtin_amdgcn_mfma_f32_32x32x16_bf16(*(const bf16x8*)(base + vo + 4096), pf.v, o1, 0, 0, 0); \
                            o2 = __builtin_amdgcn_mfma_f32_32x32x16_bf16(*(const bf16x8*)(base + vo + 8192), pf.v, o2, 0, 0, 0); \
                            o3 = __builtin_amdgcn_mfma_f32_32x32x16_bf16(*(const bf16x8*)(base + vo + 12288), pf.v, o3, 0, 0, 0); } }
#define ATT_SUB(J, W0, W1) if (2 * sp + (J) < wave_nt) { f32x16 sa, sb; \
            ATT_BIAS(sa, (W0) >> (4 * h)) ATT_BIAS(sb, (W1) >> (4 * h)) \
            __builtin_amdgcn_s_setprio(1); ATT_QK(sa, 0, J) ATT_QK(sb, 1, J) __builtin_amdgcn_s_setprio(0); \
            __builtin_amdgcn_sched_barrier(0); ATT_PV(sa, 0, J) __builtin_amdgcn_sched_barrier(0); ATT_PV(sb, 1, J) }
        ATT_SUB(0, mw.x, mw.y)
        ATT_SUB(1, mw.z, mw.w)
#undef ATT_SUB
#undef ATT_BIAS
#undef ATT_QK
#undef ATT_PV
        asm volatile("s_waitcnt vmcnt(0) lgkmcnt(0)\n\ts_barrier" ::: "memory");
    }
#undef ATT_DMA
    rsum += __int_as_float(__builtin_amdgcn_ds_bpermute((lane ^ 32) << 2, __float_as_int(rsum)));
    const float inv = 1.0f / rsum;
    bf16_t* orow = Op + (long)(32 * wv + l31) * ldo + 4 * h;
#pragma unroll
    for (int g = 0; g < 4; ++g) {
        *(uint2*)(orow + 8 * g)      = make_uint2(pack2(o0[4 * g] * inv, o0[4 * g + 1] * inv), pack2(o0[4 * g + 2] * inv, o0[4 * g + 3] * inv));
        *(uint2*)(orow + 32 + 8 * g) = make_uint2(pack2(o1[4 * g] * inv, o1[4 * g + 1] * inv), pack2(o1[4 * g + 2] * inv, o1[4 * g + 3] * inv));
        *(uint2*)(orow + 64 + 8 * g) = make_uint2(pack2(o2[4 * g] * inv, o2[4 * g + 1] * inv), pack2(o2[4 * g + 2] * inv, o2[4 * g + 3] * inv));
        *(uint2*)(orow + 96 + 8 * g) = make_uint2(pack2(o3[4 * g] * inv, o3[4 * g + 1] * inv), pack2(o3[4 * g + 2] * inv, o3[4 * g + 3] * inv));
    }
}
DEVI void ph_dsa_attn(const P& p, int l, float* lds) {
    const float negB = gain_bound(p.b_qnorm + l * 128, p.b_knorm + l * 128);
    const int wv = tidx() >> 6;
    for (int w = BIDX; w < 256; w += GDIMX) {
        const int combo = w & 15, b = combo >> 2, head = combo & 3, pr = w >> 4;
#pragma unroll 1
        for (int side = 0; side < 2; ++side) {
            const int qb = side ? 31 - pr : pr; const long t0 = (long)b * SEQ + qb * 256;
            attn_unit(p.QB + t0 * 512 + head * 128, 512, p.KB + (long)b * SEQ * 512 + head * 128, p.VT + ((long)b * 128 * 512 + head * 128) * 64, p.MASK + t0 * 256,
                      p.H + t0 * 1024 + 512 + head * 128, 1024, 4 * qb + 4, 4 * qb + (wv >> 1) + 1, negB, lds);
        }
    }
}
DEVI void ph_xattn(const P& p, int l, float* lds) {
    const float negB = gain_bound(p.x_qnorm + l * 128, p.x_knorm + l * 128);
    for (int u = BIDX; u < 512; u += GDIMX) {
        const int combo = u & 15, b = combo >> 2, head = combo & 3, qb = u >> 4; const long t0 = (long)b * SEQ + qb * 256;
        attn_unit(p.QX + t0 * 512 + head * 128, 512, p.XK + ((long)(l * 4 + b) * 256) * 512 + head * 128, p.XVT + ((long)(l * 4 + b) * 4 * 512 + head * 128) * 64, nullptr,
                  p.OX + t0 * 512 + head * 128, 512, 4, 4, negB, lds);
    }
}

DEVI void resid_epi_unit(const float* rsrc, float* dst, const tile_t* T, int m0, int tn_base) {
    const int row = tidx() >> 2, q = tidx() & 3;
    float4 cur[8], nxt[8];
    { const float* rp = rsrc + (long)(m0 + row) * DM + tn_base * 128 + 4 * q;
#pragma unroll
      for (int j = 0; j < 8; ++j) cur[j] = *(const float4*)(rp + 16 * j); }
#pragma unroll
    for (int sub = 0; sub < 4; ++sub) {
        if (sub < 3) { const int ns = sub + 1; const float* np = rsrc + (long)(m0 + 128 * (ns >> 1) + row) * DM + (tn_base + (ns & 1)) * 128 + 4 * q;
#pragma unroll
            for (int j = 0; j < 8; ++j) nxt[j] = *(const float4*)(np + 16 * j); }
        const tile_t* Ts = T + (sub >> 1) * 128 * TLD + 128 * (sub & 1);
        float* op = dst + (long)(m0 + 128 * (sub >> 1) + row) * DM + (tn_base + (sub & 1)) * 128 + 4 * q;
#pragma unroll
        for (int j = 0; j < 8; ++j) { const float4 t = t_ld4(Ts, row * TLD + 16 * j + 4 * q); float4 o = cur[j];
            o.x += t.x; o.y += t.y; o.z += t.z; o.w += t.w; *(float4*)(op + 16 * j) = o; }
#pragma unroll
        for (int j = 0; j < 8; ++j) cur[j] = nxt[j];
    }
}
DEVI void ph_outproj(const P& p, int l, float* lds) {
    for (int i = 0;; ++i) {
        int tm, tn2, tn; if (!xcd_unit(i, 4, tm, tn2)) break;
        ATile at{p.H, DM, nullptr, NTOK};
        gemm_unit8(at, tm * 256, p.WOUT + ((long)l * DM + tn2 * 256) * DM, DM, lds, [&](const tile_t* T, int mr0) __attribute__((always_inline)) NOPK {
            resid_epi_unit((l == 0) ? p.x : p.out, p.out, T, mr0, tn);
        }, tn, 2 * tn2, 0, true);
    }
}
DEVI void ph_xq(const P& p, int l, float* lds) {
    for (int i = 0;; ++i) {
        int tm, tn2, tn; if (!xcd_unit(i, 2, tm, tn2)) break;
        ATile at{p.H, DM, nullptr, NTOK};
        gemm_unit8(at, tm * 256, p.XWQ + ((long)l * 512 + tn2 * 256) * DM, DM, lds, [&](const tile_t* T, int mr0) __attribute__((always_inline)) NOPK {
            float v[8][4]; epi_load(T, v);
            norm_rope128(v, p.x_qnorm + l * 128, 0.f, QSCALE, false);
            epi_store_bf16(v, p.QX + (long)(mr0 + (tidx() >> 2)) * 512 + tn * 128);
        }, tn, 2 * tn2);
    }
}
DEVI void ph_xo(const P& p, int l, float* lds) {
    for (int i = 0;; ++i) {
        int tm, tn2, tn; if (!xcd_unit(i, 4, tm, tn2)) break;
        ATile at{p.OX, 512, nullptr, NTOK};
        gemm_unit8(at, tm * 256, p.XWO + ((long)l * DM + tn2 * 256) * 512, 512, lds, [&](const tile_t* T, int mr0) __attribute__((always_inline)) NOPK {
            resid_epi_unit(p.out, p.out, T, mr0, tn);
        }, tn, 2 * tn2, 0, true);
    }
}
DEVI bool moe_unit(const int* cnt, int u, int tilesN, int& e, int& tm, int& tn, int& base) {
    int acc = 0, rb = 0;
    for (int i = 0; i < 16; ++i) { const int tiles = (cnt[i] + 255) >> 8; if (u < acc + tiles * tilesN) { e = i; const int r = u - acc; tm = r / tilesN; tn = r % tilesN; base = rb; return true; } acc += tiles * tilesN; rb += tiles * 256; }
    return false;
}
DEVI void ph_moe_gu(const P& p, int l, float* lds) {
    const int* cnt = p.CNT + l * 16;
    for (int u = BIDX;; u += GDIMX) {
        int e, tm, tn2, tn, base; if (!moe_unit(cnt, u, 2, e, tm, tn2, base)) break;
        const int ce = cnt[e];
        ATile at{p.H, DM, p.LTOK + (long)e * NTOK, ce};
        gemm_unit8(at, tm * 256, p.WGU + (((long)l * 16 + e) * 512 + tn2 * 256) * DM, DM, lds, [&](const tile_t* T, int mr0) __attribute__((always_inline)) NOPK {
            const int row = tidx() >> 2, q = tidx() & 3, r = mr0 + row;
            const float gate = (r < ce) ? p.LGATE[(long)e * NTOK + r] : 0.f;
            bf16_t* op = p.ACT + (long)(base + r) * 256 + tn * 64;
#pragma unroll
            for (int j = 0; j < 4; ++j) { const float4 g = t_ld4(T, row * TLD + 16 * j + 4 * q), uu = t_ld4(T, row * TLD + 64 + 16 * j + 4 * q);
                *(uint2*)(op + 16 * j + 4 * q) = make_uint2(pack2(siluf(g.x) * uu.x * gate, siluf(g.y) * uu.y * gate), pack2(siluf(g.z) * uu.z * gate, siluf(g.w) * uu.w * gate)); }
        }, tn, 2 * tn2);
    }
}
DEVI void ph_moe_dn(const P& p, int l, float* lds) {
    const int* cnt = p.CNT + l * 16;
    for (int u = BIDX;; u += GDIMX) {
        int e, tm, tn2, tn, base; if (!moe_unit(cnt, u, 4, e, tm, tn2, base)) break;
        const int ce = cnt[e];
        ATile at{p.ACT + (long)base * 256, 256, nullptr, ((ce + 255) >> 8) * 256};
        gemm_unit8(at, tm * 256, p.WDN + (((long)l * 16 + e) * DM + tn2 * 256) * 256, 256, lds, [&](const tile_t* T, int mr0) __attribute__((always_inline)) NOPK {
            const int row = tidx() >> 2, q = tidx() & 3, r = mr0 + row;
            if (r < ce) { bf16_t* op = p.Y + (long)p.LSLOT[(long)e * NTOK + r] * DM + tn * 128;
#pragma unroll
                for (int j = 0; j < 8; ++j) { const float4 t = t_ld4(T, row * TLD + 16 * j + 4 * q);
                    *(uint2*)(op + 16 * j + 4 * q) = make_uint2(pack2(t.x, t.y), pack2(t.z, t.w)); } }
        }, tn, 2 * tn2);
    }
}

DEVI void ph_final(const P& p) {
    const long gt = (long)BIDX * NT + tidx(), gs = (long)GDIMX * NT;
    for (long i = gt; i < (long)NTOK * DM / 4; i += gs) {
        const long row = i >> 8; const int c4 = (int)(i & 255);
        float4 v = ((const float4*)p.out)[i];
        const uint2 a = ((const uint2*)(p.Y + (2 * row) * DM))[c4], b = ((const uint2*)(p.Y + (2 * row + 1) * DM))[c4];
        v.x = (v.x + bflo(a.x)) + bflo(b.x); v.y = (v.y + bfhi(a.x)) + bfhi(b.x); v.z = (v.z + bflo(a.y)) + bflo(b.y); v.w = (v.w + bfhi(a.y)) + bfhi(b.y);
        ((float4*)p.out)[i] = v;
    }
}
constexpr int NPH_PRO = 2, NPH_LAYER = 15;
#ifndef PHSEL
#define PHSEL 0xFFFFFFFFu
#endif
template <int PH> DEVI void run_phase(int l, float* lds, int dry = 0) {
    if (PH < 32 && !((PHSEL >> PH) & 1u)) return;
    asm volatile("; PHASE_BEGIN %0" :: "n"(PH));
    P p = make_P(kargs()); p.dry = dry; if (dry && (PH == 8 || PH == 12)) p.out = p.out_dry;
    if (PH == 100) ph_pro_a(p, lds);
    if (PH == 101) ph_pro_b(p, lds);
    if (PH == 0) { if (l == 0) ph_norm<false, false, true>(p, p.norm_mix + l * DM, l); else if (p.dry) ph_norm<false, false>(p, p.norm_mix + l * DM, l); else ph_norm<false, true>(p, p.norm_mix + l * DM, l); }
    if (PH == 16) ph_final(p);
    if (PH == 1) ph_inproj(p, l, lds);
    if (PH == 2) ph_h1(p, l, lds);
    if (PH == 3) ph_h2(p);
    if (PH == 4) ph_h3(p, l, lds);
    if (PH == 5) ph_qproj(p, l, lds);
    if (PH == 6) ph_indexer(p, lds);
    if (PH == 7) ph_dsa_attn(p, l, lds);
    if (PH == 8) ph_outproj(p, l, lds);
    if (PH == 9) ph_norm<false>(p, p.norm_x + l * DM, l);
    if (PH == 10) ph_xq(p, l, lds);
    if (PH == 11) ph_xattn(p, l, lds);
    if (PH == 12) ph_xo(p, l, lds);
    if (PH == 13) ph_norm<true>(p, p.norm_ffn + l * DM, l);
    if (PH == 14) ph_moe_gu(p, l, lds);
    if (PH == 15) ph_moe_dn(p, l, lds);
}

DEVI void grid_sync(float* lds) {
    XcdBarrier b; b.bar = (unsigned*)(kargs()->ws + WS_BAR); b.x = xb_xcc_id(); b.st = (volatile LAS unsigned*)(lds + (LDS_BYTES / 4) - 4);
    xcd_barrier(b);
}
#if MK_LAUNCHES == 0
template <int PH> __global__ void NOPK __launch_bounds__(NT, 2) k_phase(KArgs a, int l) {
    extern __shared__ __attribute__((aligned(16))) float lds[];
    (void)a;
    run_phase<PH>(l, lds);
}
#else

__global__ void NOPK __launch_bounds__(NT, 2) k_mega(KArgs a) {
    extern __shared__ __attribute__((aligned(16))) float lds[];
    (void)a;
    uint4* xbw = (uint4*)(lds + (LDS_BYTES / 4) - 4);
    if (tidx() == 0) *xbw = make_uint4(0u, 0u, 0u, 0u);
    __syncthreads();
    (void)xcd_barrier_post((unsigned*)(kargs()->ws + WS_BAR), (volatile LAS unsigned*)xbw);
    run_phase<100>(0, lds); grid_sync(lds); if (PROBE_MASK & (1u << 16)) { run_phase<100>(0, lds, 0); grid_sync(lds); }
    run_phase<101>(0, lds); if (PROBE_MASK & (1u << 17)) { grid_sync(lds); run_phase<101>(0, lds, 0); }
    for (int l = 0; l < 2; ++l) {
        run_phase<0>(l, lds); grid_sync(lds); if (PROBE_MASK & (1u << 0)) { run_phase<0>(l, lds, 1); grid_sync(lds); }
        run_phase<1>(l, lds); grid_sync(lds); if (PROBE_MASK & (1u << 1)) { run_phase<1>(l, lds, PROBE_DRY6); grid_sync(lds); }
        run_phase<2>(l, lds); grid_sync(lds); if (PROBE_MASK & (1u << 2)) { run_phase<2>(l, lds, 1); grid_sync(lds); }
        run_phase<3>(l, lds); grid_sync(lds); if (PROBE_MASK & (1u << 3)) { run_phase<3>(l, lds, 1); grid_sync(lds); }
        run_phase<4>(l, lds); grid_sync(lds); if (PROBE_MASK & (1u << 4)) { run_phase<4>(l, lds, 1); grid_sync(lds); }
        run_phase<5>(l, lds); grid_sync(lds); if (PROBE_MASK & (1u << 5)) { run_phase<5>(l, lds, 1); grid_sync(lds); }
        run_phase<6>(l, lds); grid_sync(lds); if (PROBE_MASK & (1u << 6)) { run_phase<6>(l, lds, PROBE_DRY6); grid_sync(lds); }
        run_phase<7>(l, lds); grid_sync(lds); if (PROBE_MASK & (1u << 7)) { run_phase<7>(l, lds, 1); grid_sync(lds); }
        run_phase<8>(l, lds); grid_sync(lds); if (PROBE_MASK & (1u << 8)) { run_phase<8>(l, lds, 1); grid_sync(lds); }
        run_phase<9>(l, lds); grid_sync(lds); if (PROBE_MASK & (1u << 9)) { run_phase<9>(l, lds, 1); grid_sync(lds); }
        run_phase<10>(l, lds); grid_sync(lds); if (PROBE_MASK & (1u << 10)) { run_phase<10>(l, lds, 1); grid_sync(lds); }
        run_phase<11>(l, lds); grid_sync(lds); if (PROBE_MASK & (1u << 11)) { run_phase<11>(l, lds, 1); grid_sync(lds); }
        run_phase<12>(l, lds); grid_sync(lds); if (PROBE_MASK & (1u << 12)) { run_phase<12>(l, lds, 1); grid_sync(lds); }
        run_phase<13>(l, lds); grid_sync(lds); if (PROBE_MASK & (1u << 13)) { run_phase<13>(l, lds, 1); grid_sync(lds); }
        run_phase<14>(l, lds); grid_sync(lds); if (PROBE_MASK & (1u << 14)) { run_phase<14>(l, lds, 1); grid_sync(lds); }
        run_phase<15>(l, lds); grid_sync(lds); if (PROBE_MASK & (1u << 15)) { run_phase<15>(l, lds, 1); grid_sync(lds); }
    }
    run_phase<16>(1, lds);
}
#endif

template <int PH> static void launch_phase(const KArgs& p, int l, hipStream_t stream);

extern "C" void kernel_launch(void* const* d_in, const int* in_sizes, int n_in, void* d_out, int out_size, void* d_ws, size_t ws_size, hipStream_t stream) {
    (void)in_sizes; (void)out_size;
    if (n_in != 29) { fprintf(stderr, "kernel_launch: expected 29 inputs, got %d\n", n_in); return; }
    KArgs p; memset(&p, 0, sizeof(p));
    for (int i = 0; i < 29; ++i) p.in[i] = d_in[i];
    p.out = (float*)d_out; p.ws = (char*)d_ws;
    if (WS_END > ws_size) { fprintf(stderr, "kernel_launch: workspace too small: need %zu, have %zu\n", (size_t)WS_END, ws_size); return; }
    (void)hipMemsetAsync((char*)d_ws + WS_BAR, 0, XCD_BAR_WORDS * 4, stream);
#if MK_LAUNCHES == 0
    launch_phase<100>(p, 0, stream); launch_phase<101>(p, 0, stream);
    for (int l = 0; l < 2; ++l) {
        launch_phase<0>(p, l, stream); launch_phase<1>(p, l, stream); launch_phase<2>(p, l, stream); launch_phase<3>(p, l, stream);
        launch_phase<4>(p, l, stream); launch_phase<5>(p, l, stream); launch_phase<6>(p, l, stream); launch_phase<7>(p, l, stream);
        launch_phase<8>(p, l, stream); launch_phase<9>(p, l, stream); launch_phase<10>(p, l, stream); launch_phase<11>(p, l, stream);
        launch_phase<12>(p, l, stream); launch_phase<13>(p, l, stream); launch_phase<14>(p, l, stream); launch_phase<15>(p, l, stream);
    }
    launch_phase<16>(p, 1, stream);
#else
    static int grid = 0;
    if (grid == 0) {
        int dev = 0, cus = 0;
        if (hipGetDevice(&dev) != hipSuccess || hipDeviceGetAttribute(&cus, hipDeviceAttributeMultiprocessorCount, dev) != hipSuccess) { fprintf(stderr, "kernel_launch: device query failed\n"); grid = -1; return; }
        if (hipFuncSetAttribute((const void*)k_mega, hipFuncAttributeMaxDynamicSharedMemorySize, LDS_BYTES) != hipSuccess) { fprintf(stderr, "kernel_launch: hipFuncSetAttribute failed\n"); grid = -1; return; }
        int per_cu = 0;
        if (hipOccupancyMaxActiveBlocksPerMultiprocessor(&per_cu, (const void*)k_mega, NT, LDS_BYTES) != hipSuccess || per_cu < 1) { fprintf(stderr, "kernel_launch: occupancy query says %d blocks per CU\n", per_cu); (void)hipGetLastError(); }
        grid = cus;
    }
    if (grid < 0) return;
    hipLaunchKernelGGL(k_mega, dim3(grid), dim3(NT), LDS_BYTES, stream, p);
#endif
}
#if MK_LAUNCHES == 0
template <int PH> static void launch_phase(const KArgs& p, int l, hipStream_t stream) {
    static bool once = false;
    if (!once) { (void)hipFuncSetAttribute((const void*)k_phase<PH>, hipFuncAttributeMaxDynamicSharedMemorySize, LDS_BYTES); once = true; }
    hipLaunchKernelGGL(k_phase<PH>, dim3(256), dim3(NT), LDS_BYTES, stream, p, l);
}
#endif
#if defined(__HIP_DEVICE_COMPILE__)
#pragma clang attribute pop
#endif
```

```cpp
#if defined(__HIP_DEVICE_COMPILE__)
#pragma clang attribute push(__attribute__((target("no-packed-fp32-ops"))), apply_to = function)
#endif
#include <hip/hip_runtime.h>
#define TIDX __builtin_amdgcn_workitem_id_x()
#define BIDX __builtin_amdgcn_workgroup_id_x()
#define GDIMX (__builtin_amdgcn_grid_size_x() / 512u)
#include <stdint.h>
#include <stdio.h>
#include <string.h>

#ifndef PROBE_MASK
#define PROBE_MASK 0u
#endif
#ifndef PROBE_DRY6
#define PROBE_DRY6 1
#endif
#ifndef PROBE_X
#define PROBE_X 0
#endif
#ifndef MK_LAUNCHES
#define MK_LAUNCHES 1
#endif

typedef unsigned short bf16_t;
typedef unsigned short tile_t_fwd;
#define NOPK
#define DEVI __device__ __forceinline__ NOPK
#define LAS __attribute__((address_space(3)))

constexpr int NB = 4, SEQ = 8192, NTOK = NB * SEQ, DM = 1024, DIN = 3408;
constexpr int NT = 512;
constexpr int LDS_BYTES = 153600;
constexpr float EPS = 1e-6f;
constexpr float QSCALE = 0.08838834764831845f * 1.4426950408889634f;
constexpr int TLD = 264;

struct P {
    const float *x, *mem; const int* pos;
    const float *norm_mix, *w_in, *lb_raw, *a_gnorm, *b_qlat_gain, *b_wqb, *b_wqidx, *b_qnorm, *b_knorm, *b_kidx_norm,
                *w_out, *norm_x, *norm_mem, *x_wq, *x_wk, *x_wv, *x_wo, *x_qnorm, *x_knorm, *norm_ffn, *w_rg, *b_rg, *w_re, *b_re, *w_gu, *w_dn;
    float* out;
    bf16_t *H, *QA, *VAT, *GA, *UT, *QL, *KB, *VT, *KIDX, *QB, *QIDX, *QX, *OX, *ACT, *XK, *XVT, *MEMN;
    bf16_t* ZF; float *WIDX, *DEC, *COS128, *SIN128, *COS64, *SIN64, *LB, *LGATE;
    unsigned* MASK; int *LTOK, *CNT; unsigned* bar;
    bf16_t *WIN, *WQ, *WOUT, *XWQ, *XWO, *WGU, *WDN, *XWK, *XWV;
    bf16_t* Y; int* LSLOT;
    float* out_dry; int dry;
};


constexpr size_t MiB = 1u << 20;
constexpr size_t WS_BAR = 0, WS_CNT = 16 * 1024, WS_LB = 20 * 1024, WS_DEC = 1 * MiB, WS_COS128 = 2 * MiB, WS_SIN128 = 10 * MiB, WS_COS64 = 18 * MiB, WS_SIN64 = 22 * MiB,
                 WS_XK = 26 * MiB, WS_XVT = 28 * MiB, WS_H = 30 * MiB, WS_QL = 94 * MiB, WS_KB = 110 * MiB, WS_VT = 142 * MiB, WS_KIDX = 174 * MiB, WS_WIDX = 178 * MiB,
                 WS_R1 = 180 * MiB, WS_WIN = 436 * MiB, WS_WQ = WS_WIN + 14 * MiB, WS_WOUT = WS_WQ + 1 * MiB + 512 * 1024, WS_XWQ = WS_WOUT + 4 * MiB,
                 WS_XWO = WS_XWQ + 2 * MiB, WS_WGU = WS_XWO + 2 * MiB, WS_WDN = WS_WGU + 32 * MiB, WS_END = WS_WDN + 16 * MiB;
static_assert(WS_END <= 512 * MiB, "workspace map exceeds the guaranteed 512 MiB");
struct KArgs { const void* in[29]; float* out; char* ws; };
typedef const __attribute__((address_space(4))) KArgs* KArgsPtr;
DEVI KArgsPtr kargs() { KArgsPtr k = (KArgsPtr)__builtin_amdgcn_kernarg_segment_ptr(); asm volatile("" : "+s"(k)); return k; }
DEVI P make_P(KArgsPtr ap) {
    P p;
    p.x = (const float*)ap->in[0]; p.mem = (const float*)ap->in[1]; p.pos = (const int*)ap->in[2];
    p.norm_mix = (const float*)ap->in[3]; p.w_in = (const float*)ap->in[4]; p.lb_raw = (const float*)ap->in[5]; p.a_gnorm = (const float*)ap->in[6]; p.b_qlat_gain = (const float*)ap->in[7];
    p.b_wqb = (const float*)ap->in[8]; p.b_wqidx = (const float*)ap->in[9]; p.b_qnorm = (const float*)ap->in[10]; p.b_knorm = (const float*)ap->in[11]; p.b_kidx_norm = (const float*)ap->in[12];
    p.w_out = (const float*)ap->in[13]; p.norm_x = (const float*)ap->in[14]; p.norm_mem = (const float*)ap->in[15]; p.x_wq = (const float*)ap->in[16]; p.x_wk = (const float*)ap->in[17];
    p.x_wv = (const float*)ap->in[18]; p.x_wo = (const float*)ap->in[19]; p.x_qnorm = (const float*)ap->in[20]; p.x_knorm = (const float*)ap->in[21]; p.norm_ffn = (const float*)ap->in[22];
    p.w_rg = (const float*)ap->in[23]; p.b_rg = (const float*)ap->in[24]; p.w_re = (const float*)ap->in[25]; p.b_re = (const float*)ap->in[26]; p.w_gu = (const float*)ap->in[27]; p.w_dn = (const float*)ap->in[28];
    p.out = ap->out; char* ws = ap->ws;
    p.bar = (unsigned*)(ws + WS_BAR); p.CNT = (int*)(ws + WS_CNT); p.LB = (float*)(ws + WS_LB); p.DEC = (float*)(ws + WS_DEC);
    p.COS128 = (float*)(ws + WS_COS128); p.SIN128 = (float*)(ws + WS_SIN128); p.COS64 = (float*)(ws + WS_COS64); p.SIN64 = (float*)(ws + WS_SIN64);
    p.XK = (bf16_t*)(ws + WS_XK); p.XVT = (bf16_t*)(ws + WS_XVT); p.H = (bf16_t*)(ws + WS_H);
    p.QL = (bf16_t*)(ws + WS_QL); p.KB = (bf16_t*)(ws + WS_KB); p.VT = (bf16_t*)(ws + WS_VT); p.KIDX = (bf16_t*)(ws + WS_KIDX); p.WIDX = (float*)(ws + WS_WIDX);
    char* r1 = ws + WS_R1;
    p.QA = (bf16_t*)(r1); p.ZF = (bf16_t*)(r1 + 32 * MiB); p.VAT = (bf16_t*)(r1 + 128 * MiB); p.GA = (bf16_t*)(r1 + 160 * MiB); p.UT = (bf16_t*)(r1 + 192 * MiB);
    p.QB = (bf16_t*)(r1); p.QIDX = (bf16_t*)(r1 + 32 * MiB); p.MASK = (unsigned*)(r1 + 96 * MiB);
    p.QX = (bf16_t*)(r1); p.OX = (bf16_t*)(r1 + 32 * MiB); p.ACT = (bf16_t*)(r1 + 64 * MiB); p.LTOK = (int*)(r1 + 100 * MiB); p.LGATE = (float*)(r1 + 104 * MiB);
    p.MEMN = (bf16_t*)(r1 + 128 * MiB); p.XWK = (bf16_t*)(r1 + 132 * MiB); p.XWV = (bf16_t*)(r1 + 134 * MiB);
    p.WIN = (bf16_t*)(ws + WS_WIN); p.WQ = (bf16_t*)(ws + WS_WQ); p.WOUT = (bf16_t*)(ws + WS_WOUT); p.XWQ = (bf16_t*)(ws + WS_XWQ); p.XWO = (bf16_t*)(ws + WS_XWO);
    p.WGU = (bf16_t*)(ws + WS_WGU); p.WDN = (bf16_t*)(ws + WS_WDN);
    p.Y = (bf16_t*)(r1 + 128 * MiB); p.LSLOT = (int*)(r1 + 108 * MiB);
    p.out_dry = (float*)(r1 + 128 * MiB); p.dry = 0;
    return p;
}

DEVI int tidx() { int t = (int)TIDX; asm volatile("" : "+v"(t)); return t; }
DEVI float bf2f(bf16_t v) { return __uint_as_float((uint32_t)v << 16); }
DEVI bf16_t f2bf(float f) { uint32_t u = __float_as_uint(f); u += 0x7FFFu + ((u >> 16) & 1u); return (bf16_t)(u >> 16); }
typedef __bf16 hbf16x2 __attribute__((ext_vector_type(2)));
typedef float hf32x2 __attribute__((ext_vector_type(2)));
DEVI uint32_t pack2(float a, float b) { const hf32x2 f = {a, b}; return __builtin_bit_cast(uint32_t, __builtin_convertvector(f, hbf16x2)); }
DEVI float bflo(uint32_t u) { return __uint_as_float(u << 16); }
DEVI float bfhi(uint32_t u) { return __uint_as_float(u & 0xFFFF0000u); }
#define DPP_F(old_, v_, ctrl, rm) __int_as_float(__builtin_amdgcn_update_dpp(__float_as_int(old_), __float_as_int(v_), ctrl, rm, 0xF, false))
#define DPP_I(old_, v_, ctrl, rm) __builtin_amdgcn_update_dpp(old_, v_, ctrl, rm, 0xF, false)
DEVI float wsum(float v) {
    v += DPP_F(0.f, v, 0xB1, 0xF); v += DPP_F(0.f, v, 0x4E, 0xF); v += DPP_F(0.f, v, 0x141, 0xF); v += DPP_F(0.f, v, 0x140, 0xF);
    v += DPP_F(0.f, v, 0x142, 0xA); v += DPP_F(0.f, v, 0x143, 0xC);
    return __int_as_float(__builtin_amdgcn_readlane(__float_as_int(v), 63));
}
DEVI float wmax(float v) {
    v = fmaxf(v, DPP_F(v, v, 0xB1, 0xF)); v = fmaxf(v, DPP_F(v, v, 0x4E, 0xF)); v = fmaxf(v, DPP_F(v, v, 0x141, 0xF)); v = fmaxf(v, DPP_F(v, v, 0x140, 0xF));
    v = fmaxf(v, DPP_F(v, v, 0x142, 0xA)); v = fmaxf(v, DPP_F(v, v, 0x143, 0xC));
    return __int_as_float(__builtin_amdgcn_readlane(__float_as_int(v), 63));
}
DEVI int wsumi(int v) {
    v += DPP_I(0, v, 0xB1, 0xF); v += DPP_I(0, v, 0x4E, 0xF); v += DPP_I(0, v, 0x141, 0xF); v += DPP_I(0, v, 0x140, 0xF);
    v += DPP_I(0, v, 0x142, 0xA); v += DPP_I(0, v, 0x143, 0xC);
    return __builtin_amdgcn_readlane(v, 63);
}
DEVI int wscan_incl(int v) {
    v += DPP_I(0, v, 0x111, 0xF); v += DPP_I(0, v, 0x112, 0xF); v += DPP_I(0, v, 0x114, 0xF); v += DPP_I(0, v, 0x118, 0xF);
    v += DPP_I(0, v, 0x142, 0xA); v += DPP_I(0, v, 0x143, 0xC);
    return v;
}
DEVI float quad_sum(float s) { s += DPP_F(0.f, s, 0xB1, 0xF); s += DPP_F(0.f, s, 0x4E, 0xF); return s; }
DEVI float oct_sum(float s) { s = quad_sum(s); s += DPP_F(0.f, s, 0x141, 0xF); return s; }
DEVI float siluf(float v) { return v / (1.0f + __expf(-v)); }
DEVI int kperm(int k) { return (k & ~12) | ((k & 4) << 1) | ((k & 8) >> 1); }
DEVI long vt_index(long r, int col) { return ((r >> 6) * 512 + col) * 64 + kperm((int)(r & 63)); }
DEVI unsigned ordf(float f) { unsigned u = __float_as_uint(f); return (u & 0x80000000u) ? ~u : (u | 0x80000000u); }

#define XB_TMO      128
#define XB_XCNT(j)  (256  + 64 * (j))
#define XB_XSUB(j)  (1280 + 64 * (j))
#define XB_XGEN(j)  (2304 + 64 * (j))
#define XB_TOP      3328
#define XB_TOPGEN   3392
#define XCD_BAR_WORDS 3456
#define XB_SPIN_CAP (1u << 27)
DEVI unsigned xb_ld(unsigned* p)              { return __hip_atomic_load(p, __ATOMIC_RELAXED, __HIP_MEMORY_SCOPE_AGENT); }
DEVI unsigned xb_add(unsigned* p, unsigned v) { return __hip_atomic_fetch_add(p, v, __ATOMIC_RELAXED, __HIP_MEMORY_SCOPE_AGENT); }
DEVI unsigned xb_xcc_id() { return (unsigned)__builtin_amdgcn_s_getreg((3 << 11) | 20) & 0xFu; }
#define XB_SPIN(cond, bar) do { unsigned _sp = 0; while (cond) { __builtin_amdgcn_s_sleep(1); \
    if ((++_sp & 255u) == 0u) { if (xb_ld(&(bar)[XB_TMO])) break; if (_sp > XB_SPIN_CAP) { atomicAdd(&(bar)[XB_TMO], 1u); break; } } } } while (0)
struct XcdBarrier { unsigned* bar; unsigned x; volatile LAS unsigned* st; };
DEVI XcdBarrier xcd_barrier_post(unsigned* bar, volatile LAS unsigned* st) {
    XcdBarrier b; b.bar = bar; b.x = xb_xcc_id(); b.st = st;
    if (TIDX == 0) (void)xb_add(&bar[XB_XCNT(b.x)], 1u);
    return b;
}
DEVI void xcd_barrier_complete(unsigned* bar, unsigned x, unsigned& nloc, unsigned& nx) {
    const unsigned G = GDIMX;
    unsigned sum, cnt, mine, sp = 0u;
    for (;;) {
        sum = 0u; cnt = 0u; mine = 0u;
#pragma unroll
        for (unsigned j = 0; j < 16; ++j) { const unsigned c = xb_ld(&bar[XB_XCNT(j)]); sum += c; cnt += (c > 0u) ? 1u : 0u; mine = (j == x) ? c : mine; }
        if (sum == G) break;
        __builtin_amdgcn_s_sleep(1);
        if ((++sp & 255u) == 0u) { if (xb_ld(&bar[XB_TMO])) break; if (sp > XB_SPIN_CAP) { atomicAdd(&bar[XB_TMO], 1u); break; } }
    }
    nloc = mine > 0u ? mine : 1u; nx = cnt > 0u ? cnt : 1u;
}
DEVI void xcd_barrier(const XcdBarrier& b) {
    asm volatile("s_waitcnt vmcnt(0)" ::: "memory");
    __syncthreads();
    if (TIDX == 0) {
        unsigned* bar = b.bar;
        __builtin_amdgcn_s_waitcnt(0);
        unsigned nloc = b.st[0], nx = b.st[1];
        if (nloc == 0u) { xcd_barrier_complete(bar, b.x, nloc, nx); b.st[0] = nloc; b.st[1] = nx; }
        const unsigned old = xb_add(&bar[XB_XSUB(b.x)], 1u);
        const unsigned gen = old / nloc;
        if (old + 1u == (gen + 1u) * nloc) {
            __builtin_amdgcn_fence(__ATOMIC_RELEASE, "agent");
            asm volatile("s_waitcnt vmcnt(0)" ::: "memory");
            const unsigned og = xb_add(&bar[XB_TOP], 1u);
            const unsigned tg = og / nx;
            if (og + 1u == (tg + 1u) * nx) xb_add(&bar[XB_TOPGEN], 1u);
            else XB_SPIN(xb_ld(&bar[XB_TOPGEN]) == tg, bar);
            __builtin_amdgcn_fence(__ATOMIC_ACQUIRE, "agent");
            xb_add(&bar[XB_XGEN(b.x)], 1u);
            asm volatile("s_waitcnt vmcnt(0)" ::: "memory");
        } else {
            XB_SPIN(xb_ld(&bar[XB_XGEN(b.x)]) == gen, bar);
            __builtin_amdgcn_fence(__ATOMIC_ACQUIRE, "agent");
            asm volatile("s_waitcnt vmcnt(0)" ::: "memory");
        }
    }
    __syncthreads();
}

struct ATile { const bf16_t* a; int lda; const int* rowmap; int mvalid; };
typedef short bf16x8 __attribute__((ext_vector_type(8)));
typedef float f32x16 __attribute__((ext_vector_type(16)));
DEVI int swz(int row, int chunk) { return row * 128 + ((chunk ^ ((row >> 1) & 7)) << 4); }

#define GLDS16(gp, lp) __builtin_amdgcn_global_load_lds((const __attribute__((address_space(1))) unsigned*)(gp), (__attribute__((address_space(3))) unsigned*)(lp), 16, 0, 0)
DEVI int swz32(int row, int chunk) { return row * 64 + ((chunk ^ ((row >> 2) & 3)) << 4); }
template <class Epi>
DEVI void gemm_unit256(const ATile& at, int m0, const bf16_t* Bt, int K, float* lds, Epi&& epi, int& tn_ref, int tn_base, int skip_epi = 0, bool whole = false) {
    char* base = (char*)lds;
    const int tid = tidx(), lane = tid & 63, wv = tid >> 6, wm = wv >> 1, wn = wv & 1, l31 = lane & 31, h = lane >> 5;
    const bf16_t* ap[2]; const bf16_t* bp[2];
#pragma unroll
    for (int i = 0; i < 2; ++i) { const int row = 32 * wv + 16 * i + (lane >> 2), ch = (lane & 3) ^ ((row >> 2) & 3), grow = m0 + row;
        long srow = 0; if (grow < at.mvalid) srow = at.rowmap ? (long)at.rowmap[grow] : (long)grow;
        ap[i] = at.a + srow * at.lda + ch * 8; bp[i] = Bt + (long)row * K + ch * 8; }
    const int aoffw = wv * 2048 + lane * 16, boffw = 16384 + wv * 2048 + lane * 16;
    int ra[2], rb[2];
#pragma unroll
    for (int ks = 0; ks < 2; ++ks) { ra[ks] = swz32(wm * 64 + l31, 2 * ks + h); rb[ks] = 16384 + swz32(wn * 128 + l31, 2 * ks + h); }
    f32x16 c00, c01, c02, c03, c10, c11, c12, c13;
#pragma unroll
    for (int r = 0; r < 16; ++r) { c00[r] = 0.f; c01[r] = 0.f; c02[r] = 0.f; c03[r] = 0.f; c10[r] = 0.f; c11[r] = 0.f; c12[r] = 0.f; c13[r] = 0.f; }
    const int nk = K >> 5;
#define D_ISSUE(ST, KO) { GLDS16(ap[0] + (KO), base + (ST) + aoffw); GLDS16(ap[1] + (KO), base + (ST) + aoffw + 1024); \
                          GLDS16(bp[0] + (KO), base + (ST) + boffw); GLDS16(bp[1] + (KO), base + (ST) + boffw + 1024); }
    __syncthreads();
    D_ISSUE(0, 0) D_ISSUE(32768, 32) D_ISSUE(65536, 64)
    asm volatile("s_waitcnt vmcnt(8)\n\ts_barrier" ::: "memory");
#pragma unroll 1
    for (int k = 0; k < nk; ++k) {
        const int kn = (k + 3 < nk) ? (k + 3) * 32 : K - 32;
        const int s0 = (k & 3) * 32768, s3 = ((k + 3) & 3) * 32768;
        if (skip_epi < 3) D_ISSUE(s3, kn)
        const bf16x8 a0 = *(const bf16x8*)(base + s0 + ra[0]), a1 = *(const bf16x8*)(base + s0 + ra[0] + 2048);
        const bf16x8 b0 = *(const bf16x8*)(base + s0 + rb[0]), b1 = *(const bf16x8*)(base + s0 + rb[0] + 2048);
        const bf16x8 b2 = *(const bf16x8*)(base + s0 + rb[0] + 4096), b3 = *(const bf16x8*)(base + s0 + rb[0] + 6144);
        const bf16x8 e0 = *(const bf16x8*)(base + s0 + ra[1]), e1 = *(const bf16x8*)(base + s0 + ra[1] + 2048);
        const bf16x8 f0 = *(const bf16x8*)(base + s0 + rb[1]), f1 = *(const bf16x8*)(base + s0 + rb[1] + 2048);
        const bf16x8 f2 = *(const bf16x8*)(base + s0 + rb[1] + 4096), f3 = *(const bf16x8*)(base + s0 + rb[1] + 6144);
        __builtin_amdgcn_sched_barrier(0);
        __builtin_amdgcn_s_setprio(1);
        c00 = __builtin_amdgcn_mfma_f32_32x32x16_bf16(b0, a0, c00, 0, 0, 0); c01 = __builtin_amdgcn_mfma_f32_32x32x16_bf16(b1, a0, c01, 0, 0, 0);
        c02 = __builtin_amdgcn_mfma_f32_32x32x16_bf16(b2, a0, c02, 0, 0, 0); c03 = __builtin_amdgcn_mfma_f32_32x32x16_bf16(b3, a0, c03, 0, 0, 0);
        c10 = __builtin_amdgcn_mfma_f32_32x32x16_bf16(b0, a1, c10, 0, 0, 0); c11 = __builtin_amdgcn_mfma_f32_32x32x16_bf16(b1, a1, c11, 0, 0, 0);
        c12 = __builtin_amdgcn_mfma_f32_32x32x16_bf16(b2, a1, c12, 0, 0, 0); c13 = __builtin_amdgcn_mfma_f32_32x32x16_bf16(b3, a1, c13, 0, 0, 0);
        c00 = __builtin_amdgcn_mfma_f32_32x32x16_bf16(f0, e0, c00, 0, 0, 0); c01 = __builtin_amdgcn_mfma_f32_32x32x16_bf16(f1, e0, c01, 0, 0, 0);
        c02 = __builtin_amdgcn_mfma_f32_32x32x16_bf16(f2, e0, c02, 0, 0, 0); c03 = __builtin_amdgcn_mfma_f32_32x32x16_bf16(f3, e0, c03, 0, 0, 0);
        c10 = __builtin_amdgcn_mfma_f32_32x32x16_bf16(f0, e1, c10, 0, 0, 0); c11 = __builtin_amdgcn_mfma_f32_32x32x16_bf16(f1, e1, c11, 0, 0, 0);
        c12 = __builtin_amdgcn_mfma_f32_32x32x16_bf16(f2, e1, c12, 0, 0, 0); c13 = __builtin_amdgcn_mfma_f32_32x32x16_bf16(f3, e1, c13, 0, 0, 0);
        __builtin_amdgcn_s_setprio(0);
        if (skip_epi < 4) asm volatile("s_waitcnt vmcnt(8) lgkmcnt(0)\n\ts_barrier" ::: "memory");
    }
#undef D_ISSUE
    asm volatile("s_waitcnt vmcnt(0)\n\ts_barrier" ::: "memory");
    unsigned short* T = (unsigned short*)lds;
    {
        unsigned short* t0 = T + (wm * 64 + l31) * TLD + wn * 128 + 4 * h;
#define T_PUT(C, RO, CO) { _Pragma("unroll") for (int g = 0; g < 4; ++g) *(uint2*)(t0 + (RO) * TLD + (CO) + 8 * g) = make_uint2(pack2(C[4 * g], C[4 * g + 1]), pack2(C[4 * g + 2], C[4 * g + 3])); }
        T_PUT(c00, 0, 0) T_PUT(c01, 0, 32) T_PUT(c02, 0, 64) T_PUT(c03, 0, 96) T_PUT(c10, 32, 0) T_PUT(c11, 32, 32) T_PUT(c12, 32, 64) T_PUT(c13, 32, 96)
#undef T_PUT
    }
    __syncthreads();
    if (whole) { tn_ref = tn_base; if (!skip_epi) epi(T, m0); return; }
#pragma unroll 1
    for (int sub = 0; sub < 4 && !skip_epi; ++sub) { const int rh = sub >> 1, ch = sub & 1; tn_ref = tn_base + ch; epi(T + rh * 128 * TLD + 128 * ch, m0 + 128 * rh); }
}

typedef float f32x4 __attribute__((ext_vector_type(4)));
constexpr int PG_HTB = 128 * 64 * 2;
DEVI int pg_lds_byte(int r, int c) { const int st = (r >> 4) * 2 + (c >> 5), rr = r & 15, cc = c & 31, ob = rr * 64 + cc * 2; return st * 1024 + (ob ^ (((ob >> 9) & 1) << 5)); }
DEVI void pg_stage_rc(int b, int& R, int& C) { const int st = b / 1024, sb = b % 1024, sw = sb ^ (((sb >> 9) & 1) << 5); R = (st >> 1) * 16 + sw / 64; C = (st & 1) * 32 + (sw % 64) / 2; }
template <class Epi>
DEVI void gemm_unit8(const ATile& at, int m0, const bf16_t* Bt, int K, float* ldsf, Epi&& epi, int& tn_ref, int tn_base, int skip_epi = 0, bool whole = false) {
    LAS unsigned char* lds = (LAS unsigned char*)ldsf;
    const int tid = tidx(), wid = __builtin_amdgcn_readfirstlane(tid >> 6), lane = tid & 63, wr = wid >> 2, wc = wid & 3, fr = lane & 15, fq = lane >> 4;
    const int nt = K >> 6;
    const char* ap00; const char* ap01; const char* ap10; const char* ap11;
    unsigned vb0, vb1;
    {   int R, C;
        pg_stage_rc(tid * 16, R, C);
        { const int g0 = m0 + R, g1 = m0 + 128 + R;
          const long s0 = (g0 < at.mvalid) ? (at.rowmap ? (long)at.rowmap[g0] : (long)g0) : 0, s1 = (g1 < at.mvalid) ? (at.rowmap ? (long)at.rowmap[g1] : (long)g1) : 0;
          ap00 = (const char*)(at.a + s0 * at.lda + C); ap10 = (const char*)(at.a + s1 * at.lda + C); vb0 = (unsigned)(R * K + C) * 2u; }
        pg_stage_rc(tid * 16 + 8192, R, C);
        { const int g0 = m0 + R, g1 = m0 + 128 + R;
          const long s0 = (g0 < at.mvalid) ? (at.rowmap ? (long)at.rowmap[g0] : (long)g0) : 0, s1 = (g1 < at.mvalid) ? (at.rowmap ? (long)at.rowmap[g1] : (long)g1) : 0;
          ap01 = (const char*)(at.a + s0 * at.lda + C); ap11 = (const char*)(at.a + s1 * at.lda + C); vb1 = (unsigned)(R * K + C) * 2u; }
    }
    const size_t kstep = 128, hstep = (size_t)128 * K * 2;
    const unsigned ldsw = (unsigned)wid * 1024u;
    const int aoff = pg_lds_byte(wr * 64 + fr, fq * 8), boff = pg_lds_byte(wc * 32 + fr, fq * 8);
#define PG_SA(b, h) (((b) * 2 + (h)) * PG_HTB)
#define PG_SB(b, h) ((4 + (b) * 2 + (h)) * PG_HTB)
#define PG_DMA(gp, lo) __builtin_amdgcn_global_load_lds((const __attribute__((address_space(1))) unsigned*)(gp), (LAS unsigned*)(lds + (lo)), 16, 0, 0)
#define PG_STAGE_A0(bufoff, ko) do { PG_DMA(ap00 + (ko), (bufoff) + ldsw); PG_DMA(ap01 + (ko), (bufoff) + ldsw + 8192); } while (0)
#define PG_STAGE_A1(bufoff, ko) do { PG_DMA(ap10 + (ko), (bufoff) + ldsw); PG_DMA(ap11 + (ko), (bufoff) + ldsw + 8192); } while (0)
#define PG_STAGE_B(bufoff, gbase) do { PG_DMA((const char*)(gbase) + vb0, (bufoff) + ldsw); PG_DMA((const char*)(gbase) + vb1, (bufoff) + ldsw + 8192); } while (0)
#define PG_LDA(dst, b, h) do { _Pragma("unroll") for (int m = 0; m < 4; ++m) _Pragma("unroll") for (int k = 0; k < 2; ++k) dst[m][k] = *(const LAS bf16x8*)(lds + PG_SA(b, h) + aoff + m * 2048 + k * 1024); } while (0)
#define PG_LDB(dst, b, h) do { _Pragma("unroll") for (int n = 0; n < 2; ++n) _Pragma("unroll") for (int k = 0; k < 2; ++k) dst[n][k] = *(const LAS bf16x8*)(lds + PG_SB(b, h) + boff + n * 2048 + k * 1024); } while (0)
#define PG_MMA(ai, bj, At_, Bt_) do { __builtin_amdgcn_s_setprio(1); _Pragma("unroll") for (int m = 0; m < 4; ++m) _Pragma("unroll") for (int n = 0; n < 2; ++n) _Pragma("unroll") for (int k = 0; k < 2; ++k) \
        acc[ai][bj][m][n] = __builtin_amdgcn_mfma_f32_16x16x32_bf16(Bt_[n][k], At_[m][k], acc[ai][bj][m][n], 0, 0, 0); __builtin_amdgcn_s_setprio(0); } while (0)
#define PG_WAIT_V(n) asm volatile("s_waitcnt vmcnt(" #n ")" ::: "memory")
#define PG_WAIT_L(n) asm volatile("s_waitcnt lgkmcnt(" #n ")" ::: "memory")
#define PG_BAR __builtin_amdgcn_s_barrier()
#define PG_SCHED __builtin_amdgcn_sched_barrier(0)
    f32x4 acc[2][2][4][2];
#pragma unroll
    for (int a = 0; a < 2; ++a)
#pragma unroll
        for (int b = 0; b < 2; ++b)
#pragma unroll
            for (int m = 0; m < 4; ++m)
#pragma unroll
                for (int n = 0; n < 2; ++n) acc[a][b][m][n] = (f32x4){0.f, 0.f, 0.f, 0.f};
    bf16x8 At[4][2], B0[2][2], B1[2][2];
    const char* cB = (const char*)Bt;
    __syncthreads();
    PG_STAGE_B(PG_SB(0, 0), cB); PG_STAGE_A0(PG_SA(0, 0), 0); PG_STAGE_B(PG_SB(0, 1), cB + hstep); PG_STAGE_A1(PG_SA(0, 1), 0);
    if (wr == 1) PG_BAR;
    PG_WAIT_V(4); PG_BAR;
    PG_STAGE_B(PG_SB(1, 0), cB + kstep); PG_STAGE_A0(PG_SA(1, 0), kstep); PG_STAGE_B(PG_SB(1, 1), cB + hstep + kstep);
    PG_WAIT_V(6); PG_BAR;
#pragma unroll 1
    for (int t = 0; t < nt; t += 2) {
        const bool last = (t == nt - 2);
        const size_t a1 = (size_t)(t + 1) * kstep, a2 = last ? 0 : (size_t)(t + 2) * kstep, a3 = a2 + kstep;
        const char* b2 = cB + a2; const char* b3 = cB + a3;
        PG_LDB(B0, 0, 0); PG_SCHED; PG_LDA(At, 0, 0); PG_STAGE_A1(PG_SA(1, 1), a1);
        PG_WAIT_L(8); PG_BAR; PG_WAIT_L(0); PG_MMA(0, 0, At, B0); PG_BAR; PG_SCHED;
        PG_LDB(B1, 0, 1); PG_STAGE_B(PG_SB(0, 0), b2);
        PG_BAR; PG_WAIT_L(0); PG_MMA(0, 1, At, B1); PG_BAR;
        PG_LDA(At, 0, 1); PG_STAGE_A0(PG_SA(0, 0), a2);
        PG_BAR; PG_WAIT_L(0); PG_MMA(1, 0, At, B0); PG_BAR; PG_SCHED;
        PG_STAGE_B(PG_SB(0, 1), b2 + hstep);
        PG_WAIT_V(6); PG_BAR; PG_MMA(1, 1, At, B1); PG_BAR;
        PG_LDB(B0, 1, 0); PG_SCHED; PG_LDA(At, 1, 0); PG_STAGE_A1(PG_SA(0, 1), a2);
        PG_WAIT_L(8); PG_BAR; PG_WAIT_L(0); PG_MMA(0, 0, At, B0); PG_BAR; PG_SCHED;
        PG_LDB(B1, 1, 1); PG_STAGE_B(PG_SB(1, 0), b3);
        PG_BAR; PG_WAIT_L(0); PG_MMA(0, 1, At, B1); PG_BAR;
        PG_LDA(At, 1, 1); PG_STAGE_A0(PG_SA(1, 0), a3);
        PG_BAR; PG_WAIT_L(0); PG_MMA(1, 0, At, B0); PG_BAR; PG_SCHED;
        PG_STAGE_B(PG_SB(1, 1), b3 + hstep);
        PG_WAIT_V(6); PG_BAR; PG_MMA(1, 1, At, B1); PG_BAR;
    }
    PG_WAIT_V(0);
    if (wr == 0) PG_BAR;
    PG_BAR;
    unsigned short* T = (unsigned short*)ldsf;
#pragma unroll
    for (int ai = 0; ai < 2; ++ai)
#pragma unroll
        for (int m = 0; m < 4; ++m) { unsigned short* tr = T + (ai * 128 + wr * 64 + m * 16 + fr) * TLD + wc * 32 + 4 * fq;
#pragma unroll
            for (int bj = 0; bj < 2; ++bj)
#pragma unroll
                for (int n = 0; n < 2; ++n) { const f32x4 v = acc[ai][bj][m][n]; *(uint2*)(tr + bj * 128 + n * 16) = make_uint2(pack2(v[0], v[1]), pack2(v[2], v[3])); } }
    __syncthreads();
    if (whole) { tn_ref = tn_base; if (!skip_epi) epi(T, m0); return; }
#pragma unroll 1
    for (int sub = 0; sub < 4 && !skip_epi; ++sub) { const int rh = sub >> 1, ch = sub & 1; tn_ref = tn_base + ch; epi(T + rh * 128 * TLD + 128 * ch, m0 + 128 * rh); }
#undef PG_SA
#undef PG_SB
#undef PG_DMA
#undef PG_STAGE_A0
#undef PG_STAGE_A1
#undef PG_STAGE_B
#undef PG_LDA
#undef PG_LDB
#undef PG_MMA
#undef PG_WAIT_V
#undef PG_WAIT_L
#undef PG_BAR
#undef PG_SCHED
}

DEVI void tr_job(const float* src, long mat_stride, int gpm, int nmat, int ld, int K, int nvalid, int mode, bf16_t* dst, float* lds) {
    const int tid = tidx(), kt = K >> 6, total = nmat * gpm * kt;
    const int i = tid >> 3, j8 = (tid & 7) * 8;
#define TR_LOAD(U, X0, X1) { const int G_ = (U) / kt, k0_ = ((U) % kt) * 64, mat_ = G_ / gpm, g_ = G_ % gpm; \
        const int col0_ = (mode == 0) ? g_ * 64 : ((g_ & 1) ? 256 + (g_ >> 1) * 64 : (g_ >> 1) * 64); \
        const float* rp_ = src + mat_ * mat_stride + (long)(k0_ + i) * ld + col0_ + j8; \
        if (col0_ + j8 + 7 < nvalid) { X0 = *(const float4*)rp_; X1 = *(const float4*)(rp_ + 4); } \
        else { float t_[8]; _Pragma("unroll") for (int e = 0; e < 8; ++e) t_[e] = (col0_ + j8 + e < nvalid) ? rp_[e] : 0.f; \
               X0 = make_float4(t_[0], t_[1], t_[2], t_[3]); X1 = make_float4(t_[4], t_[5], t_[6], t_[7]); } }
    float4 x0 = make_float4(0.f, 0.f, 0.f, 0.f), x1 = x0, y0 = x0, y1 = x0;
    int u = BIDX;
    if (u < total) TR_LOAD(u, x0, x1)
    for (; u < total; u += GDIMX) {
        const int un = u + GDIMX;
        if (un < total) TR_LOAD(un, y0, y1)
        const int G = u / kt, k0 = (u % kt) * 64;
        __syncthreads();
        lds[i * 65 + j8] = x0.x; lds[i * 65 + j8 + 1] = x0.y; lds[i * 65 + j8 + 2] = x0.z; lds[i * 65 + j8 + 3] = x0.w;
        lds[i * 65 + j8 + 4] = x1.x; lds[i * 65 + j8 + 5] = x1.y; lds[i * 65 + j8 + 6] = x1.z; lds[i * 65 + j8 + 7] = x1.w;
        __syncthreads();
        { const int n = tid >> 3, kc = (tid & 7) * 8; float f[8];
#pragma unroll
          for (int e = 0; e < 8; ++e) f[e] = lds[(kc + e) * 65 + n];
          uint4 w; w.x = pack2(f[0], f[1]); w.y = pack2(f[2], f[3]); w.z = pack2(f[4], f[5]); w.w = pack2(f[6], f[7]);
          *(uint4*)(dst + ((long)G * 64 + n) * K + k0 + kc) = w; }
        x0 = y0; x1 = y1;
    }
#undef TR_LOAD
}

typedef bf16_t tile_t;
DEVI float4 t_ld4(const tile_t* T, int idx) { const uint2 u = *(const uint2*)(T + idx); return make_float4(bflo(u.x), bfhi(u.x), bflo(u.y), bfhi(u.y)); }
DEVI void epi_load(const tile_t* T, float (&v)[8][4]) {
    const int row = tidx() >> 2, q = tidx() & 3;
#pragma unroll
    for (int j = 0; j < 8; ++j) { const float4 t = t_ld4(T, row * TLD + 16 * j + 4 * q); v[j][0] = t.x; v[j][1] = t.y; v[j][2] = t.z; v[j][3] = t.w; }
}
DEVI void epi_store_bf16(const float (&v)[8][4], bf16_t* rowp  ) {
    const int q = tidx() & 3;
#pragma unroll
    for (int j = 0; j < 8; ++j) *(uint2*)(rowp + 16 * j + 4 * q) = make_uint2(pack2(v[j][0], v[j][1]), pack2(v[j][2], v[j][3]));
}
DEVI void rope_cs(float posf, int c, float fscale, float& cs, float& sn) {
    const float inv = __builtin_amdgcn_exp2f(-(float)c * fscale);
    const float rev = __builtin_amdgcn_fractf((posf * inv) * 0.15915494309189535f);
    sn = __builtin_amdgcn_sinf(rev); cs = __builtin_amdgcn_cosf(rev);
}
constexpr float ROPE_FS128 = 13.287712379549449f * 2.0f / 128.0f, ROPE_FS64 = 13.287712379549449f * 2.0f / 64.0f;
DEVI void norm_rope128(float (&v)[8][4], const float* gain, float posf, float post, bool do_rope) {
    const int q = tidx() & 3;
    float ss = 0.f;
#pragma unroll
    for (int j = 0; j < 8; ++j)
#pragma unroll
        for (int i = 0; i < 4; ++i) ss += v[j][i] * v[j][i];
    ss = quad_sum(ss);
    const float rstd = rsqrtf(ss * (1.0f / 128.0f) + EPS);
#pragma unroll
    for (int j = 0; j < 8; ++j) { const float4 g = *(const float4*)(gain + 16 * j + 4 * q); v[j][0] *= rstd * g.x; v[j][1] *= rstd * g.y; v[j][2] *= rstd * g.z; v[j][3] *= rstd * g.w; }
    if (do_rope) {
#pragma unroll
        for (int j = 0; j < 4; ++j) {
#pragma unroll
            for (int i = 0; i < 4; ++i) { float c_, s_; rope_cs(posf, 16 * j + 4 * q + i, ROPE_FS128, c_, s_);
                const float x1 = v[j][i], x2 = v[j + 4][i]; v[j][i] = x1 * c_ - x2 * s_; v[j + 4][i] = x2 * c_ + x1 * s_; }
        }
    }
#pragma unroll
    for (int j = 0; j < 8; ++j)
#pragma unroll
        for (int i = 0; i < 4; ++i) v[j][i] *= post;
}
DEVI void rope64(float (&v)[8][4], int jb, float posf) {
    const int q = tidx() & 3;
#pragma unroll
    for (int jj = 0; jj < 2; ++jj) {
#pragma unroll
        for (int i = 0; i < 4; ++i) { float c_, s_; rope_cs(posf, 16 * jj + 4 * q + i, ROPE_FS64, c_, s_);
            const float x1 = v[jb + jj][i], x2 = v[jb + jj + 2][i]; v[jb + jj][i] = x1 * c_ - x2 * s_; v[jb + jj + 2][i] = x2 * c_ + x1 * s_; }
    }
}
DEVI void epi_store_vt(const tile_t* T, bf16_t* dst, long r0  , int col0) {
    const int col = tidx() & 127, sg = tidx() >> 7, kt = sg >> 1;
#pragma unroll
    for (int g = 0; g < 2; ++g) {
        const int kb = 32 * (sg & 1) + 16 * g;
#pragma unroll
        for (int half = 0; half < 2; ++half) {
            uint32_t f[8];
#pragma unroll
            for (int e = 0; e < 8; ++e) { const int key = kb + kperm(8 * half + e); f[e] = T[(64 * kt + key) * TLD + col]; }
            uint4 w; w.x = f[0] | (f[1] << 16); w.y = f[2] | (f[3] << 16); w.z = f[4] | (f[5] << 16); w.w = f[6] | (f[7] << 16);
            *(uint4*)(dst + (((r0 >> 6) + kt) * 512 + col0 + col) * 64 + kb + 8 * half) = w;
        }
    }
}

DEVI void sincos_acc(float ang, float& s, float& c) {
    const double a = (double)ang * 0.15915494309189535; const double n = rint(a); const float fr = (float)(a - n);
    s = __builtin_amdgcn_sinf(fr); c = __builtin_amdgcn_cosf(fr);
}
DEVI void ph_pro_w(const P& p, float* lds);
DEVI void ph_pro_a(const P& p, float* lds) {
    const long gt = (long)BIDX * NT + tidx(), gs = (long)GDIMX * NT;
    for (long i = gt; i < 1024; i += gs) { const int l = (int)(i >> 9), c = (int)(i & 511); p.LB[i] = (l == 0) ? 0.f : 1.0f / (1.0f + expf(p.lb_raw[c] - p.lb_raw[512 + c])); }
    for (long i = gt; i < 64; i += gs) p.CNT[i] = 0;
    ph_pro_w(p, lds);
    const int lane = tidx() & 63, gw = BIDX * 8 + (tidx() >> 6), nw = GDIMX * 8;
    for (int r = gw; r < 2 * 1024; r += nw) {
        const int l = r >> 10, rr = r & 1023;
        const float4* xr = (const float4*)(p.mem + (long)rr * DM); const float4* gr = (const float4*)(p.norm_mem + l * DM);
        float4 v[4]; float ss = 0.f;
#pragma unroll
        for (int j = 0; j < 4; ++j) { v[j] = xr[lane + 64 * j]; ss += v[j].x * v[j].x + v[j].y * v[j].y + v[j].z * v[j].z + v[j].w * v[j].w; }
        ss = wsum(ss); const float rstd = rsqrtf(ss * (1.0f / 1024.0f) + EPS);
#pragma unroll
        for (int j = 0; j < 4; ++j) { const float4 g = gr[lane + 64 * j];
            *(uint2*)(p.MEMN + (long)r * DM + 4 * (lane + 64 * j)) = make_uint2(pack2(v[j].x * rstd * g.x, v[j].y * rstd * g.y), pack2(v[j].z * rstd * g.z, v[j].w * rstd * g.w)); }
    }
}
DEVI void ph_pro_w(const P& p, float* lds) {
    tr_job(p.w_in, (long)DM * DIN, 56, 2, DIN, DM, DIN, 0, p.WIN, lds);
    tr_job(p.b_wqb, 256L * 512, 8, 1, 512, 256, 512, 0, p.WQ, lds);
    tr_job(p.b_wqb + 256L * 512, 256L * 512, 8, 1, 512, 256, 512, 0, p.WQ + 1536L * 256, lds);
    tr_job(p.b_wqidx, 256L * 1024, 16, 1, 1024, 256, 1024, 0, p.WQ + 512L * 256, lds);
    tr_job(p.b_wqidx + 256L * 1024, 256L * 1024, 16, 1, 1024, 256, 1024, 0, p.WQ + (1536L + 512) * 256, lds);
    tr_job(p.w_out, (long)DM * DM, 16, 2, DM, DM, DM, 0, p.WOUT, lds);
    tr_job(p.x_wq, (long)DM * 512, 8, 2, 512, DM, 512, 0, p.XWQ, lds);
    tr_job(p.x_wk, (long)DM * 512, 8, 2, 512, DM, 512, 0, p.XWK, lds);
    tr_job(p.x_wv, (long)DM * 512, 8, 2, 512, DM, 512, 0, p.XWV, lds);
    tr_job(p.x_wo, 512L * DM, 16, 2, DM, 512, DM, 0, p.XWO, lds);
    tr_job(p.w_gu, (long)DM * 512, 8, 32, 512, DM, 512, 1, p.WGU, lds);
    tr_job(p.w_dn, 256L * DM, 16, 32, DM, 256, DM, 0, p.WDN, lds);
}
DEVI void ph_pro_b(const P& p, float* lds) {
    for (int u = BIDX; u < 2 * 4 * 4; u += GDIMX) {
        const int l = u >> 4, tm = (u >> 2) & 3, tn2 = u & 3; int tn;
        ATile at{p.MEMN + (long)l * 1024 * DM, DM, nullptr, 1024};
        gemm_unit8(at, tm * 256, ((tn2 >> 1) ? p.XWV : p.XWK) + ((long)l * 512 + (tn2 & 1) * 256) * DM, DM, lds, [&](const tile_t* T, int mr0) __attribute__((always_inline)) NOPK {
            const int isv = tn >> 2, hn = tn & 3;
            if (!isv) {
                float v[8][4]; epi_load(T, v);
                norm_rope128(v, p.x_knorm + l * 128, 0.f, 1.0f, false);
                epi_store_bf16(v, p.XK + ((long)l * 1024 + mr0 + (tidx() >> 2)) * 512 + hn * 128);
            } else {
                epi_store_vt(T, p.XVT + (long)l * 1024 * 512, mr0, hn * 128);
            }
        }, tn, 2 * tn2);
    }
}

#define ST_AGENT(ptr, val) __hip_atomic_store((ptr), (val), __ATOMIC_RELAXED, __HIP_MEMORY_SCOPE_AGENT)
template <bool ROUTER, bool ADDY = false, bool XIN = false>
DEVI void ph_norm(const P& p, const float* gain, int l) {
    const int lane = tidx() & 63, gw = BIDX * 8 + (tidx() >> 6), nw = GDIMX * 8;
    for (int row = gw; row < NTOK; row += nw) {
        const float4* xr = (const float4*)((XIN ? p.x : p.out) + (long)row * DM); const float4* gr = (const float4*)gain;
        float4 v0 = xr[lane], v1 = xr[lane + 64], v2 = xr[lane + 128], v3 = xr[lane + 192];
        if (ADDY) {
            const uint2* y0 = (const uint2*)(p.Y + (long)(2 * row) * DM); const uint2* y1 = (const uint2*)(p.Y + (long)(2 * row + 1) * DM);
#define ADDY_ONE(V, J) { const uint2 a = y0[lane + 64 * J], b = y1[lane + 64 * J]; V.x = (V.x + bflo(a.x)) + bflo(b.x); V.y = (V.y + bfhi(a.x)) + bfhi(b.x); \
                         V.z = (V.z + bflo(a.y)) + bflo(b.y); V.w = (V.w + bfhi(a.y)) + bfhi(b.y); ((float4*)(p.out + (long)row * DM))[lane + 64 * J] = V; }
            ADDY_ONE(v0, 0) ADDY_ONE(v1, 1) ADDY_ONE(v2, 2) ADDY_ONE(v3, 3)
#undef ADDY_ONE
        }
        float ss = v0.x * v0.x + v0.y * v0.y + v0.z * v0.z + v0.w * v0.w + v1.x * v1.x + v1.y * v1.y + v1.z * v1.z + v1.w * v1.w
                 + v2.x * v2.x + v2.y * v2.y + v2.z * v2.z + v2.w * v2.w + v3.x * v3.x + v3.y * v3.y + v3.z * v3.z + v3.w * v3.w;
        ss = wsum(ss); const float rstd = rsqrtf(ss * (1.0f / 1024.0f) + EPS);
#define NORM_ONE(V, J) { const float4 g = gr[lane + 64 * J]; V.x *= rstd * g.x; V.y *= rstd * g.y; V.z *= rstd * g.z; V.w *= rstd * g.w; \
            *(uint2*)(p.H + (long)row * DM + 4 * (lane + 64 * J)) = make_uint2(pack2(V.x, V.y), pack2(V.z, V.w)); }
        NORM_ONE(v0, 0) NORM_ONE(v1, 1) NORM_ONE(v2, 2) NORM_ONE(v3, 3)
#undef NORM_ONE
        if (ROUTER) {
            float4 ag = make_float4(0.f, 0.f, 0.f, 0.f), ae0 = ag, ae1 = ag, ae2 = ag, ae3 = ag;
#define RT_ONE(HH, D) { const float hh = HH; const int d = D; \
                    const float4 wg = *(const float4*)(p.w_rg + ((long)l * DM + d) * 4); \
                    ag.x += hh * wg.x; ag.y += hh * wg.y; ag.z += hh * wg.z; ag.w += hh * wg.w; \
                    const float4* we = (const float4*)(p.w_re + ((long)l * DM + d) * 16); \
                    const float4 w0 = we[0], w1 = we[1], w2 = we[2], w3 = we[3]; \
                    ae0.x += hh * w0.x; ae0.y += hh * w0.y; ae0.z += hh * w0.z; ae0.w += hh * w0.w; \
                    ae1.x += hh * w1.x; ae1.y += hh * w1.y; ae1.z += hh * w1.z; ae1.w += hh * w1.w; \
                    ae2.x += hh * w2.x; ae2.y += hh * w2.y; ae2.z += hh * w2.z; ae2.w += hh * w2.w; \
                    ae3.x += hh * w3.x; ae3.y += hh * w3.y; ae3.z += hh * w3.z; ae3.w += hh * w3.w; }
#define RT_VEC(V, J) RT_ONE(V.x, 4 * (lane + 64 * J)) RT_ONE(V.y, 4 * (lane + 64 * J) + 1) RT_ONE(V.z, 4 * (lane + 64 * J) + 2) RT_ONE(V.w, 4 * (lane + 64 * J) + 3)
            RT_VEC(v0, 0) RT_VEC(v1, 1) RT_VEC(v2, 2) RT_VEC(v3, 3)
#undef RT_VEC
#undef RT_ONE
            ag.x = wsum(ag.x); ag.y = wsum(ag.y); ag.z = wsum(ag.z); ag.w = wsum(ag.w);
            ae0.x = wsum(ae0.x); ae0.y = wsum(ae0.y); ae0.z = wsum(ae0.z); ae0.w = wsum(ae0.w);
            ae1.x = wsum(ae1.x); ae1.y = wsum(ae1.y); ae1.z = wsum(ae1.z); ae1.w = wsum(ae1.w);
            ae2.x = wsum(ae2.x); ae2.y = wsum(ae2.y); ae2.z = wsum(ae2.z); ae2.w = wsum(ae2.w);
            ae3.x = wsum(ae3.x); ae3.y = wsum(ae3.y); ae3.z = wsum(ae3.z); ae3.w = wsum(ae3.w);
            if (lane == 0) {
                const float g0 = ag.x + p.b_rg[l * 4 + 0], g1 = ag.y + p.b_rg[l * 4 + 1], g2 = ag.z + p.b_rg[l * 4 + 2], g3 = ag.w + p.b_rg[l * 4 + 3];
                int gsel = 0; float gm = g0;
                if (g1 > gm) { gm = g1; gsel = 1; }
                if (g2 > gm) { gm = g2; gsel = 2; }
                if (g3 > gm) { gm = g3; gsel = 3; }
                const float gw_ = 1.0f / (expf(g0 - gm) + expf(g1 - gm) + expf(g2 - gm) + expf(g3 - gm));
                const float m0 = (gsel == 0) ? 1.f : 0.f, m1 = (gsel == 1) ? 1.f : 0.f, m2 = (gsel == 2) ? 1.f : 0.f, m3 = (gsel == 3) ? 1.f : 0.f;
                float4 es; es.x = m0 * ae0.x + m1 * ae1.x + m2 * ae2.x + m3 * ae3.x; es.y = m0 * ae0.y + m1 * ae1.y + m2 * ae2.y + m3 * ae3.y;
                es.z = m0 * ae0.z + m1 * ae1.z + m2 * ae2.z + m3 * ae3.z; es.w = m0 * ae0.w + m1 * ae1.w + m2 * ae2.w + m3 * ae3.w;
                const float4 be = *(const float4*)(p.b_re + l * 16 + gsel * 4);
                const float x0 = es.x + be.x, x1 = es.y + be.y, x2 = es.z + be.z, x3 = es.w + be.w;
                int i1 = 0; float e1 = x0;
                if (x1 > e1) { e1 = x1; i1 = 1; }
                if (x2 > e1) { e1 = x2; i1 = 2; }
                if (x3 > e1) { e1 = x3; i1 = 3; }
                int i2 = -1; float e2 = -3.0e38f;
                if (i1 != 0 && x0 > e2) { e2 = x0; i2 = 0; }
                if (i1 != 1 && x1 > e2) { e2 = x1; i2 = 1; }
                if (i1 != 2 && x2 > e2) { e2 = x2; i2 = 2; }
                if (i1 != 3 && x3 > e2) { e2 = x3; i2 = 3; }
                const float z = expf(e2 - e1); const float w1 = 1.0f / (1.0f + z), w2 = z / (1.0f + z);
                const int ex1 = gsel * 4 + i1, ex2 = gsel * 4 + i2;
                if (!p.dry) {
                const int p1 = atomicAdd(&p.CNT[l * 16 + ex1], 1); ST_AGENT(&p.LTOK[(long)ex1 * NTOK + p1], row); ST_AGENT(&p.LSLOT[(long)ex1 * NTOK + p1], 2 * row); ST_AGENT((int*)&p.LGATE[(long)ex1 * NTOK + p1], __float_as_int(w1 * gw_));
                const int p2 = atomicAdd(&p.CNT[l * 16 + ex2], 1); ST_AGENT(&p.LTOK[(long)ex2 * NTOK + p2], row); ST_AGENT(&p.LSLOT[(long)ex2 * NTOK + p2], 2 * row + 1); ST_AGENT((int*)&p.LGATE[(long)ex2 * NTOK + p2], __float_as_int(w2 * gw_)); }
            }
        }
    }
}

DEVI bool xcd_unit(int i, int tilesN, int& tm, int& tn) {
    if ((GDIMX & 7) != 0) { const int u = BIDX + i * GDIMX; if (u >= 128 * tilesN) return false; tm = u / tilesN; tn = u % tilesN; return true; }
    const int xcd = BIDX & 7, slot = BIDX >> 3, nslots = GDIMX >> 3, ul = slot + nslots * i;
    if (ul >= 16 * tilesN) return false;
    tm = xcd + 8 * (ul / tilesN); tn = ul % tilesN; return true;
}
DEVI void epi_inproj(const P& p, int l, const tile_t* T, int m0, int tn) {
    const int row = tidx() >> 2, q = tidx() & 3; const long t = m0 + row;
    if ((tn >= 8 && tn < 12) || (tn >= 22 && tn < 26)) {
        epi_store_vt(T, (tn < 12) ? p.VAT : p.VT, m0, ((tn < 12) ? (tn - 8) : (tn - 22)) * 128);
        return;
    }
    float v[8][4]; epi_load(T, v);
    if (tn < 4 || (tn >= 12 && tn < 16)) {
#pragma unroll
        for (int j = 0; j < 8; ++j)
#pragma unroll
            for (int i = 0; i < 4; ++i) v[j][i] = siluf(v[j][i]);
        epi_store_bf16(v, ((tn < 4) ? p.QA : p.GA) + t * 512 + (tn & 3) * 128);
    } else if (tn < 8) {
        epi_store_bf16(v, p.ZF + t * 512 + (tn - 4) * 128);
    } else if (tn < 18) {
        epi_store_bf16(v, p.QL + t * 256 + (tn - 16) * 128);
    } else if (tn < 22) {
        norm_rope128(v, p.b_knorm + l * 128, (float)p.pos[t], 1.0f, true);
        epi_store_bf16(v, p.KB + t * 512 + (tn - 18) * 128);
    } else {
        float ss = 0.f;
#pragma unroll
        for (int j = 0; j < 4; ++j)
#pragma unroll
            for (int i = 0; i < 4; ++i) ss += v[j][i] * v[j][i];
        ss = quad_sum(ss); const float rstd = rsqrtf(ss * (1.0f / 64.0f) + EPS);
#pragma unroll
        for (int j = 0; j < 4; ++j) { const float4 g = *(const float4*)(p.b_kidx_norm + l * 64 + 16 * j + 4 * q); v[j][0] *= rstd * g.x; v[j][1] *= rstd * g.y; v[j][2] *= rstd * g.z; v[j][3] *= rstd * g.w; }
        rope64(v, 0, (float)p.pos[t]);
#pragma unroll
        for (int j = 0; j < 4; ++j) *(uint2*)(p.KIDX + t * 64 + 16 * j + 4 * q) = make_uint2(pack2(v[j][0], v[j][1]), pack2(v[j][2], v[j][3]));
        *(float4*)(p.WIDX + t * 16 + 4 * q) = make_float4(v[4][0] * 0.03125f, v[4][1] * 0.03125f, v[4][2] * 0.03125f, v[4][3] * 0.03125f);
    }
}
DEVI void ph_inproj(const P& p, int l, float* lds) {
    for (int i = 0;; ++i) {
        int tm, tn2, tn; if (!xcd_unit(i, 14, tm, tn2)) break;
        ATile at{p.H, DM, nullptr, NTOK};
        gemm_unit8(at, tm * 256, p.WIN + ((long)l * 3584 + tn2 * 256) * DM, DM, lds, [&](const tile_t* T, int mr0) __attribute__((always_inline)) NOPK { if (tn < 27) epi_inproj(p, l, T, mr0, tn); }, tn, 2 * tn2, p.dry >= 2 ? p.dry : 0);
    }
}

DEVI void hgrn_state_units(const P& p, int l, float* lds);
DEVI void ph_h1(const P& p, int l, float* lds) {
    const int tid = tidx(), lane = tid & 63;
    if (!p.dry) {
        const int gw = BIDX * 8 + (tid >> 6), nw = GDIMX * 8;
        for (int row = gw; row < NTOK; row += nw) {
            bf16_t* rp = p.QL + (long)row * 256 + 4 * lane; const uint2 u = *(const uint2*)rp;
            float a = bflo(u.x), b = bfhi(u.x), c = bflo(u.y), d = bfhi(u.y);
            float ss = wsum(a * a + b * b + c * c + d * d); const float rstd = rsqrtf(ss * (1.0f / 256.0f) + EPS);
            const float4 g = *(const float4*)(p.b_qlat_gain + l * 256 + 4 * lane);
            *(uint2*)rp = make_uint2(pack2(a * rstd * g.x, b * rstd * g.y), pack2(c * rstd * g.z, d * rstd * g.w));
        }
    }
    hgrn_state_units(p, l, lds);
}
struct HgCol { float b[16]; float kg[16]; float m, bl; };
DEVI void hgrn_cumsum(const P& p, int l, long t0, int h, float* tot  , HgCol& c) {
    const int tid = tidx(), k = tid & 127, sg = tid >> 7;
    const bf16_t* zp = p.ZF + (t0 + 16 * sg) * 512 + h * 128 + k;
    const float lb = p.LB[l * 512 + h * 128 + k];
    bf16_t zr[16];
#pragma unroll
    for (int i = 0; i < 16; ++i) zr[i] = zp[(long)i * 512];
    float run = 0.f;
#pragma unroll
    for (int i = 0; i < 16; ++i) {
        const float z = bf2f(zr[i]);
        const float e = __expf(-fabsf(z)), r1 = __builtin_amdgcn_rcpf(1.0f + e);
        const float sp = (z >= 0.f) ? r1 : e * r1, sn = (z >= 0.f) ? e * r1 : r1;
        const float lf = (lb > 0.f) ? __logf(lb + (1.0f - lb) * sp) : (fminf(z, 0.f) - __logf(1.0f + e));
        c.kg[i] = (1.0f - lb) * sn;
        run += lf; c.b[i] = run;
    }
    __syncthreads();
    tot[sg * 128 + k] = run;
    __syncthreads();
    const float t0_ = tot[k], t1_ = tot[128 + k], t2_ = tot[256 + k], t3_ = tot[384 + k];
    const float off = (sg > 0 ? t0_ : 0.f) + (sg > 1 ? t1_ : 0.f) + (sg > 2 ? t2_ : 0.f);
#pragma unroll
    for (int i = 0; i < 16; ++i) c.b[i] += off;
    c.m = t0_ + t1_; c.bl = (t0_ + t1_) + (t2_ + t3_);
}
DEVI void hgrn_state_units(const P& p, int l, float* lds) {
    char* base = (char*)lds;
    const int tid = tidx(), lane = tid & 63, wv = tid >> 6, l31 = lane & 31, hl = lane >> 5, k = tid & 127, sg = tid >> 7;
    float* tot = (float*)(base + 16384);
    for (int u = BIDX; u < 2048; u += GDIMX) {
        const int bh = u >> 7, c = u & 127, b = bh >> 2, h = bh & 3; const long t0 = (long)b * SEQ + c * 64;
        const bf16_t* vp = p.VAT + (((long)(b * 128 + c) * 512 + h * 128 + 32 * (wv >> 1) + l31) * 64 + 8 * hl);
        const bf16x8 vf0 = *(const bf16x8*)vp, vf1 = *(const bf16x8*)(vp + 16), vf2 = *(const bf16x8*)(vp + 32), vf3 = *(const bf16x8*)(vp + 48);
        HgCol col; hgrn_cumsum(p, l, t0, h, tot, col);
        {
            float kv[16];
#pragma unroll
            for (int i = 0; i < 16; ++i) kv[i] = col.kg[i] * __expf(col.bl - col.b[i]);
            uint4 w0, w1;
            w0.x = pack2(kv[0], kv[1]); w0.y = pack2(kv[2], kv[3]); w0.z = pack2(kv[8], kv[9]); w0.w = pack2(kv[10], kv[11]);
            w1.x = pack2(kv[4], kv[5]); w1.y = pack2(kv[6], kv[7]); w1.z = pack2(kv[12], kv[13]); w1.w = pack2(kv[14], kv[15]);
            *(uint4*)(base + swz(k, 2 * sg)) = w0; *(uint4*)(base + swz(k, 2 * sg + 1)) = w1;
            if (sg == 0) p.DEC[u * 128 + k] = __expf(col.bl);
        }
        __syncthreads();
        {
            const int vt = wv >> 1, kt0 = 2 * (wv & 1);
            f32x16 a0, a1;
#pragma unroll
            for (int r = 0; r < 16; ++r) { a0[r] = 0.f; a1[r] = 0.f; }
#pragma unroll
            for (int ks = 0; ks < 4; ++ks) {
                const bf16x8 vf = (ks == 0) ? vf0 : (ks == 1) ? vf1 : (ks == 2) ? vf2 : vf3;
                const bf16x8 k0 = *(const bf16x8*)(base + swz(32 * kt0 + l31, 2 * ks + hl)), k1 = *(const bf16x8*)(base + swz(32 * kt0 + 32 + l31, 2 * ks + hl));
                a0 = __builtin_amdgcn_mfma_f32_32x32x16_bf16(k0, vf, a0, 0, 0, 0);
                a1 = __builtin_amdgcn_mfma_f32_32x32x16_bf16(k1, vf, a1, 0, 0, 0);
            }
            bf16_t* up = p.UT + (long)u * 16384 + (32 * vt + l31) * 128 + 32 * kt0 + 4 * hl;
#pragma unroll
            for (int g = 0; g < 4; ++g) {
                *(uint2*)(up + 8 * g)      = make_uint2(pack2(a0[4 * g], a0[4 * g + 1]), pack2(a0[4 * g + 2], a0[4 * g + 3]));
                *(uint2*)(up + 32 + 8 * g) = make_uint2(pack2(a1[4 * g], a1[4 * g + 1]), pack2(a1[4 * g + 2], a1[4 * g + 3]));
            }
        }
    }
}
DEVI void ph_h2(const P& p) {
    const long gt = (long)BIDX * NT + tidx(), gs = (long)GDIMX * NT;
    for (long e = gt; e < 16 * 8192; e += gs) {
        const int bh = (int)(e >> 13), vk = (int)(e & 8191) * 2, k = vk & 127; float s0 = 0.f, s1 = 0.f;
        uint32_t* up = (uint32_t*)(p.UT + (long)bh * 128 * 16384 + vk); uint32_t* wp_ = p.dry ? (uint32_t*)(p.H + (long)bh * 128 * 16384 + vk) : up; const float* dp = p.DEC + (long)bh * 128 * 128 + k;
#pragma unroll 1
        for (int c0 = 0; c0 < 128; c0 += 16) {
            uint32_t uu[16]; float2 dd[16];
#pragma unroll
            for (int j = 0; j < 16; ++j) { uu[j] = up[(long)(c0 + j) * 8192]; dd[j] = *(const float2*)(dp + (c0 + j) * 128); }
#pragma unroll
            for (int j = 0; j < 16; ++j) { wp_[(long)(c0 + j) * 8192] = pack2(s0, s1); s0 = dd[j].x * s0 + bflo(uu[j]); s1 = dd[j].y * s1 + bfhi(uu[j]); }
        }
    }
}
DEVI void ph_h3(const P& p, int l, float* lds) {
    char* base = (char*)lds;
    const int tid = tidx(), lane = tid & 63, wv = tid >> 6, l31 = lane & 31, hl = lane >> 5, k = tid & 127, sg = tid >> 7;
    float* tot = (float*)(base + 49152); float* part = (float*)(base + 51200);
    for (int u = BIDX; u < 2048; u += GDIMX) {
        const int bh = u >> 7, c = u & 127, b = bh >> 2, h = bh & 3; const long t0 = (long)b * SEQ + c * 64;
        bf16_t qraw[16];
#pragma unroll
        for (int i = 0; i < 16; ++i) { const long gi = (t0 + 16 * sg + i) * 512 + h * 128 + k; qraw[i] = p.QA[gi]; }
        const int vt = wv >> 1, tt = wv & 1;
        const bf16_t* vp = p.VAT + (((long)(b * 128 + c) * 512 + h * 128 + 32 * vt + l31) * 64 + 8 * hl);
        const bf16_t* sp = p.UT + (long)u * 16384 + (32 * vt + l31) * 128 + 8 * hl;
        bf16x8 vfr[4], sfr[8];
        uint2 ggr[4]; float4 gnr[4];
#pragma unroll
        for (int g = 0; g < 4; ++g) { const int v0 = 32 * vt + 8 * g + 4 * hl; ggr[g] = *(const uint2*)(p.GA + (t0 + 32 * tt + l31) * 512 + h * 128 + v0); gnr[g] = *(const float4*)(p.a_gnorm + l * 128 + v0); }
#pragma unroll
        for (int i = 0; i < 4; ++i) vfr[i] = *(const bf16x8*)(vp + 16 * i);
#pragma unroll
        for (int i = 0; i < 8; ++i) sfr[i] = *(const bf16x8*)(sp + 16 * i);
        HgCol col; hgrn_cumsum(p, l, t0, h, tot, col);
#pragma unroll
        for (int i = 0; i < 16; ++i) {
            const int s = 16 * sg + i;
            const float q = bf2f(qraw[i]), ka = col.kg[i];
            const int o = s * 256 + ((((k >> 3) ^ (s & 15)) << 4) | ((k & 7) << 1));
            *(bf16_t*)(base + o)         = f2bf(q * __expf(col.b[i] - col.m));
            *(bf16_t*)(base + 16384 + o) = f2bf(ka * __expf(col.m - col.b[i]));
            *(bf16_t*)(base + 32768 + o) = f2bf(q * __expf(col.b[i]));
        }
        __syncthreads();
        f32x16 o;
#pragma unroll
        for (int r = 0; r < 16; ++r) o[r] = 0.f;
        const int tro = (32 * tt + l31) * 256, trx = l31 & 15;
#pragma unroll
        for (int st = 0; st < 2; ++st) {
            if (st <= tt) {
                f32x16 sacc;
#pragma unroll
                for (int r = 0; r < 16; ++r) sacc[r] = 0.f;
#pragma unroll
                for (int ks = 0; ks < 8; ++ks) {
                    const bf16x8 kf = *(const bf16x8*)(base + 16384 + (32 * st + l31) * 256 + (((2 * ks + hl) ^ trx) << 4));
                    const bf16x8 qf = *(const bf16x8*)(base + tro + (((2 * ks + hl) ^ trx) << 4));
                    sacc = __builtin_amdgcn_mfma_f32_32x32x16_bf16(kf, qf, sacc, 0, 0, 0);
                }
                float ps[16];
#pragma unroll
                for (int r = 0; r < 16; ++r) { const int sl = (r & 3) + 8 * (r >> 2) + 4 * hl; ps[r] = (st < tt || sl <= l31) ? sacc[r] : 0.f; }
#pragma unroll
                for (int s_ = 0; s_ < 2; ++s_) {
                    union { bf16x8 v; uint32_t w[4]; } pf;
#pragma unroll
                    for (int e = 0; e < 4; ++e) pf.w[e] = pack2(ps[8 * s_ + 2 * e], ps[8 * s_ + 2 * e + 1]);
                    const bf16x8 vf = vfr[2 * st + s_];
                    o = __builtin_amdgcn_mfma_f32_32x32x16_bf16(vf, pf.v, o, 0, 0, 0);
                }
            }
        }
        {
#pragma unroll
            for (int ks = 0; ks < 8; ++ks) {
                const bf16x8 sf = sfr[ks];
                const bf16x8 qf = *(const bf16x8*)(base + 32768 + tro + (((2 * ks + hl) ^ trx) << 4));
                o = __builtin_amdgcn_mfma_f32_32x32x16_bf16(sf, qf, o, 0, 0, 0);
            }
        }
        float ss = 0.f;
#pragma unroll
        for (int r = 0; r < 16; ++r) ss += o[r] * o[r];
        ss += __int_as_float(__builtin_amdgcn_ds_bpermute((lane ^ 32) << 2, __float_as_int(ss)));
        if (hl == 0) part[vt * 64 + 32 * tt + l31] = ss;
        __syncthreads();
        const int t = 32 * tt + l31;
        const float rstd = rsqrtf((part[t] + part[64 + t] + part[128 + t] + part[192 + t]) * (1.0f / 128.0f) + EPS);
#pragma unroll
        for (int g = 0; g < 4; ++g) {
            const int v0 = 32 * vt + 8 * g + 4 * hl;
            const float4 gn = gnr[g]; const uint2 gg = ggr[g];
            *(uint2*)(p.H + (t0 + t) * 1024 + h * 128 + v0) = make_uint2(pack2(o[4 * g] * rstd * gn.x * bflo(gg.x), o[4 * g + 1] * rstd * gn.y * bfhi(gg.x)),
                                                                        pack2(o[4 * g + 2] * rstd * gn.z * bflo(gg.y), o[4 * g + 3] * rstd * gn.w * bfhi(gg.y)));
        }
    }
}

DEVI void ph_qproj(const P& p, int l, float* lds) {
    for (int i = 0;; ++i) {
        int tm, tn2, tn; if (!xcd_unit(i, 6, tm, tn2)) break;
        ATile at{p.QL, 256, nullptr, NTOK};
        gemm_unit8(at, tm * 256, p.WQ + ((long)l * 1536 + tn2 * 256) * 256, 256, lds, [&](const tile_t* T, int mr0) __attribute__((always_inline)) NOPK {
            const int row = tidx() >> 2, q = tidx() & 3; const long t = mr0 + row;
            float v[8][4]; epi_load(T, v);
            if (tn < 4) {
                norm_rope128(v, p.b_qnorm + l * 128, (float)p.pos[t], QSCALE, true);
                epi_store_bf16(v, p.QB + t * 512 + tn * 128);
            } else {
                const float posf = (float)p.pos[t]; rope64(v, 0, posf); rope64(v, 4, posf);
                const int h0 = 2 * (tn - 4); const float w0 = p.WIDX[t * 16 + h0], w1 = p.WIDX[t * 16 + h0 + 1];
#pragma unroll
                for (int j = 0; j < 8; ++j)
#pragma unroll
                    for (int i = 0; i < 4; ++i) v[j][i] *= (j < 4) ? w0 : w1;
                epi_store_bf16(v, p.QIDX + t * 1024 + h0 * 64);
            }
        }, tn, 2 * tn2);
    }
}
constexpr int IXCAP = 624;
constexpr int IXSTR = IXCAP + 1;
constexpr int IX_QP = 0, IX_LIST = 69632, IX_CNT = IX_LIST + 32 * IXSTR * 4, IX_CNTN = IX_CNT + 128, IX_THR = IX_CNTN + 128;
typedef LAS unsigned* lds_u32p;
DEVI unsigned lds_add_rtn(unsigned* p, unsigned v) { return __hip_atomic_fetch_add((lds_u32p)p, v, __ATOMIC_RELAXED, __HIP_MEMORY_SCOPE_WORKGROUP); }
DEVI void lds_add(unsigned* p, unsigned v) { (void)__hip_atomic_fetch_add((lds_u32p)p, v, __ATOMIC_RELAXED, __HIP_MEMORY_SCOPE_WORKGROUP); }
DEVI void lds_or(unsigned* p, unsigned v) { (void)__hip_atomic_fetch_or((lds_u32p)p, v, __ATOMIC_RELAXED, __HIP_MEMORY_SCOPE_WORKGROUP); }
DEVI unsigned wmaxu(unsigned v) {
    v = max(v, (unsigned)DPP_I((int)v, (int)v, 0xB1, 0xF)); v = max(v, (unsigned)DPP_I((int)v, (int)v, 0x4E, 0xF)); v = max(v, (unsigned)DPP_I((int)v, (int)v, 0x141, 0xF)); v = max(v, (unsigned)DPP_I((int)v, (int)v, 0x140, 0xF));
    v = max(v, (unsigned)DPP_I((int)v, (int)v, 0x142, 0xA)); v = max(v, (unsigned)DPP_I((int)v, (int)v, 0x143, 0xC));
    return (unsigned)__builtin_amdgcn_readlane((int)v, 63);
}
DEVI unsigned prune256(unsigned* lst_, int n, int lane, bool exact, int& cnt_out) {
    lds_u32p lst = (lds_u32p)lst_;
    unsigned v[10];
#pragma unroll
    for (int j = 0; j < 10; ++j) v[j] = (lane + 64 * j < n) ? lst[lane + 64 * j] : 0u;
    unsigned mx = 0u, mn = 0u;
#pragma unroll
    for (int j = 0; j < 10; ++j) { mx = max(mx, v[j]); mn = max(mn, (lane + 64 * j < n) ? ~v[j] : 0u); }
    mx = wmaxu(mx); mn = ~wmaxu(mn);
    const unsigned diff = mx ^ mn;
    int bit = 31 - __builtin_clz(diff | 1u);
    unsigned thr = (bit >= 31) ? 0u : (mx & ~((2u << bit) - 1u));
    int cnt = n;
    const int hi = exact ? 256 : 320;
#pragma unroll 1
    for (; bit >= 0 && cnt > hi; --bit) {
        const unsigned trial = thr | (1u << bit); int c = 0;
#pragma unroll
        for (int j = 0; j < 10; ++j) c += __builtin_popcountll(__builtin_amdgcn_ballot_w64(v[j] >= trial));
        if (c >= 256) { thr = trial; cnt = c; }
    }
    int basep = 0;
#pragma unroll
    for (int j = 0; j < 10; ++j) {
        const bool keep = v[j] >= thr; const unsigned long long m = __builtin_amdgcn_ballot_w64(keep);
        const int pos = basep + (int)__builtin_amdgcn_mbcnt_hi((unsigned)(m >> 32), __builtin_amdgcn_mbcnt_lo((unsigned)m, 0u));
        if (keep) lst[pos] = v[j];
        basep += __builtin_popcountll(m);
    }
    cnt_out = basep;
    return thr;
}
constexpr int IX_KEEP = IXCAP - 256;
DEVI unsigned prune_bucket(unsigned* lst_, int n, int lane, unsigned* hist  , int& cnt_out) {
    lds_u32p lst = (lds_u32p)lst_; lds_u32p hs = (lds_u32p)hist;
    unsigned v[10];
#pragma unroll
    for (int j = 0; j < 10; ++j) v[j] = (lane + 64 * j < n) ? lst[lane + 64 * j] : 0u;
    unsigned mx = 0u, mn = 0u;
#pragma unroll
    for (int j = 0; j < 10; ++j) { mx = max(mx, v[j]); mn = max(mn, (lane + 64 * j < n) ? ~v[j] : 0u); }
    mx = wmaxu(mx); mn = ~wmaxu(mn);
    const unsigned range = mx - mn;
    const int sh = max(0, 26 - (int)__builtin_clz(range | 1u));
    hs[lane] = 0u;
    __builtin_amdgcn_wave_barrier();
#pragma unroll
    for (int j = 0; j < 10; ++j) if (lane + 64 * j < n) lds_add((unsigned*)(hist + ((v[j] - mn) >> sh)), 1u);
    __builtin_amdgcn_wave_barrier();
    asm volatile("s_waitcnt lgkmcnt(0)" ::: "memory");
    const int suf = wscan_incl((int)hs[63 - lane]);
    const unsigned long long ok = __builtin_amdgcn_ballot_w64(suf >= 256);
    const int i0 = __builtin_ctzll(ok | (1ull << 63));
    const int kept = __builtin_amdgcn_readlane(suf, i0);
    if (kept > IX_KEEP) { return prune256(lst_, n, lane, false, cnt_out); }
    const unsigned thr = mn + ((unsigned)(63 - i0) << sh);
    int basep = 0;
#pragma unroll
    for (int j = 0; j < 10; ++j) {
        const bool keep = v[j] >= thr && (lane + 64 * j < n); const unsigned long long m = __builtin_amdgcn_ballot_w64(keep);
        const int pos = basep + (int)__builtin_amdgcn_mbcnt_hi((unsigned)(m >> 32), __builtin_amdgcn_mbcnt_lo((unsigned)m, 0u));
        if (keep) lst[pos] = v[j];
        basep += __builtin_popcountll(m);
    }
    cnt_out = basep;
    return thr;
}
#define IX_BAR() do { asm volatile("s_waitcnt lgkmcnt(0)\n\ts_barrier" ::: "memory"); if (PROBE_X == 2) asm volatile("s_waitcnt lgkmcnt(0)\n\ts_barrier" ::: "memory"); } while (0)
DEVI void ix_append(const unsigned (&pk)[16], unsigned* CNT, unsigned* LIST, unsigned* THR, int l31, int dry = 0) {
    if (dry >= 4) return;
    const unsigned thrq = THR[l31]; unsigned c2 = 0;
#pragma unroll
    for (int r = 0; r < 16; ++r) c2 += (pk[r] > thrq) ? 1u : 0u;
    if (c2) { unsigned pos = lds_add_rtn(&CNT[l31], c2); lds_u32p lq = (lds_u32p)(LIST + l31 * IXSTR);
#pragma unroll
        for (int r = 0; r < 16; ++r) if (pk[r] > thrq) { lq[dry ? (pos & 511u) : pos] = pk[r]; ++pos; } }
}
DEVI void index_unit(const P& p, int b, int q0, float* lds) {
    char* base = (char*)lds;
    const int tid = tidx(), lane = tid & 63, wv = tid >> 6, l31 = lane & 31, h = lane >> 5;
    const long t0 = (long)b * SEQ + q0; const int L = ((q0 >> 6) + 1) * 64, nw = L >> 5;
    if (L <= 256) { for (int e = tid; e < 32 * nw; e += NT) p.MASK[(t0 + e / nw) * 256 + (e % nw)] = 0xFFFFFFFFu; return; }
    unsigned* LIST = (unsigned*)(base + IX_LIST); unsigned* CNT = (unsigned*)(base + IX_CNT); unsigned* CNTN = (unsigned*)(base + IX_CNTN); unsigned* THR = (unsigned*)(base + IX_THR);
    unsigned* BIG = THR + 32; unsigned* HIST = THR + 64;
    __syncthreads();
#pragma unroll
    for (int i = 0; i < 8; ++i) { const int c = tid + 512 * i, qy = c >> 7, rem = c & 127, hd = rem >> 3, ch = rem & 7;
        *(uint4*)(base + IX_QP + swz(hd * 32 + qy, ch)) = *(const uint4*)(p.QIDX + (t0 + qy) * 1024 + hd * 64 + ch * 8); }
    if (tid < 256) {
        const int qy = tid >> 3, ch = tid & 7; float a[8];
#pragma unroll
        for (int e = 0; e < 8; ++e) a[e] = 0.f;
#pragma unroll 4
        for (int hd = 0; hd < 16; ++hd) { const uint4 w = *(const uint4*)(p.QIDX + (t0 + qy) * 1024 + hd * 64 + ch * 8);
            a[0] += bflo(w.x); a[1] += bfhi(w.x); a[2] += bflo(w.y); a[3] += bfhi(w.y); a[4] += bflo(w.z); a[5] += bfhi(w.z); a[6] += bflo(w.w); a[7] += bfhi(w.w); }
        uint4 o; o.x = pack2(a[0], a[1]); o.y = pack2(a[2], a[3]); o.z = pack2(a[4], a[5]); o.w = pack2(a[6], a[7]);
        *(uint4*)(base + IX_QP + swz(512 + qy, ch)) = o;
    }
    if (tid < 32) { CNT[tid] = 0u; CNTN[tid] = 0u; THR[tid] = 0u; }
    if (tid == 0) *BIG = 0u;
    unsigned sgbits = 0u;
    { const float4* wp = (const float4*)(p.WIDX + (t0 + l31) * 16);
#pragma unroll
      for (int g = 0; g < 4; ++g) { const float4 w = wp[g]; sgbits |= (w.x < 0.f ? 1u : 0u) << (4 * g); sgbits |= (w.y < 0.f ? 2u : 0u) << (4 * g); sgbits |= (w.z < 0.f ? 4u : 0u) << (4 * g); sgbits |= (w.w < 0.f ? 8u : 0u) << (4 * g); } }
    __syncthreads();
    const int ntile = (L + 511) >> 9;
    const bf16_t* kbase = p.KIDX + ((long)b * SEQ + 64 * wv + l31) * 64 + 8 * h;
    const int boff = IX_QP + l31 * 128, bx = (l31 >> 1) & 7;
    bf16x8 a0, a1, a2, a3, e0, e1, e2, e3;
#define IX_LDA(KP) { const bf16_t* kp_ = (KP); a0 = *(const bf16x8*)kp_; a1 = *(const bf16x8*)(kp_ + 16); a2 = *(const bf16x8*)(kp_ + 32); a3 = *(const bf16x8*)(kp_ + 48); \
                     e0 = *(const bf16x8*)(kp_ + 2048); e1 = *(const bf16x8*)(kp_ + 2064); e2 = *(const bf16x8*)(kp_ + 2080); e3 = *(const bf16x8*)(kp_ + 2096); }
    if (64 * wv < L) IX_LDA(kbase)
#pragma unroll 1
    for (int kt = 0; kt < ntile; ++kt) {
        const int key0 = kt * 512 + 64 * wv; const bool active = key0 < L;
        const bf16x8 c0 = a0, c1 = a1, c2 = a2, c3 = a3, d0 = e0, d1 = e1, d2 = e2, d3 = e3;
        if (key0 + 512 < L) IX_LDA(kbase + (long)(kt + 1) * 512 * 64)
        unsigned pk0[16], pk1[16];
        int boffv = boff; asm volatile("" : "+v"(boffv));
        if (active) {
            f32x16 s0, s1;
#pragma unroll
            for (int r = 0; r < 16; ++r) { s0[r] = 0.f; s1[r] = 0.f; }
#define IX_CHAIN(ACC0, ACC1, BP) { const bf16x8 q0_ = *(const bf16x8*)((BP) + (((0 + h) ^ bx) << 4)), q1_ = *(const bf16x8*)((BP) + (((2 + h) ^ bx) << 4)); \
              const bf16x8 q2_ = *(const bf16x8*)((BP) + (((4 + h) ^ bx) << 4)), q3_ = *(const bf16x8*)((BP) + (((6 + h) ^ bx) << 4)); \
              ACC0 = __builtin_amdgcn_mfma_f32_32x32x16_bf16(c0, q0_, ACC0, 0, 0, 0); ACC1 = __builtin_amdgcn_mfma_f32_32x32x16_bf16(d0, q0_, ACC1, 0, 0, 0); \
              ACC0 = __builtin_amdgcn_mfma_f32_32x32x16_bf16(c1, q1_, ACC0, 0, 0, 0); ACC1 = __builtin_amdgcn_mfma_f32_32x32x16_bf16(d1, q1_, ACC1, 0, 0, 0); \
              ACC0 = __builtin_amdgcn_mfma_f32_32x32x16_bf16(c2, q2_, ACC0, 0, 0, 0); ACC1 = __builtin_amdgcn_mfma_f32_32x32x16_bf16(d2, q2_, ACC1, 0, 0, 0); \
              ACC0 = __builtin_amdgcn_mfma_f32_32x32x16_bf16(c3, q3_, ACC0, 0, 0, 0); ACC1 = __builtin_amdgcn_mfma_f32_32x32x16_bf16(d3, q3_, ACC1, 0, 0, 0); }
            IX_CHAIN(s0, s1, base + boffv + 16 * 4096)
#pragma unroll 2
            for (int hd = 0; hd < 16; ++hd) {
                const float sgf = ((sgbits >> hd) & 1u) ? -1.f : 1.f;
                f32x16 u0, u1;
#pragma unroll
                for (int r = 0; r < 16; ++r) { u0[r] = 0.f; u1[r] = 0.f; }
                IX_CHAIN(u0, u1, base + boffv + hd * 4096)
#pragma unroll
                for (int r = 0; r < 16; ++r) { s0[r] = __builtin_fmaf(sgf, __builtin_fabsf(u0[r]), s0[r]); s1[r] = __builtin_fmaf(sgf, __builtin_fabsf(u1[r]), s1[r]); }
            }
#undef IX_CHAIN
            if (p.dry == 2) { float mxs = s0[0];
#pragma unroll
                for (int r = 1; r < 16; ++r) mxs = fmaxf(mxs, fmaxf(s0[r], s1[r]));
                if (mxs == 1.2345e30f) p.MASK[0] = 1u; }
            const unsigned thrq = (p.dry == 2) ? 0xFFFFFFFFu : THR[l31]; int c = 0;
#pragma unroll
            for (int r = 0; r < 16; ++r) { const unsigned ko = (unsigned)(key0 + (r & 3) + 8 * (r >> 2) + 4 * h);
                pk0[r] = (ordf(s0[r]) & 0xFFFFE000u) | ko; pk1[r] = (ordf(s1[r]) & 0xFFFFE000u) | (ko + 32u);
                c += (pk0[r] > thrq) ? 1 : 0; c += (pk1[r] > thrq) ? 1 : 0; }
            if (c) lds_add(&CNTN[l31], (unsigned)c);
        } else {
#pragma unroll
            for (int r = 0; r < 16; ++r) { pk0[r] = 0u; pk1[r] = 0u; }
        }
        if (p.dry == 2) continue;
        IX_BAR();
#pragma unroll 1
        for (int qq = wv; qq < 32; qq += 8) {
            const int n = (int)CNT[qq], nn = (int)CNTN[qq];
            if (n + nn > IXCAP && p.dry < 3) { int kept; unsigned T = prune_bucket(LIST + qq * IXSTR, n, lane, HIST + 64 * wv, kept); if (PROBE_X == 1) T = prune_bucket(LIST + qq * IXSTR, kept, lane, HIST + 64 * wv, kept); if (lane == 0) { CNT[qq] = (unsigned)kept; THR[qq] = T; if (nn > IXCAP - IX_KEEP) *BIG = 1u; } }
            if (lane == 0) CNTN[qq] = 0u;
        }
        IX_BAR();
        const unsigned big = *BIG;
        if (active) ix_append(pk0, CNT, LIST, THR, l31, p.dry >= 3 ? p.dry : 0);
        if (big) {
            if (active) { const unsigned thrq = THR[l31]; unsigned c = 0;
#pragma unroll
                for (int r = 0; r < 16; ++r) c += (pk1[r] > thrq) ? 1u : 0u;
                if (c) lds_add(&CNTN[l31], c); }
            IX_BAR();
#pragma unroll 1
            for (int qq = wv; qq < 32; qq += 8) {
                const int n = (int)CNT[qq], nn = (int)CNTN[qq];
                if (n + nn > IXCAP && p.dry < 3) { int kept; const unsigned T = prune_bucket(LIST + qq * IXSTR, n, lane, HIST + 64 * wv, kept); if (lane == 0) { CNT[qq] = (unsigned)kept; THR[qq] = T; } }
                if (lane == 0) CNTN[qq] = 0u;
            }
            if (tid == 0) *BIG = 0u;
            IX_BAR();
        }
        if (active) ix_append(pk1, CNT, LIST, THR, l31, p.dry >= 3 ? p.dry : 0);
    }
#undef IX_LDA
    __syncthreads();
    if (p.dry >= 2) return;
    if (p.dry == 1 && PROBE_DRY6 == 1 && (PROBE_MASK & 0x100000u)) return;
#pragma unroll 1
    for (int qq = wv; qq < 32; qq += 8) { const int n = (int)CNT[qq]; if (n > 256) { int kept; (void)prune256(LIST + qq * IXSTR, n, lane, true, kept); } }
    unsigned* MR = (unsigned*)(base + IX_QP);
    for (int e = tid; e < 32 * 256; e += NT) MR[e] = 0u;
    __syncthreads();
#pragma unroll 1
    for (int qq = wv; qq < 32; qq += 8) {
#pragma unroll
        for (int j = 0; j < 4; ++j) { const unsigned idx = LIST[qq * IXSTR + lane + 64 * j] & 0x1FFFu; lds_or(&MR[qq * 256 + (idx >> 5)], 1u << (idx & 31u)); }
    }
    __syncthreads();
    for (int e = tid; e < 32 * nw; e += NT) { const int qy = e / nw, w = e % nw; p.MASK[(t0 + qy) * 256 + w] = MR[qy * 256 + w]; }
}
DEVI void ph_indexer(const P& p, float* lds) {
    for (int w = BIDX; w < 256; w += GDIMX) {
        const int b = w >> 6, j = w & 63;
#pragma unroll 1
        for (int ui = 0; ui < 4; ++ui) {
            const int blk = (ui == 0) ? j : (ui == 1) ? 127 - j : (ui == 2) ? 128 + j : 255 - j;
            index_unit(p, b, blk * 32, lds);
        }
    }
}
DEVI float gain_bound(const float* gq, const float* gk) {
    float a = 0.f, b = 0.f;
    for (int i = 0; i < 128; ++i) { a = fmaxf(a, fabsf(gq[i])); b = fmaxf(b, fabsf(gk[i])); }
    return -(16.33f * a * b + 0.25f);
}
DEVI void attn_unit(const bf16_t* Qp, int ldq, const bf16_t* Kb, const bf16_t* VTb, const unsigned* maskp, bf16_t* Op, int ldo, int nt, int wave_nt, float negB, float* lds) {
    char* base = (char*)lds;
    const int tid = tidx(), lane = tid & 63, wv = tid >> 6, l31 = lane & 31, h = lane >> 5;
    bf16x8 qf[8];
    { const bf16_t* qr = Qp + (long)(32 * wv + l31) * ldq + 8 * h;
#pragma unroll
      for (int ks = 0; ks < 8; ++ks) qf[ks] = *(const bf16x8*)(qr + 16 * ks); }
    const unsigned* mrow = maskp ? maskp + (long)(32 * wv + l31) * 256 : nullptr;
    const bf16_t* kdp[4]; const bf16_t* vdp[2];
#pragma unroll
    for (int i = 0; i < 4; ++i) { const int row = 16 * wv + 4 * i + (lane >> 4), ch = (lane & 15) ^ (row & 15); kdp[i] = Kb + (long)row * 512 + ch * 8; }
#pragma unroll
    for (int i = 0; i < 2; ++i) { const int row = 16 * wv + 8 * i + (lane >> 3), ch = (lane & 7) ^ ((row >> 1) & 7); vdp[i] = VTb + (long)row * 64 + ch * 8; }
    const int kdo = wv * 4096 + lane * 16, vdo = 32768 + wv * 2048 + lane * 16;
    const int kr = l31 * 256, kx = l31 & 15;
    f32x16 o0, o1, o2, o3;
#pragma unroll
    for (int r = 0; r < 16; ++r) { o0[r] = 0.f; o1[r] = 0.f; o2[r] = 0.f; o3[r] = 0.f; }
    float rsum = 0.f;
    const int ns = nt >> 1;
#define ATT_DMA(S, ST) { const long ko_ = (long)(S) * 128 * 512, vo_ = (long)(S) * 2 * 512 * 64; \
        GLDS16(kdp[0] + ko_, base + (ST) + kdo); GLDS16(kdp[1] + ko_, base + (ST) + kdo + 1024); GLDS16(kdp[2] + ko_, base + (ST) + kdo + 2048); GLDS16(kdp[3] + ko_, base + (ST) + kdo + 3072); \
        GLDS16(vdp[0] + vo_, base + (ST) + vdo); GLDS16(vdp[1] + vo_, base + (ST) + vdo + 1024); \
        GLDS16(vdp[0] + vo_ + 512 * 64, base + (ST) + vdo + 16384); GLDS16(vdp[1] + vo_ + 512 * 64, base + (ST) + vdo + 16384 + 1024); }
    __syncthreads();
    ATT_DMA(0, 0)
    asm volatile("s_waitcnt vmcnt(0)\n\ts_barrier" ::: "memory");
    uint4 mwn = make_uint4(0xFFFFFFFFu, 0xFFFFFFFFu, 0xFFFFFFFFu, 0xFFFFFFFFu);
    if (mrow && wave_nt > 0) mwn = *(const uint4*)mrow;
#pragma unroll 1
    for (int sp = 0; sp < ns; ++sp) {
        const int st = (sp & 1) * 65536, sn = 65536 - st;
        const bool more = (sp + 1) < ns;
        const uint4 mw = mwn;
        if (mrow && 2 * (sp + 1) < wave_nt) mwn = *(const uint4*)(mrow + 4 * (sp + 1));
        if (more) ATT_DMA(sp + 1, sn)
#define ATT_BIAS(S, W) { _Pragma("unroll") for (int r = 0; r < 16; ++r) { const unsigned sel = (unsigned)__builtin_amdgcn_sbfe((int)(W), (r & 3) + 8 * (r >> 2), 1); \
                          S[r] = __uint_as_float((sel & __float_as_uint(negB)) | (~sel & 0xFF800000u)); } }
#define ATT_QK(S, KK, J) { _Pragma("unroll") for (int ks = 0; ks < 8; ++ks) { const bf16x8 kf = *(const bf16x8*)(base + st + (J) * 16384 + (KK) * 8192 + kr + (((2 * ks + h) ^ kx) << 4)); \
                          S = __builtin_amdgcn_mfma_f32_32x32x16_bf16(kf, qf[ks], S, 0, 0, 0); } }
#define ATT_PV(S, KK, J) { float ps[16]; _Pragma("unroll") for (int r = 0; r < 16; ++r) { ps[r] = __builtin_amdgcn_exp2f(S[r]); rsum += ps[r]; } \
                        _Pragma("unroll") for (int s_ = 0; s_ < 2; ++s_) { union { bf16x8 v; uint32_t u[4]; } pf; \
                            _Pragma("unroll") for (int e = 0; e < 4; ++e) pf.u[e] = pack2(ps[8 * s_ + 2 * e], ps[8 * s_ + 2 * e + 1]); \
                            const int vo = st + 32768 + (J) * 16384 + l31 * 128 + ((((2 * (2 * (KK) + s_) + h)) ^ ((l31 >> 1) & 7)) << 4); \
                            o0 = __builtin_amdgcn_mfma_f32_32x32x16_bf16(*(const bf16x8*)(base + vo), pf.v, o0, 0, 0, 0); \
                            o1 = __builtin_amdgcn_mfma_f32_32x32x16_bf16(*(const bf16x8*)(base + vo + 4096), pf.v, o1, 0, 0, 0); \
                            o2 = __builtin_amdgcn_mfma_f32_32x32x16_bf16(*(const bf16x8*)(base + vo + 8192), pf.v, o2, 0, 0, 0); \
                            o3 = __builtin_amdgcn_mfma_f32_32x32x16_bf16(*(const bf16x8*)(base + vo + 12288), pf.v, o3, 0, 0, 0); } }
#define ATT_SUB(J, W0, W1) if (2 * sp + (J) < wave_nt) { f32x16 sa, sb; \
            ATT_BIAS(sa, (W0) >> (4 * h)) ATT_BIAS(sb, (W1) >> (4 * h)) \
            __builtin_amdgcn_s_setprio(1); ATT_QK(sa, 0, J) ATT_QK(sb, 1, J) __builtin_amdgcn_s_setprio(0); \
            __builtin_amdgcn_sched_barrier(0); ATT_PV(sa, 0, J) __builtin_amdgcn_sched_barrier(0); ATT_PV(sb, 1, J) }
        ATT_SUB(0, mw.x, mw.y)
        ATT_SUB(1, mw.z, mw.w)
#undef ATT_SUB
#undef ATT_BIAS
#undef ATT_QK
#undef ATT_PV
        asm volatile("s_waitcnt vmcnt(0) lgkmcnt(0)\n\ts_barrier" ::: "memory");
    }
#undef ATT_DMA
    rsum += __int_as_float(__builtin_amdgcn_ds_bpermute((lane ^ 32) << 2, __float_as_int(rsum)));
    const float inv = 1.0f / rsum;
    bf16_t* orow = Op + (long)(32 * wv + l31) * ldo + 4 * h;
#pragma unroll
    for (int g = 0; g < 4; ++g) {
        *(uint2*)(orow + 8 * g)      = make_uint2(pack2(o0[4 * g] * inv, o0[4 * g + 1] * inv), pack2(o0[4 * g + 2] * inv, o0[4 * g + 3] * inv));
        *(uint2*)(orow + 32 + 8 * g) = make_uint2(pack2(o1[4 * g] * inv, o1[4 * g + 1] * inv), pack2(o1[4 * g + 2] * inv, o1[4 * g + 3] * inv));
        *(uint2*)(orow + 64 + 8 * g) = make_uint2(pack2(o2[4 * g] * inv, o2[4 * g + 1] * inv), pack2(o2[4 * g + 2] * inv, o2[4 * g + 3] * inv));
        *(uint2*)(orow + 96 + 8 * g) = make_uint2(pack2(o3[4 * g] * inv, o3[4 * g + 1] * inv), pack2(o3[4 * g + 2] * inv, o3[4 * g + 3] * inv));
    }
}
DEVI void ph_dsa_attn(const P& p, int l, float* lds) {
    const float negB = gain_bound(p.b_qnorm + l * 128, p.b_knorm + l * 128);
    const int wv = tidx() >> 6;
    for (int w = BIDX; w < 256; w += GDIMX) {
        const int combo = w & 15, b = combo >> 2, head = combo & 3, pr = w >> 4;
#pragma unroll 1
        for (int side = 0; side < 2; ++side) {
            const int qb = side ? 31 - pr : pr; const long t0 = (long)b * SEQ + qb * 256;
            attn_unit(p.QB + t0 * 512 + head * 128, 512, p.KB + (long)b * SEQ * 512 + head * 128, p.VT + ((long)b * 128 * 512 + head * 128) * 64, p.MASK + t0 * 256,
                      p.H + t0 * 1024 + 512 + head * 128, 1024, 4 * qb + 4, 4 * qb + (wv >> 1) + 1, negB, lds);
        }
    }
}
DEVI void ph_xattn(const P& p, int l, float* lds) {
    const float negB = gain_bound(p.x_qnorm + l * 128, p.x_knorm + l * 128);
    for (int u = BIDX; u < 512; u += GDIMX) {
        const int combo = u & 15, b = combo >> 2, head = combo & 3, qb = u >> 4; const long t0 = (long)b * SEQ + qb * 256;
        attn_unit(p.QX + t0 * 512 + head * 128, 512, p.XK + ((long)(l * 4 + b) * 256) * 512 + head * 128, p.XVT + ((long)(l * 4 + b) * 4 * 512 + head * 128) * 64, nullptr,
                  p.OX + t0 * 512 + head * 128, 512, 4, 4, negB, lds);
    }
}

DEVI void resid_epi_unit(const float* rsrc, float* dst, const tile_t* T, int m0, int tn_base) {
    const int row = tidx() >> 2, q = tidx() & 3;
    float4 cur[8], nxt[8];
    { const float* rp = rsrc + (long)(m0 + row) * DM + tn_base * 128 + 4 * q;
#pragma unroll
      for (int j = 0; j < 8; ++j) cur[j] = *(const float4*)(rp + 16 * j); }
#pragma unroll
    for (int sub = 0; sub < 4; ++sub) {
        if (sub < 3) { const int ns = sub + 1; const float* np = rsrc + (long)(m0 + 128 * (ns >> 1) + row) * DM + (tn_base + (ns & 1)) * 128 + 4 * q;
#pragma unroll
            for (int j = 0; j < 8; ++j) nxt[j] = *(const float4*)(np + 16 * j); }
        const tile_t* Ts = T + (sub >> 1) * 128 * TLD + 128 * (sub & 1);
        float* op = dst + (long)(m0 + 128 * (sub >> 1) + row) * DM + (tn_base + (sub & 1)) * 128 + 4 * q;
#pragma unroll
        for (int j = 0; j < 8; ++j) { const float4 t = t_ld4(Ts, row * TLD + 16 * j + 4 * q); float4 o = cur[j];
            o.x += t.x; o.y += t.y; o.z += t.z; o.w += t.w; *(float4*)(op + 16 * j) = o; }
#pragma unroll
        for (int j = 0; j < 8; ++j) cur[j] = nxt[j];
    }
}
DEVI void ph_outproj(const P& p, int l, float* lds) {
    for (int i = 0;; ++i) {
        int tm, tn2, tn; if (!xcd_unit(i, 4, tm, tn2)) break;
        ATile at{p.H, DM, nullptr, NTOK};
        gemm_unit8(at, tm * 256, p.WOUT + ((long)l * DM + tn2 * 256) * DM, DM, lds, [&](const tile_t* T, int mr0) __attribute__((always_inline)) NOPK {
            resid_epi_unit((l == 0) ? p.x : p.out, p.out, T, mr0, tn);
        }, tn, 2 * tn2, 0, true);
    }
}
DEVI void ph_xq(const P& p, int l, float* lds) {
    for (int i = 0;; ++i) {
        int tm, tn2, tn; if (!xcd_unit(i, 2, tm, tn2)) break;
        ATile at{p.H, DM, nullptr, NTOK};
        gemm_unit8(at, tm * 256, p.XWQ + ((long)l * 512 + tn2 * 256) * DM, DM, lds, [&](const tile_t* T, int mr0) __attribute__((always_inline)) NOPK {
            float v[8][4]; epi_load(T, v);
            norm_rope128(v, p.x_qnorm + l * 128, 0.f, QSCALE, false);
            epi_store_bf16(v, p.QX + (long)(mr0 + (tidx() >> 2)) * 512 + tn * 128);
        }, tn, 2 * tn2);
    }
}
DEVI void ph_xo(const P& p, int l, float* lds) {
    for (int i = 0;; ++i) {
        int tm, tn2, tn; if (!xcd_unit(i, 4, tm, tn2)) break;
        ATile at{p.OX, 512, nullptr, NTOK};
        gemm_unit8(at, tm * 256, p.XWO + ((long)l * DM + tn2 * 256) * 512, 512, lds, [&](const tile_t* T, int mr0) __attribute__((always_inline)) NOPK {
            resid_epi_unit(p.out, p.out, T, mr0, tn);
        }, tn, 2 * tn2, 0, true);
    }
}
DEVI bool moe_unit(const int* cnt, int u, int tilesN, int& e, int& tm, int& tn, int& base) {
    int acc = 0, rb = 0;
    for (int i = 0; i < 16; ++i) { const int tiles = (cnt[i] + 255) >> 8; if (u < acc + tiles * tilesN) { e = i; const int r = u - acc; tm = r / tilesN; tn = r % tilesN; base = rb; return true; } acc += tiles * tilesN; rb += tiles * 256; }
    return false;
}
DEVI void ph_moe_gu(const P& p, int l, float* lds) {
    const int* cnt = p.CNT + l * 16;
    for (int u = BIDX;; u += GDIMX) {
        int e, tm, tn2, tn, base; if (!moe_unit(cnt, u, 2, e, tm, tn2, base)) break;
        const int ce = cnt[e];
        ATile at{p.H, DM, p.LTOK + (long)e * NTOK, ce};
        gemm_unit8(at, tm * 256, p.WGU + (((long)l * 16 + e) * 512 + tn2 * 256) * DM, DM, lds, [&](const tile_t* T, int mr0) __attribute__((always_inline)) NOPK {
            const int row = tidx() >> 2, q = tidx() & 3, r = mr0 + row;
            const float gate = (r < ce) ? p.LGATE[(long)e * NTOK + r] : 0.f;
            bf16_t* op = p.ACT + (long)(base + r) * 256 + tn * 64;
#pragma unroll
            for (int j = 0; j < 4; ++j) { const float4 g = t_ld4(T, row * TLD + 16 * j + 4 * q), uu = t_ld4(T, row * TLD + 64 + 16 * j + 4 * q);
                *(uint2*)(op + 16 * j + 4 * q) = make_uint2(pack2(siluf(g.x) * uu.x * gate, siluf(g.y) * uu.y * gate), pack2(siluf(g.z) * uu.z * gate, siluf(g.w) * uu.w * gate)); }
        }, tn, 2 * tn2);
    }
}
DEVI void ph_moe_dn(const P& p, int l, float* lds) {
    const int* cnt = p.CNT + l * 16;
    for (int u = BIDX;; u += GDIMX) {
        int e, tm, tn2, tn, base; if (!moe_unit(cnt, u, 4, e, tm, tn2, base)) break;
        const int ce = cnt[e];
        ATile at{p.ACT + (long)base * 256, 256, nullptr, ((ce + 255) >> 8) * 256};
        gemm_unit8(at, tm * 256, p.WDN + (((long)l * 16 + e) * DM + tn2 * 256) * 256, 256, lds, [&](const tile_t* T, int mr0) __attribute__((always_inline)) NOPK {
            const int row = tidx() >> 2, q = tidx() & 3, r = mr0 + row;
            if (r < ce) { bf16_t* op = p.Y + (long)p.LSLOT[(long)e * NTOK + r] * DM + tn * 128;
#pragma unroll
                for (int j = 0; j < 8; ++j) { const float4 t = t_ld4(T, row * TLD + 16 * j + 4 * q);
                    *(uint2*)(op + 16 * j + 4 * q) = make_uint2(pack2(t.x, t.y), pack2(t.z, t.w)); } }
        }, tn, 2 * tn2);
    }
}

DEVI void ph_final(const P& p) {
    const long gt = (long)BIDX * NT + tidx(), gs = (long)GDIMX * NT;
    for (long i = gt; i < (long)NTOK * DM / 4; i += gs) {
        const long row = i >> 8; const int c4 = (int)(i & 255);
        float4 v = ((const float4*)p.out)[i];
        const uint2 a = ((const uint2*)(p.Y + (2 * row) * DM))[c4], b = ((const uint2*)(p.Y + (2 * row + 1) * DM))[c4];
        v.x = (v.x + bflo(a.x)) + bflo(b.x); v.y = (v.y + bfhi(a.x)) + bfhi(b.x); v.z = (v.z + bflo(a.y)) + bflo(b.y); v.w = (v.w + bfhi(a.y)) + bfhi(b.y);
        ((float4*)p.out)[i] = v;
    }
}
constexpr int NPH_PRO = 2, NPH_LAYER = 15;
#ifndef PHSEL
#define PHSEL 0xFFFFFFFFu
#endif
template <int PH> DEVI void run_phase(int l, float* lds, int dry = 0) {
    if (PH < 32 && !((PHSEL >> PH) & 1u)) return;
    asm volatile("; PHASE_BEGIN %0" :: "n"(PH));
    P p = make_P(kargs()); p.dry = dry; if (dry && (PH == 8 || PH == 12)) p.out = p.out_dry;
    if (PH == 100) ph_pro_a(p, lds);
    if (PH == 101) ph_pro_b(p, lds);
    if (PH == 0) { if (l == 0) ph_norm<false, false, true>(p, p.norm_mix + l * DM, l); else if (p.dry) ph_norm<false, false>(p, p.norm_mix + l * DM, l); else ph_norm<false, true>(p, p.norm_mix + l * DM, l); }
    if (PH == 16) ph_final(p);
    if (PH == 1) ph_inproj(p, l, lds);
    if (PH == 2) ph_h1(p, l, lds);
    if (PH == 3) ph_h2(p);
    if (PH == 4) ph_h3(p, l, lds);
    if (PH == 5) ph_qproj(p, l, lds);
    if (PH == 6) ph_indexer(p, lds);
    if (PH == 7) ph_dsa_attn(p, l, lds);
    if (PH == 8) ph_outproj(p, l, lds);
    if (PH == 9) ph_norm<false>(p, p.norm_x + l * DM, l);
    if (PH == 10) ph_xq(p, l, lds);
    if (PH == 11) ph_xattn(p, l, lds);
    if (PH == 12) ph_xo(p, l, lds);
    if (PH == 13) ph_norm<true>(p, p.norm_ffn + l * DM, l);
    if (PH == 14) ph_moe_gu(p, l, lds);
    if (PH == 15) ph_moe_dn(p, l, lds);
}

DEVI void grid_sync(float* lds) {
    XcdBarrier b; b.bar = (unsigned*)(kargs()->ws + WS_BAR); b.x = xb_xcc_id(); b.st = (volatile LAS unsigned*)(lds + (LDS_BYTES / 4) - 4);
    xcd_barrier(b);
}
#if MK_LAUNCHES == 0
template <int PH> __global__ void NOPK __launch_bounds__(NT, 2) k_phase(KArgs a, int l) {
    extern __shared__ __attribute__((aligned(16))) float lds[];
    (void)a;
    run_phase<PH>(l, lds);
}
#else

__global__ void NOPK __launch_bounds__(NT, 2) k_mega(KArgs a) {
    extern __shared__ __attribute__((aligned(16))) float lds[];
    (void)a;
    uint4* xbw = (uint4*)(lds + (LDS_BYTES / 4) - 4);
    if (tidx() == 0) *xbw = make_uint4(0u, 0u, 0u, 0u);
    __syncthreads();
    (void)xcd_barrier_post((unsigned*)(kargs()->ws + WS_BAR), (volatile LAS unsigned*)xbw);
    run_phase<100>(0, lds); grid_sync(lds); if (PROBE_MASK & (1u << 16)) { run_phase<100>(0, lds, 0); grid_sync(lds); }
    run_phase<101>(0, lds); if (PROBE_MASK & (1u << 17)) { grid_sync(lds); run_phase<101>(0, lds, 0); }
    for (int l = 0; l < 2; ++l) {
        run_phase<0>(l, lds); grid_sync(lds); if (PROBE_MASK & (1u << 0)) { run_phase<0>(l, lds, 1); grid_sync(lds); }
        run_phase<1>(l, lds); grid_sync(lds); if (PROBE_MASK & (1u << 1)) { run_phase<1>(l, lds, PROBE_DRY6); grid_sync(lds); }
        run_phase<2>(l, lds); grid_sync(lds); if (PROBE_MASK & (1u << 2)) { run_phase<2>(l, lds, 1); grid_sync(lds); }
        run_phase<3>(l, lds); grid_sync(lds); if (PROBE_MASK & (1u << 3)) { run_phase<3>(l, lds, 1); grid_sync(lds); }
        run_phase<4>(l, lds); grid_sync(lds); if (PROBE_MASK & (1u << 4)) { run_phase<4>(l, lds, 1); grid_sync(lds); }
        run_phase<5>(l, lds); grid_sync(lds); if (PROBE_MASK & (1u << 5)) { run_phase<5>(l, lds, 1); grid_sync(lds); }
        run_phase<6>(l, lds); grid_sync(lds); if (PROBE_MASK & (1u << 6)) { run_phase<6>(l, lds, PROBE_DRY6); grid_sync(lds); }
        run_phase<7>(l, lds); grid_sync(lds); if (PROBE_MASK & (1u << 7)) { run_phase<7>(l, lds, 1); grid_sync(lds); }
        run_phase<8>(l, lds); grid_sync(lds); if (PROBE_MASK & (1u << 8)) { run_phase<8>(l, lds, 1); grid_sync(lds); }
        run_phase<9>(l, lds); grid_sync(lds); if (PROBE_MASK & (1u << 9)) { run_phase<9>(l, lds, 1); grid_sync(lds); }
        run_phase<10>(l, lds); grid_sync(lds); if (PROBE_MASK & (1u << 10)) { run_phase<10>(l, lds, 1); grid_sync(lds); }
        run_phase<11>(l, lds); grid_sync(lds); if (PROBE_MASK & (1u << 11)) { run_phase<11>(l, lds, 1); grid_sync(lds); }
        run_phase<12>(l, lds); grid_sync(lds); if (PROBE_MASK & (1u << 12)) { run_phase<12>(l, lds, 1); grid_sync(lds); }
        run_phase<13>(l, lds); grid_sync(lds); if (PROBE_MASK & (1u << 13)) { run_phase<13>(l, lds, 1); grid_sync(lds); }
        run_phase<14>(l, lds); grid_sync(lds); if (PROBE_MASK & (1u << 14)) { run_phase<14>(l, lds, 1); grid_sync(lds); }
        run_phase<15>(l, lds); grid_sync(lds); if (PROBE_MASK & (1u << 15)) { run_phase<15>(l, lds, 1); grid_sync(lds); }
    }
    run_phase<16>(1, lds);
}
#endif

template <int PH> static void launch_phase(const KArgs& p, int l, hipStream_t stream);

extern "C" void kernel_launch(void* const* d_in, const int* in_sizes, int n_in, void* d_out, int out_size, void* d_ws, size_t ws_size, hipStream_t stream) {
    (void)in_sizes; (void)out_size;
    if (n_in != 29) { fprintf(stderr, "kernel_launch: expected 29 inputs, got %d\n", n_in); return; }
    KArgs p; memset(&p, 0, sizeof(p));
    for (int i = 0; i < 29; ++i) p.in[i] = d_in[i];
    p.out = (float*)d_out; p.ws = (char*)d_ws;
    if (WS_END > ws_size) { fprintf(stderr, "kernel_launch: workspace too small: need %zu, have %zu\n", (size_t)WS_END, ws_size); return; }
    (void)hipMemsetAsync((char*)d_ws + WS_BAR, 0, XCD_BAR_WORDS * 4, stream);
#if MK_LAUNCHES == 0
    launch_phase<100>(p, 0, stream); launch_phase<101>(p, 0, stream);
    for (int l = 0; l < 2; ++l) {
        launch_phase<0>(p, l, stream); launch_phase<1>(p, l, stream); launch_phase<2>(p, l, stream); launch_phase<3>(p, l, stream);
        launch_phase<4>(p, l, stream); launch_phase<5>(p, l, stream); launch_phase<6>(p, l, stream); launch_phase<7>(p, l, stream);
        launch_phase<8>(p, l, stream); launch_phase<9>(p, l, stream); launch_phase<10>(p, l, stream); launch_phase<11>(p, l, stream);
        launch_phase<12>(p, l, stream); launch_phase<13>(p, l, stream); launch_phase<14>(p, l, stream); launch_phase<15>(p, l, stream);
    }
    launch_phase<16>(p, 1, stream);
#else
    static int grid = 0;
    if (grid == 0) {
        int dev = 0, cus = 0;
        if (hipGetDevice(&dev) != hipSuccess || hipDeviceGetAttribute(&cus, hipDeviceAttributeMultiprocessorCount, dev) != hipSuccess) { fprintf(stderr, "kernel_launch: device query failed\n"); grid = -1; return; }
        if (hipFuncSetAttribute((const void*)k_mega, hipFuncAttributeMaxDynamicSharedMemorySize, LDS_BYTES) != hipSuccess) { fprintf(stderr, "kernel_launch: hipFuncSetAttribute failed\n"); grid = -1; return; }
        int per_cu = 0;
        if (hipOccupancyMaxActiveBlocksPerMultiprocessor(&per_cu, (const void*)k_mega, NT, LDS_BYTES) != hipSuccess || per_cu < 1) { fprintf(stderr, "kernel_launch: occupancy query says %d blocks per CU\n", per_cu); (void)hipGetLastError(); }
        grid = cus;
    }
    if (grid < 0) return;
    hipLaunchKernelGGL(k_mega, dim3(grid), dim3(NT), LDS_BYTES, stream, p);
#endif
}
#if MK_LAUNCHES == 0
template <int PH> static void launch_phase(const KArgs& p, int l, hipStream_t stream) {
    static bool once = false;
    if (!once) { (void)hipFuncSetAttribute((const void*)k_phase<PH>, hipFuncAttributeMaxDynamicSharedMemorySize, LDS_BYTES); once = true; }
    hipLaunchKernelGGL(k_phase<PH>, dim3(256), dim3(NT), LDS_BYTES, stream, p, l);
}
#endif
#if defined(__HIP_DEVICE_COMPILE__)
#pragma clang attribute pop
#endif
```

```cpp
#if defined(__HIP_DEVICE_COMPILE__)
#pragma clang attribute push(__attribute__((target("no-packed-fp32-ops"))), apply_to = function)
#endif
#include <hip/hip_runtime.h>
#define TIDX __builtin_amdgcn_workitem_id_x()
#define BIDX __builtin_amdgcn_workgroup_id_x()
#define GDIMX (__builtin_amdgcn_grid_size_x() / 512u)
#include <stdint.h>
#include <stdio.h>
#include <string.h>

#ifndef PROBE_MASK
#define PROBE_MASK 0u
#endif
#ifndef PROBE_DRY6
#define PROBE_DRY6 1
#endif
#ifndef PROBE_X
#define PROBE_X 0
#endif
#ifndef MK_LAUNCHES
#define MK_LAUNCHES 1
#endif

typedef unsigned short bf16_t;
typedef unsigned short tile_t_fwd;
#define NOPK
#define DEVI __device__ __forceinline__ NOPK
#define LAS __attribute__((address_space(3)))

constexpr int NB = 4, SEQ = 8192, NTOK = NB * SEQ, DM = 1024, DIN = 3408;
constexpr int NT = 512;
constexpr int LDS_BYTES = 153600;
constexpr float EPS = 1e-6f;
constexpr float QSCALE = 0.08838834764831845f * 1.4426950408889634f;
constexpr int TLD = 264;

struct P {
    const float *x, *mem; const int* pos;
    const float *norm_mix, *w_in, *lb_raw, *a_gnorm, *b_qlat_gain, *b_wqb, *b_wqidx, *b_qnorm, *b_knorm, *b_kidx_norm,
                *w_out, *norm_x, *norm_mem, *x_wq, *x_wk, *x_wv, *x_wo, *x_qnorm, *x_knorm, *norm_ffn, *w_rg, *b_rg, *w_re, *b_re, *w_gu, *w_dn;
    float* out;
    bf16_t *H, *QA, *VAT, *GA, *UT, *QL, *KB, *VT, *KIDX, *QB, *QIDX, *QX, *OX, *ACT, *XK, *XVT, *MEMN;
    bf16_t* ZF; float *WIDX, *DEC, *COS128, *SIN128, *COS64, *SIN64, *LB, *LGATE;
    unsigned* MASK; int *LTOK, *CNT; unsigned* bar;
    bf16_t *WIN, *WQ, *WOUT, *XWQ, *XWO, *WGU, *WDN, *XWK, *XWV;
    bf16_t* Y; int* LSLOT;
    float* out_dry; int dry;
};


constexpr size_t MiB = 1u << 20;
constexpr size_t WS_BAR = 0, WS_CNT = 16 * 1024, WS_LB = 20 * 1024, WS_DEC = 1 * MiB, WS_COS128 = 2 * MiB, WS_SIN128 = 10 * MiB, WS_COS64 = 18 * MiB, WS_SIN64 = 22 * MiB,
                 WS_XK = 26 * MiB, WS_XVT = 28 * MiB, WS_H = 30 * MiB, WS_QL = 94 * MiB, WS_KB = 110 * MiB, WS_VT = 142 * MiB, WS_KIDX = 174 * MiB, WS_WIDX = 178 * MiB,
                 WS_R1 = 180 * MiB, WS_WIN = 436 * MiB, WS_WQ = WS_WIN + 14 * MiB, WS_WOUT = WS_WQ + 1 * MiB + 512 * 1024, WS_XWQ = WS_WOUT + 4 * MiB,
                 WS_XWO = WS_XWQ + 2 * MiB, WS_WGU = WS_XWO + 2 * MiB, WS_WDN = WS_WGU + 32 * MiB, WS_END = WS_WDN + 16 * MiB;
static_assert(WS_END <= 512 * MiB, "workspace map exceeds the guaranteed 512 MiB");
struct KArgs { const void* in[29]; float* out; char* ws; };
typedef const __attribute__((address_space(4))) KArgs* KArgsPtr;
DEVI KArgsPtr kargs() { KArgsPtr k = (KArgsPtr)__builtin_amdgcn_kernarg_segment_ptr(); asm volatile("" : "+s"(k)); return k; }
DEVI P make_P(KArgsPtr ap) {
    P p;
    p.x = (const float*)ap->in[0]; p.mem = (const float*)ap->in[1]; p.pos = (const int*)ap->in[2];
    p.norm_mix = (const float*)ap->in[3]; p.w_in = (const float*)ap->in[4]; p.lb_raw = (const float*)ap->in[5]; p.a_gnorm = (const float*)ap->in[6]; p.b_qlat_gain = (const float*)ap->in[7];
    p.b_wqb = (const float*)ap->in[8]; p.b_wqidx = (const float*)ap->in[9]; p.b_qnorm = (const float*)ap->in[10]; p.b_knorm = (const float*)ap->in[11]; p.b_kidx_norm = (const float*)ap->in[12];
    p.w_out = (const float*)ap->in[13]; p.norm_x = (const float*)ap->in[14]; p.norm_mem = (const float*)ap->in[15]; p.x_wq = (const float*)ap->in[16]; p.x_wk = (const float*)ap->in[17];
    p.x_wv = (const float*)ap->in[18]; p.x_wo = (const float*)ap->in[19]; p.x_qnorm = (const float*)ap->in[20]; p.x_knorm = (const float*)ap->in[21]; p.norm_ffn = (const float*)ap->in[22];
    p.w_rg = (const float*)ap->in[23]; p.b_rg = (const float*)ap->in[24]; p.w_re = (const float*)ap->in[25]; p.b_re = (const float*)ap->in[26]; p.w_gu = (const float*)ap->in[27]; p.w_dn = (const float*)ap->in[28];
    p.out = ap->out; char* ws = ap->ws;
    p.bar = (unsigned*)(ws + WS_BAR); p.CNT = (int*)(ws + WS_CNT); p.LB = (float*)(ws + WS_LB); p.DEC = (float*)(ws + WS_DEC);
    p.COS128 = (float*)(ws + WS_COS128); p.SIN128 = (float*)(ws + WS_SIN128); p.COS64 = (float*)(ws + WS_COS64); p.SIN64 = (float*)(ws + WS_SIN64);
    p.XK = (bf16_t*)(ws + WS_XK); p.XVT = (bf16_t*)(ws + WS_XVT); p.H = (bf16_t*)(ws + WS_H);
    p.QL = (bf16_t*)(ws + WS_QL); p.KB = (bf16_t*)(ws + WS_KB); p.VT = (bf16_t*)(ws + WS_VT); p.KIDX = (bf16_t*)(ws + WS_KIDX); p.WIDX = (float*)(ws + WS_WIDX);
    char* r1 = ws + WS_R1;
    p.QA = (bf16_t*)(r1); p.ZF = (bf16_t*)(r1 + 32 * MiB); p.VAT = (bf16_t*)(r1 + 128 * MiB); p.GA = (bf16_t*)(r1 + 160 * MiB); p.UT = (bf16_t*)(r1 + 192 * MiB);
    p.QB = (bf16_t*)(r1); p.QIDX = (bf16_t*)(r1 + 32 * MiB); p.MASK = (unsigned*)(r1 + 96 * MiB);
    p.QX = (bf16_t*)(r1); p.OX = (bf16_t*)(r1 + 32 * MiB); p.ACT = (bf16_t*)(r1 + 64 * MiB); p.LTOK = (int*)(r1 + 100 * MiB); p.LGATE = (float*)(r1 + 104 * MiB);
    p.MEMN = (bf16_t*)(r1 + 128 * MiB); p.XWK = (bf16_t*)(r1 + 132 * MiB); p.XWV = (bf16_t*)(r1 + 134 * MiB);
    p.WIN = (bf16_t*)(ws + WS_WIN); p.WQ = (bf16_t*)(ws + WS_WQ); p.WOUT = (bf16_t*)(ws + WS_WOUT); p.XWQ = (bf16_t*)(ws + WS_XWQ); p.XWO = (bf16_t*)(ws + WS_XWO);
    p.WGU = (bf16_t*)(ws + WS_WGU); p.WDN = (bf16_t*)(ws + WS_WDN);
    p.Y = (bf16_t*)(r1 + 128 * MiB); p.LSLOT = (int*)(r1 + 108 * MiB);
    p.out_dry = (float*)(r1 + 128 * MiB); p.dry = 0;
    return p;
}

DEVI int tidx() { int t = (int)TIDX; asm volatile("" : "+v"(t)); return t; }
DEVI float bf2f(bf16_t v) { return __uint_as_float((uint32_t)v << 16); }
DEVI bf16_t f2bf(float f) { uint32_t u = __float_as_uint(f); u += 0x7FFFu + ((u >> 16) & 1u); return (bf16_t)(u >> 16); }
typedef __bf16 hbf16x2 __attribute__((ext_vector_type(2)));
typedef float hf32x2 __attribute__((ext_vector_type(2)));
DEVI uint32_t pack2(float a, float b) { const hf32x2 f = {a, b}; return __builtin_bit_cast(uint32_t, __builtin_convertvector(f, hbf16x2)); }
DEVI float bflo(uint32_t u) { return __uint_as_float(u << 16); }
DEVI float bfhi(uint32_t u) { return __uint_as_float(u & 0xFFFF0000u); }
#define DPP_F(old_, v_, ctrl, rm) __int_as_float(__builtin_amdgcn_update_dpp(__float_as_int(old_), __float_as_int(v_), ctrl, rm, 0xF, false))
#define DPP_I(old_, v_, ctrl, rm) __builtin_amdgcn_update_dpp(old_, v_, ctrl, rm, 0xF, false)
DEVI float wsum(float v) {
    v += DPP_F(0.f, v, 0xB1, 0xF); v += DPP_F(0.f, v, 0x4E, 0xF); v += DPP_F(0.f, v, 0x141, 0xF); v += DPP_F(0.f, v, 0x140, 0xF);
    v += DPP_F(0.f, v, 0x142, 0xA); v += DPP_F(0.f, v, 0x143, 0xC);
    return __int_as_float(__builtin_amdgcn_readlane(__float_as_int(v), 63));
}
DEVI float wmax(float v) {
    v = fmaxf(v, DPP_F(v, v, 0xB1, 0xF)); v = fmaxf(v, DPP_F(v, v, 0x4E, 0xF)); v = fmaxf(v, DPP_F(v, v, 0x141, 0xF)); v = fmaxf(v, DPP_F(v, v, 0x140, 0xF));
    v = fmaxf(v, DPP_F(v, v, 0x142, 0xA)); v = fmaxf(v, DPP_F(v, v, 0x143, 0xC));
    return __int_as_float(__builtin_amdgcn_readlane(__float_as_int(v), 63));
}
DEVI int wsumi(int v) {
    v += DPP_I(0, v, 0xB1, 0xF); v += DPP_I(0, v, 0x4E, 0xF); v += DPP_I(0, v, 0x141, 0xF); v += DPP_I(0, v, 0x140, 0xF);
    v += DPP_I(0, v, 0x142, 0xA); v += DPP_I(0, v, 0x143, 0xC);
    return __builtin_amdgcn_readlane(v, 63);
}
DEVI int wscan_incl(int v) {
    v += DPP_I(0, v, 0x111, 0xF); v += DPP_I(0, v, 0x112, 0xF); v += DPP_I(0, v, 0x114, 0xF); v += DPP_I(0, v, 0x118, 0xF);
    v += DPP_I(0, v, 0x142, 0xA); v += DPP_I(0, v, 0x143, 0xC);
    return v;
}
DEVI float quad_sum(float s) { s += DPP_F(0.f, s, 0xB1, 0xF); s += DPP_F(0.f, s, 0x4E, 0xF); return s; }
DEVI float oct_sum(float s) { s = quad_sum(s); s += DPP_F(0.f, s, 0x141, 0xF); return s; }
DEVI float siluf(float v) { return v / (1.0f + __expf(-v)); }
DEVI int kperm(int k) { return (k & ~12) | ((k & 4) << 1) | ((k & 8) >> 1); }
DEVI long vt_index(long r, int col) { return ((r >> 6) * 512 + col) * 64 + kperm((int)(r & 63)); }
DEVI unsigned ordf(float f) { unsigned u = __float_as_uint(f); return (u & 0x80000000u) ? ~u : (u | 0x80000000u); }

#define XB_TMO      128
#define XB_XCNT(j)  (256  + 64 * (j))
#define XB_XSUB(j)  (1280 + 64 * (j))
#define XB_XGEN(j)  (2304 + 64 * (j))
#define XB_TOP      3328
#define XB_TOPGEN   3392
#define XCD_BAR_WORDS 3456
#define XB_SPIN_CAP (1u << 27)
DEVI unsigned xb_ld(unsigned* p)              { return __hip_atomic_load(p, __ATOMIC_RELAXED, __HIP_MEMORY_SCOPE_AGENT); }
DEVI unsigned xb_add(unsigned* p, unsigned v) { return __hip_atomic_fetch_add(p, v, __ATOMIC_RELAXED, __HIP_MEMORY_SCOPE_AGENT); }
DEVI unsigned xb_xcc_id() { return (unsigned)__builtin_amdgcn_s_getreg((3 << 11) | 20) & 0xFu; }
#define XB_SPIN(cond, bar) do { unsigned _sp = 0; while (cond) { __builtin_amdgcn_s_sleep(1); \
    if ((++_sp & 255u) == 0u) { if (xb_ld(&(bar)[XB_TMO])) break; if (_sp > XB_SPIN_CAP) { atomicAdd(&(bar)[XB_TMO], 1u); break; } } } } while (0)
struct XcdBarrier { unsigned* bar; unsigned x; volatile LAS unsigned* st; };
DEVI XcdBarrier xcd_barrier_post(unsigned* bar, volatile LAS unsigned* st) {
    XcdBarrier b; b.bar = bar; b.x = xb_xcc_id(); b.st = st;
    if (TIDX == 0) (void)xb_add(&bar[XB_XCNT(b.x)], 1u);
    return b;
}
DEVI void xcd_barrier_complete(unsigned* bar, unsigned x, unsigned& nloc, unsigned& nx) {
    const unsigned G = GDIMX;
    unsigned sum, cnt, mine, sp = 0u;
    for (;;) {
        sum = 0u; cnt = 0u; mine = 0u;
#pragma unroll
        for (unsigned j = 0; j < 16; ++j) { const unsigned c = xb_ld(&bar[XB_XCNT(j)]); sum += c; cnt += (c > 0u) ? 1u : 0u; mine = (j == x) ? c : mine; }
        if (sum == G) break;
        __builtin_amdgcn_s_sleep(1);
        if ((++sp & 255u) == 0u) { if (xb_ld(&bar[XB_TMO])) break; if (sp > XB_SPIN_CAP) { atomicAdd(&bar[XB_TMO], 1u); break; } }
    }
    nloc = mine > 0u ? mine : 1u; nx = cnt > 0u ? cnt : 1u;
}
DEVI void xcd_barrier(const XcdBarrier& b) {
    asm volatile("s_waitcnt vmcnt(0)" ::: "memory");
    __syncthreads();
    if (TIDX == 0) {
        unsigned* bar = b.bar;
        __builtin_amdgcn_s_waitcnt(0);
        unsigned nloc = b.st[0], nx = b.st[1];
        if (nloc == 0u) { xcd_barrier_complete(bar, b.x, nloc, nx); b.st[0] = nloc; b.st[1] = nx; }
        const unsigned old = xb_add(&bar[XB_XSUB(b.x)], 1u);
        const unsigned gen = old / nloc;
        if (old + 1u == (gen + 1u) * nloc) {
            __builtin_amdgcn_fence(__ATOMIC_RELEASE, "agent");
            asm volatile("s_waitcnt vmcnt(0)" ::: "memory");
            const unsigned og = xb_add(&bar[XB_TOP], 1u);
            const unsigned tg = og / nx;
            if (og + 1u == (tg + 1u) * nx) xb_add(&bar[XB_TOPGEN], 1u);
            else XB_SPIN(xb_ld(&bar[XB_TOPGEN]) == tg, bar);
            __builtin_amdgcn_fence(__ATOMIC_ACQUIRE, "agent");
            xb_add(&bar[XB_XGEN(b.x)], 1u);
            asm volatile("s_waitcnt vmcnt(0)" ::: "memory");
        } else {
            XB_SPIN(xb_ld(&bar[XB_XGEN(b.x)]) == gen, bar);
            __builtin_amdgcn_fence(__ATOMIC_ACQUIRE, "agent");
            asm volatile("s_waitcnt vmcnt(0)" ::: "memory");
        }
    }
    __syncthreads();
}

struct ATile { const bf16_t* a; int lda; const int* rowmap; int mvalid; };
typedef short bf16x8 __attribute__((ext_vector_type(8)));
typedef float f32x16 __attribute__((ext_vector_type(16)));
DEVI int swz(int row, int chunk) { return row * 128 + ((chunk ^ ((row >> 1) & 7)) << 4); }

#define GLDS16(gp, lp) __builtin_amdgcn_global_load_lds((const __attribute__((address_space(1))) unsigned*)(gp), (__attribute__((address_space(3))) unsigned*)(lp), 16, 0, 0)
DEVI int swz32(int row, int chunk) { return row * 64 + ((chunk ^ ((row >> 2) & 3)) << 4); }
template <class Epi>
DEVI void gemm_unit256(const ATile& at, int m0, const bf16_t* Bt, int K, float* lds, Epi&& epi, int& tn_ref, int tn_base, int skip_epi = 0, bool whole = false) {
    char* base = (char*)lds;
    const int tid = tidx(), lane = tid & 63, wv = tid >> 6, wm = wv >> 1, wn = wv & 1, l31 = lane & 31, h = lane >> 5;
    const bf16_t* ap[2]; const bf16_t* bp[2];
#pragma unroll
    for (int i = 0; i < 2; ++i) { const int row = 32 * wv + 16 * i + (lane >> 2), ch = (lane & 3) ^ ((row >> 2) & 3), grow = m0 + row;
        long srow = 0; if (grow < at.mvalid) srow = at.rowmap ? (long)at.rowmap[grow] : (long)grow;
        ap[i] = at.a + srow * at.lda + ch * 8; bp[i] = Bt + (long)row * K + ch * 8; }
    const int aoffw = wv * 2048 + lane * 16, boffw = 16384 + wv * 2048 + lane * 16;
    int ra[2], rb[2];
#pragma unroll
    for (int ks = 0; ks < 2; ++ks) { ra[ks] = swz32(wm * 64 + l31, 2 * ks + h); rb[ks] = 16384 + swz32(wn * 128 + l31, 2 * ks + h); }
    f32x16 c00, c01, c02, c03, c10, c11, c12, c13;
#pragma unroll
    for (int r = 0; r < 16; ++r) { c00[r] = 0.f; c01[r] = 0.f; c02[r] = 0.f; c03[r] = 0.f; c10[r] = 0.f; c11[r] = 0.f; c12[r] = 0.f; c13[r] = 0.f; }
    const int nk = K >> 5;
#define D_ISSUE(ST, KO) { GLDS16(ap[0] + (KO), base + (ST) + aoffw); GLDS16(ap[1] + (KO), base + (ST) + aoffw + 1024); \
                          GLDS16(bp[0] + (KO), base + (ST) + boffw); GLDS16(bp[1] + (KO), base + (ST) + boffw + 1024); }
    __syncthreads();
    D_ISSUE(0, 0) D_ISSUE(32768, 32) D_ISSUE(65536, 64)
    asm volatile("s_waitcnt vmcnt(8)\n\ts_barrier" ::: "memory");
#pragma unroll 1
    for (int k = 0; k < nk; ++k) {
        const int kn = (k + 3 < nk) ? (k + 3) * 32 : K - 32;
        const int s0 = (k & 3) * 32768, s3 = ((k + 3) & 3) * 32768;
        if (skip_epi < 3) D_ISSUE(s3, kn)
        const bf16x8 a0 = *(const bf16x8*)(base + s0 + ra[0]), a1 = *(const bf16x8*)(base + s0 + ra[0] + 2048);
        const bf16x8 b0 = *(const bf16x8*)(base + s0 + rb[0]), b1 = *(const bf16x8*)(base + s0 + rb[0] + 2048);
        const bf16x8 b2 = *(const bf16x8*)(base + s0 + rb[0] + 4096), b3 = *(const bf16x8*)(base + s0 + rb[0] + 6144);
        const bf16x8 e0 = *(const bf16x8*)(base + s0 + ra[1]), e1 = *(const bf16x8*)(base + s0 + ra[1] + 2048);
        const bf16x8 f0 = *(const bf16x8*)(base + s0 + rb[1]), f1 = *(const bf16x8*)(base + s0 + rb[1] + 2048);
        const bf16x8 f2 = *(const bf16x8*)(base + s0 + rb[1] + 4096), f3 = *(const bf16x8*)(base + s0 + rb[1] + 6144);
        __builtin_amdgcn_sched_barrier(0);
        __builtin_amdgcn_s_setprio(1);
        c00 = __builtin_amdgcn_mfma_f32_32x32x16_bf16(b0, a0, c00, 0, 0, 0); c01 = __builtin_amdgcn_mfma_f32_32x32x16_bf16(b1, a0, c01, 0, 0, 0);
        c02 = __builtin_amdgcn_mfma_f32_32x32x16_bf16(b2, a0, c02, 0, 0, 0); c03 = __builtin_amdgcn_mfma_f32_32x32x16_bf16(b3, a0, c03, 0, 0, 0);
        c10 = __builtin_amdgcn_mfma_f32_32x32x16_bf16(b0, a1, c10, 0, 0, 0); c11 = __builtin_amdgcn_mfma_f32_32x32x16_bf16(b1, a1, c11, 0, 0, 0);
        c12 = __builtin_amdgcn_mfma_f32_32x32x16_bf16(b2, a1, c12, 0, 0, 0); c13 = __builtin_amdgcn_mfma_f32_32x32x16_bf16(b3, a1, c13, 0, 0, 0);
        c00 = __builtin_amdgcn_mfma_f32_32x32x16_bf16(f0, e0, c00, 0, 0, 0); c01 = __builtin_amdgcn_mfma_f32_32x32x16_bf16(f1, e0, c01, 0, 0, 0);
        c02 = __builtin_amdgcn_mfma_f32_32x32x16_bf16(f2, e0, c02, 0, 0, 0); c03 = __builtin_amdgcn_mfma_f32_32x32x16_bf16(f3, e0, c03, 0, 0, 0);
        c10 = __builtin_amdgcn_mfma_f32_32x32x16_bf16(f0, e1, c10, 0, 0, 0); c11 = __builtin_amdgcn_mfma_f32_32x32x16_bf16(f1, e1, c11, 0, 0, 0);
        c12 = __builtin_amdgcn_mfma_f32_32x32x16_bf16(f2, e1, c12, 0, 0, 0); c13 = __builtin_amdgcn_mfma_f32_32x32x16_bf16(f3, e1, c13, 0, 0, 0);
        __builtin_amdgcn_s_setprio(0);
        if (skip_epi < 4) asm volatile("s_waitcnt vmcnt(8) lgkmcnt(0)\n\ts_barrier" ::: "memory");
    }
#undef D_ISSUE
    asm volatile("s_waitcnt vmcnt(0)\n\ts_barrier" ::: "memory");
    unsigned short* T = (unsigned short*)lds;
    {
        unsigned short* t0 = T + (wm * 64 + l31) * TLD + wn * 128 + 4 * h;
#define T_PUT(C, RO, CO) { _Pragma("unroll") for (int g = 0; g < 4; ++g) *(uint2*)(t0 + (RO) * TLD + (CO) + 8 * g) = make_uint2(pack2(C[4 * g], C[4 * g + 1]), pack2(C[4 * g + 2], C[4 * g + 3])); }
        T_PUT(c00, 0, 0) T_PUT(c01, 0, 32) T_PUT(c02, 0, 64) T_PUT(c03, 0, 96) T_PUT(c10, 32, 0) T_PUT(c11, 32, 32) T_PUT(c12, 32, 64) T_PUT(c13, 32, 96)
#undef T_PUT
    }
    __syncthreads();
    if (whole) { tn_ref = tn_base; if (!skip_epi) epi(T, m0); return; }
#pragma unroll 1
    for (int sub = 0; sub < 4 && !skip_epi; ++sub) { const int rh = sub >> 1, ch = sub & 1; tn_ref = tn_base + ch; epi(T + rh * 128 * TLD + 128 * ch, m0 + 128 * rh); }
}

typedef float f32x4 __attribute__((ext_vector_type(4)));
constexpr int PG_HTB = 128 * 64 * 2;
DEVI int pg_lds_byte(int r, int c) { const int st = (r >> 4) * 2 + (c >> 5), rr = r & 15, cc = c & 31, ob = rr * 64 + cc * 2; return st * 1024 + (ob ^ (((ob >> 9) & 1) << 5)); }
DEVI void pg_stage_rc(int b, int& R, int& C) { const int st = b / 1024, sb = b % 1024, sw = sb ^ (((sb >> 9) & 1) << 5); R = (st >> 1) * 16 + sw / 64; C = (st & 1) * 32 + (sw % 64) / 2; }
template <class Epi>
DEVI void gemm_unit8(const ATile& at, int m0, const bf16_t* Bt, int K, float* ldsf, Epi&& epi, int& tn_ref, int tn_base, int skip_epi = 0, bool whole = false) {
    LAS unsigned char* lds = (LAS unsigned char*)ldsf;
    const int tid = tidx(), wid = __builtin_amdgcn_readfirstlane(tid >> 6), lane = tid & 63, wr = wid >> 2, wc = wid & 3, fr = lane & 15, fq = lane >> 4;
    const int nt = K >> 6;
    const char* ap00; const char* ap01; const char* ap10; const char* ap11;
    unsigned vb0, vb1;
    {   int R, C;
        pg_stage_rc(tid * 16, R, C);
        { const int g0 = m0 + R, g1 = m0 + 128 + R;
          const long s0 = (g0 < at.mvalid) ? (at.rowmap ? (long)at.rowmap[g0] : (long)g0) : 0, s1 = (g1 < at.mvalid) ? (at.rowmap ? (long)at.rowmap[g1] : (long)g1) : 0;
          ap00 = (const char*)(at.a + s0 * at.lda + C); ap10 = (const char*)(at.a + s1 * at.lda + C); vb0 = (unsigned)(R * K + C) * 2u; }
        pg_stage_rc(tid * 16 + 8192, R, C);
        { const int g0 = m0 + R, g1 = m0 + 128 + R;
          const long s0 = (g0 < at.mvalid) ? (at.rowmap ? (long)at.rowmap[g0] : (long)g0) : 0, s1 = (g1 < at.mvalid) ? (at.rowmap ? (long)at.rowmap[g1] : (long)g1) : 0;
          ap01 = (const char*)(at.a + s0 * at.lda + C); ap11 = (const char*)(at.a + s1 * at.lda + C); vb1 = (unsigned)(R * K + C) * 2u; }
    }
    const size_t kstep = 128, hstep = (size_t)128 * K * 2;
    const unsigned ldsw = (unsigned)wid * 1024u;
    const int aoff = pg_lds_byte(wr * 64 + fr, fq * 8), boff = pg_lds_byte(wc * 32 + fr, fq * 8);
#define PG_SA(b, h) (((b) * 2 + (h)) * PG_HTB)
#define PG_SB(b, h) ((4 + (b) * 2 + (h)) * PG_HTB)
#define PG_DMA(gp, lo) __builtin_amdgcn_global_load_lds((const __attribute__((address_space(1))) unsigned*)(gp), (LAS unsigned*)(lds + (lo)), 16, 0, 0)
#define PG_STAGE_A0(bufoff, ko) do { PG_DMA(ap00 + (ko), (bufoff) + ldsw); PG_DMA(ap01 + (ko), (bufoff) + ldsw + 8192); } while (0)
#define PG_STAGE_A1(bufoff, ko) do { PG_DMA(ap10 + (ko), (bufoff) + ldsw); PG_DMA(ap11 + (ko), (bufoff) + ldsw + 8192); } while (0)
#define PG_STAGE_B(bufoff, gbase) do { PG_DMA((const char*)(gbase) + vb0, (bufoff) + ldsw); PG_DMA((const char*)(gbase) + vb1, (bufoff) + ldsw + 8192); } while (0)
#define PG_LDA(dst, b, h) do { _Pragma("unroll") for (int m = 0; m < 4; ++m) _Pragma("unroll") for (int k = 0; k < 2; ++k) dst[m][k] = *(const LAS bf16x8*)(lds + PG_SA(b, h) + aoff + m * 2048 + k * 1024); } while (0)
#define PG_LDB(dst, b, h) do { _Pragma("unroll") for (int n = 0; n < 2; ++n) _Pragma("unroll") for (int k = 0; k < 2; ++k) dst[n][k] = *(const LAS bf16x8*)(lds + PG_SB(b, h) + boff + n * 2048 + k * 1024); } while (0)
#define PG_MMA(ai, bj, At_, Bt_) do { __builtin_amdgcn_s_setprio(1); _Pragma("unroll") for (int m = 0; m < 4; ++m) _Pragma("unroll") for (int n = 0; n < 2; ++n) _Pragma("unroll") for (int k = 0; k < 2; ++k) \
        acc[ai][bj][m][n] = __builtin_amdgcn_mfma_f32_16x16x32_bf16(Bt_[n][k], At_[m][k], acc[ai][bj][m][n], 0, 0, 0); __builtin_amdgcn_s_setprio(0); } while (0)
#define PG_WAIT_V(n) asm volatile("s_waitcnt vmcnt(" #n ")" ::: "memory")
#define PG_WAIT_L(n) asm volatile("s_waitcnt lgkmcnt(" #n ")" ::: "memory")
#define PG_BAR __builtin_amdgcn_s_barrier()
#define PG_SCHED __builtin_amdgcn_sched_barrier(0)
    f32x4 acc[2][2][4][2];
#pragma unroll
    for (int a = 0; a < 2; ++a)
#pragma unroll
        for (int b = 0; b < 2; ++b)
#pragma unroll
            for (int m = 0; m < 4; ++m)
#pragma unroll
                for (int n = 0; n < 2; ++n) acc[a][b][m][n] = (f32x4){0.f, 0.f, 0.f, 0.f};
    bf16x8 At[4][2], B0[2][2], B1[2][2];
    const char* cB = (const char*)Bt;
    __syncthreads();
    PG_STAGE_B(PG_SB(0, 0), cB); PG_STAGE_A0(PG_SA(0, 0), 0); PG_STAGE_B(PG_SB(0, 1), cB + hstep); PG_STAGE_A1(PG_SA(0, 1), 0);
    if (wr == 1) PG_BAR;
    PG_WAIT_V(4); PG_BAR;
    PG_STAGE_B(PG_SB(1, 0), cB + kstep); PG_STAGE_A0(PG_SA(1, 0), kstep); PG_STAGE_B(PG_SB(1, 1), cB + hstep + kstep);
    PG_WAIT_V(6); PG_BAR;
#pragma unroll 1
    for (int t = 0; t < nt; t += 2) {
        const bool last = (t == nt - 2);
        const size_t a1 = (size_t)(t + 1) * kstep, a2 = last ? 0 : (size_t)(t + 2) * kstep, a3 = a2 + kstep;
        const char* b2 = cB + a2; const char* b3 = cB + a3;
        PG_LDB(B0, 0, 0); PG_SCHED; PG_LDA(At, 0, 0); PG_STAGE_A1(PG_SA(1, 1), a1);
        PG_WAIT_L(8); PG_BAR; PG_WAIT_L(0); PG_MMA(0, 0, At, B0); PG_BAR; PG_SCHED;
        PG_LDB(B1, 0, 1); PG_STAGE_B(PG_SB(0, 0), b2);
        PG_BAR; PG_WAIT_L(0); PG_MMA(0, 1, At, B1); PG_BAR;
        PG_LDA(At, 0, 1); PG_STAGE_A0(PG_SA(0, 0), a2);
        PG_BAR; PG_WAIT_L(0); PG_MMA(1, 0, At, B0); PG_BAR; PG_SCHED;
        PG_STAGE_B(PG_SB(0, 1), b2 + hstep);
        PG_WAIT_V(6); PG_BAR; PG_MMA(1, 1, At, B1); PG_BAR;
        PG_LDB(B0, 1, 0); PG_SCHED; PG_LDA(At, 1, 0); PG_STAGE_A1(PG_SA(0, 1), a2);
        PG_WAIT_L(8); PG_BAR; PG_WAIT_L(0); PG_MMA(0, 0, At, B0); PG_BAR; PG_SCHED;
        PG_LDB(B1, 1, 1); PG_STAGE_B(PG_SB(1, 0), b3);
        PG_BAR; PG_WAIT_L(0); PG_MMA(0, 1, At, B1); PG_BAR;
        PG_LDA(At, 1, 1); PG_STAGE_A0(PG_SA(1, 0), a3);
        PG_BAR; PG_WAIT_L(0); PG_MMA(1, 0, At, B0); PG_BAR; PG_SCHED;
        PG_STAGE_B(PG_SB(1, 1), b3 + hstep);
        PG_WAIT_V(6); PG_BAR; PG_MMA(1, 1, At, B1); PG_BAR;
    }
    PG_WAIT_V(0);
    if (wr == 0) PG_BAR;
    PG_BAR;
    unsigned short* T = (unsigned short*)ldsf;
#pragma unroll
    for (int ai = 0; ai < 2; ++ai)
#pragma unroll
        for (int m = 0; m < 4; ++m) { unsigned short* tr = T + (ai * 128 + wr * 64 + m * 16 + fr) * TLD + wc * 32 + 4 * fq;
#pragma unroll
            for (int bj = 0; bj < 2; ++bj)
#pragma unroll
                for (int n = 0; n < 2; ++n) { const f32x4 v = acc[ai][bj][m][n]; *(uint2*)(tr + bj * 128 + n * 16) = make_uint2(pack2(v[0], v[1]), pack2(v[2], v[3])); } }
    __syncthreads();
    if (whole) { tn_ref = tn_base; if (!skip_epi) epi(T, m0); return; }
#pragma unroll 1
    for (int sub = 0; sub < 4 && !skip_epi; ++sub) { const int rh = sub >> 1, ch = sub & 1; tn_ref = tn_base + ch; epi(T + rh * 128 * TLD + 128 * ch, m0 + 128 * rh); }
#undef PG_SA
#undef PG_SB
#undef PG_DMA
#undef PG_STAGE_A0
#undef PG_STAGE_A1
#undef PG_STAGE_B
#undef PG_LDA
#undef PG_LDB
#undef PG_MMA
#undef PG_WAIT_V
#undef PG_WAIT_L
#undef PG_BAR
#undef PG_SCHED
}

DEVI void tr_job(const float* src, long mat_stride, int gpm, int nmat, int ld, int K, int nvalid, int mode, bf16_t* dst, float* lds) {
    const int tid = tidx(), kt = K >> 6, total = nmat * gpm * kt;
    const int i = tid >> 3, j8 = (tid & 7) * 8;
#define TR_LOAD(U, X0, X1) { const int G_ = (U) / kt, k0_ = ((U) % kt) * 64, mat_ = G_ / gpm, g_ = G_ % gpm; \
        const int col0_ = (mode == 0) ? g_ * 64 : ((g_ & 1) ? 256 + (g_ >> 1) * 64 : (g_ >> 1) * 64); \
        const float* rp_ = src + mat_ * mat_stride + (long)(k0_ + i) * ld + col0_ + j8; \
        if (col0_ + j8 + 7 < nvalid) { X0 = *(const float4*)rp_; X1 = *(const float4*)(rp_ + 4); } \
        else { float t_[8]; _Pragma("unroll") for (int e = 0; e < 8; ++e) t_[e] = (col0_ + j8 + e < nvalid) ? rp_[e] : 0.f; \
               X0 = make_float4(t_[0], t_[1], t_[2], t_[3]); X1 = make_float4(t_[4], t_[5], t_[6], t_[7]); } }
    float4 x0 = make_float4(0.f, 0.f, 0.f, 0.f), x1 = x0, y0 = x0, y1 = x0;
    int u = BIDX;
    if (u < total) TR_LOAD(u, x0, x1)
    for (; u < total; u += GDIMX) {
        const int un = u + GDIMX;
        if (un < total) TR_LOAD(un, y0, y1)
        const int G = u / kt, k0 = (u % kt) * 64;
        __syncthreads();
        lds[i * 65 + j8] = x0.x; lds[i * 65 + j8 + 1] = x0.y; lds[i * 65 + j8 + 2] = x0.z; lds[i * 65 + j8 + 3] = x0.w;
        lds[i * 65 + j8 + 4] = x1.x; lds[i * 65 + j8 + 5] = x1.y; lds[i * 65 + j8 + 6] = x1.z; lds[i * 65 + j8 + 7] = x1.w;
        __syncthreads();
        { const int n = tid >> 3, kc = (tid & 7) * 8; float f[8];
#pragma unroll
          for (int e = 0; e < 8; ++e) f[e] = lds[(kc + e) * 65 + n];
          uint4 w; w.x = pack2(f[0], f[1]); w.y = pack2(f[2], f[3]); w.z = pack2(f[4], f[5]); w.w = pack2(f[6], f[7]);
          *(uint4*)(dst + ((long)G * 64 + n) * K + k0 + kc) = w; }
        x0 = y0; x1 = y1;
    }
#undef TR_LOAD
}

typedef bf16_t tile_t;
DEVI float4 t_ld4(const tile_t* T, int idx) { const uint2 u = *(const uint2*)(T + idx); return make_float4(bflo(u.x), bfhi(u.x), bflo(u.y), bfhi(u.y)); }
DEVI void epi_load(const tile_t* T, float (&v)[8][4]) {
    const int row = tidx() >> 2, q = tidx() & 3;
#pragma unroll
    for (int j = 0; j < 8; ++j) { const float4 t = t_ld4(T, row * TLD + 16 * j + 4 * q); v[j][0] = t.x; v[j][1] = t.y; v[j][2] = t.z; v[j][3] = t.w; }
}
DEVI void epi_store_bf16(const float (&v)[8][4], bf16_t* rowp  ) {
    const int q = tidx() & 3;
#pragma unroll
    for (int j = 0; j < 8; ++j) *(uint2*)(rowp + 16 * j + 4 * q) = make_uint2(pack2(v[j][0], v[j][1]), pack2(v[j][2], v[j][3]));
}
DEVI void rope_cs(float posf, int c, float fscale, float& cs, float& sn) {
    const float inv = __builtin_amdgcn_exp2f(-(float)c * fscale);
    const float rev = __builtin_amdgcn_fractf((posf * inv) * 0.15915494309189535f);
    sn = __builtin_amdgcn_sinf(rev); cs = __builtin_amdgcn_cosf(rev);
}
constexpr float ROPE_FS128 = 13.287712379549449f * 2.0f / 128.0f, ROPE_FS64 = 13.287712379549449f * 2.0f / 64.0f;
DEVI void norm_rope128(float (&v)[8][4], const float* gain, float posf, float post, bool do_rope) {
    const int q = tidx() & 3;
    float ss = 0.f;
#pragma unroll
    for (int j = 0; j < 8; ++j)
#pragma unroll
        for (int i = 0; i < 4; ++i) ss += v[j][i] * v[j][i];
    ss = quad_sum(ss);
    const float rstd = rsqrtf(ss * (1.0f / 128.0f) + EPS);
#pragma unroll
    for (int j = 0; j < 8; ++j) { const float4 g = *(const float4*)(gain + 16 * j + 4 * q); v[j][0] *= rstd * g.x; v[j][1] *= rstd * g.y; v[j][2] *= rstd * g.z; v[j][3] *= rstd * g.w; }
    if (do_rope) {
#pragma unroll
        for (int j = 0; j < 4; ++j) {
#pragma unroll
            for (int i = 0; i < 4; ++i) { float c_, s_; rope_cs(posf, 16 * j + 4 * q + i, ROPE_FS128, c_, s_);
                const float x1 = v[j][i], x2 = v[j + 4][i]; v[j][i] = x1 * c_ - x2 * s_; v[j + 4][i] = x2 * c_ + x1 * s_; }
        }
    }
#pragma unroll
    for (int j = 0; j < 8; ++j)
#pragma unroll
        for (int i = 0; i < 4; ++i) v[j][i] *= post;
}
DEVI void rope64(float (&v)[8][4], int jb, float posf) {
    const int q = tidx() & 3;
#pragma unroll
    for (int jj = 0; jj < 2; ++jj) {
#pragma unroll
        for (int i = 0; i < 4; ++i) { float c_, s_; rope_cs(posf, 16 * jj + 4 * q + i, ROPE_FS64, c_, s_);
            const float x1 = v[jb + jj][i], x2 = v[jb + jj + 2][i]; v[jb + jj][i] = x1 * c_ - x2 * s_; v[jb + jj + 2][i] = x2 * c_ + x1 * s_; }
    }
}
DEVI void epi_store_vt(const tile_t* T, bf16_t* dst, long r0  , int col0) {
    const int col = tidx() & 127, sg = tidx() >> 7, kt = sg >> 1;
#pragma unroll
    for (int g = 0; g < 2; ++g) {
        const int kb = 32 * (sg & 1) + 16 * g;
#pragma unroll
        for (int half = 0; half < 2; ++half) {
            uint32_t f[8];
#pragma unroll
            for (int e = 0; e < 8; ++e) { const int key = kb + kperm(8 * half + e); f[e] = T[(64 * kt + key) * TLD + col]; }
            uint4 w; w.x = f[0] | (f[1] << 16); w.y = f[2] | (f[3] << 16); w.z = f[4] | (f[5] << 16); w.w = f[6] | (f[7] << 16);
            *(uint4*)(dst + (((r0 >> 6) + kt) * 512 + col0 + col) * 64 + kb + 8 * half) = w;
        }
    }
}

DEVI void sincos_acc(float ang, float& s, float& c) {
    const double a = (double)ang * 0.15915494309189535; const double n = rint(a); const float fr = (float)(a - n);
    s = __builtin_amdgcn_sinf(fr); c = __builtin_amdgcn_cosf(fr);
}
DEVI void ph_pro_w(const P& p, float* lds);
DEVI void ph_pro_a(const P& p, float* lds) {
    const long gt = (long)BIDX * NT + tidx(), gs = (long)GDIMX * NT;
    for (long i = gt; i < 1024; i += gs) { const int l = (int)(i >> 9), c = (int)(i & 511); p.LB[i] = (l == 0) ? 0.f : 1.0f / (1.0f + expf(p.lb_raw[c] - p.lb_raw[512 + c])); }
    for (long i = gt; i < 64; i += gs) p.CNT[i] = 0;
    ph_pro_w(p, lds);
    const int lane = tidx() & 63, gw = BIDX * 8 + (tidx() >> 6), nw = GDIMX * 8;
    for (int r = gw; r < 2 * 1024; r += nw) {
        const int l = r >> 10, rr = r & 1023;
        const float4* xr = (const float4*)(p.mem + (long)rr * DM); const float4* gr = (const float4*)(p.norm_mem + l * DM);
        float4 v[4]; float ss = 0.f;
#pragma unroll
        for (int j = 0; j < 4; ++j) { v[j] = xr[lane + 64 * j]; ss += v[j].x * v[j].x + v[j].y * v[j].y + v[j].z * v[j].z + v[j].w * v[j].w; }
        ss = wsum(ss); const float rstd = rsqrtf(ss * (1.0f / 1024.0f) + EPS);
#pragma unroll
        for (int j = 0; j < 4; ++j) { const float4 g = gr[lane + 64 * j];
            *(uint2*)(p.MEMN + (long)r * DM + 4 * (lane + 64 * j)) = make_uint2(pack2(v[j].x * rstd * g.x, v[j].y * rstd * g.y), pack2(v[j].z * rstd * g.z, v[j].w * rstd * g.w)); }
    }
}
DEVI void ph_pro_w(const P& p, float* lds) {
    tr_job(p.w_in, (long)DM * DIN, 56, 2, DIN, DM, DIN, 0, p.WIN, lds);
    tr_job(p.b_wqb, 256L * 512, 8, 1, 512, 256, 512, 0, p.WQ, lds);
    tr_job(p.b_wqb + 256L * 512, 256L * 512, 8, 1, 512, 256, 512, 0, p.WQ + 1536L * 256, lds);
    tr_job(p.b_wqidx, 256L * 1024, 16, 1, 1024, 256, 1024, 0, p.WQ + 512L * 256, lds);
    tr_job(p.b_wqidx + 256L * 1024, 256L * 1024, 16, 1, 1024, 256, 1024, 0, p.WQ + (1536L + 512) * 256, lds);
    tr_job(p.w_out, (long)DM * DM, 16, 2, DM, DM, DM, 0, p.WOUT, lds);
    tr_job(p.x_wq, (long)DM * 512, 8, 2, 512, DM, 512, 0, p.XWQ, lds);
    tr_job(p.x_wk, (long)DM * 512, 8, 2, 512, DM, 512, 0, p.XWK, lds);
    tr_job(p.x_wv, (long)DM * 512, 8, 2, 512, DM, 512, 0, p.XWV, lds);
    tr_job(p.x_wo, 512L * DM, 16, 2, DM, 512, DM, 0, p.XWO, lds);
    tr_job(p.w_gu, (long)DM * 512, 8, 32, 512, DM, 512, 1, p.WGU, lds);
    tr_job(p.w_dn, 256L * DM, 16, 32, DM, 256, DM, 0, p.WDN, lds);
}
DEVI void ph_pro_b(const P& p, float* lds) {
    for (int u = BIDX; u < 2 * 4 * 4; u += GDIMX) {
        const int l = u >> 4, tm = (u >> 2) & 3, tn2 = u & 3; int tn;
        ATile at{p.MEMN + (long)l * 1024 * DM, DM, nullptr, 1024};
        gemm_unit8(at, tm * 256, ((tn2 >> 1) ? p.XWV : p.XWK) + ((long)l * 512 + (tn2 & 1) * 256) * DM, DM, lds, [&](const tile_t* T, int mr0) __attribute__((always_inline)) NOPK {
            const int isv = tn >> 2, hn = tn & 3;
            if (!isv) {
                float v[8][4]; epi_load(T, v);
                norm_rope128(v, p.x_knorm + l * 128, 0.f, 1.0f, false);
                epi_store_bf16(v, p.XK + ((long)l * 1024 + mr0 + (tidx() >> 2)) * 512 + hn * 128);
            } else {
                epi_store_vt(T, p.XVT + (long)l * 1024 * 512, mr0, hn * 128);
            }
        }, tn, 2 * tn2);
    }
}

#define ST_AGENT(ptr, val) __hip_atomic_store((ptr), (val), __ATOMIC_RELAXED, __HIP_MEMORY_SCOPE_AGENT)
template <bool ROUTER, bool ADDY = false, bool XIN = false>
DEVI void ph_norm(const P& p, const float* gain, int l) {
    const int lane = tidx() & 63, gw = BIDX * 8 + (tidx() >> 6), nw = GDIMX * 8;
    for (int row = gw; row < NTOK; row += nw) {
        const float4* xr = (const float4*)((XIN ? p.x : p.out) + (long)row * DM); const float4* gr = (const float4*)gain;
        float4 v0 = xr[lane], v1 = xr[lane + 64], v2 = xr[lane + 128], v3 = xr[lane + 192];
        if (ADDY) {
            const uint2* y0 = (const uint2*)(p.Y + (long)(2 * row) * DM); const uint2* y1 = (const uint2*)(p.Y + (long)(2 * row + 1) * DM);
#define ADDY_ONE(V, J) { const uint2 a = y0[lane + 64 * J], b = y1[lane + 64 * J]; V.x = (V.x + bflo(a.x)) + bflo(b.x); V.y = (V.y + bfhi(a.x)) + bfhi(b.x); \
                         V.z = (V.z + bflo(a.y)) + bflo(b.y); V.w = (V.w + bfhi(a.y)) + bfhi(b.y); ((float4*)(p.out + (long)row * DM))[lane + 64 * J] = V; }
            ADDY_ONE(v0, 0) ADDY_ONE(v1, 1) ADDY_ONE(v2, 2) ADDY_ONE(v3, 3)
#undef ADDY_ONE
        }
        float ss = v0.x * v0.x + v0.y * v0.y + v0.z * v0.z + v0.w * v0.w + v1.x * v1.x + v1.y * v1.y + v1.z * v1.z + v1.w * v1.w
                 + v2.x * v2.x + v2.y * v2.y + v2.z * v2.z + v2.w * v2.w + v3.x * v3.x + v3.y * v3.y + v3.z * v3.z + v3.w * v3.w;
        ss = wsum(ss); const float rstd = rsqrtf(ss * (1.0f / 1024.0f) + EPS);
#define NORM_ONE(V, J) { const float4 g = gr[lane + 64 * J]; V.x *= rstd * g.x; V.y *= rstd * g.y; V.z *= rstd * g.z; V.w *= rstd * g.w; \
            *(uint2*)(p.H + (long)row * DM + 4 * (lane + 64 * J)) = make_uint2(pack2(V.x, V.y), pack2(V.z, V.w)); }
        NORM_ONE(v0, 0) NORM_ONE(v1, 1) NORM_ONE(v2, 2) NORM_ONE(v3, 3)
#undef NORM_ONE
        if (ROUTER) {
            float4 ag = make_float4(0.f, 0.f, 0.f, 0.f), ae0 = ag, ae1 = ag, ae2 = ag, ae3 = ag;
#define RT_ONE(HH, D) { const float hh = HH; const int d = D; \
                    const float4 wg = *(const float4*)(p.w_rg + ((long)l * DM + d) * 4); \
                    ag.x += hh * wg.x; ag.y += hh * wg.y; ag.z += hh * wg.z; ag.w += hh * wg.w; \
                    const float4* we = (const float4*)(p.w_re + ((long)l * DM + d) * 16); \
                    const float4 w0 = we[0], w1 = we[1], w2 = we[2], w3 = we[3]; \
                    ae0.x += hh * w0.x; ae0.y += hh * w0.y; ae0.z += hh * w0.z; ae0.w += hh * w0.w; \
                    ae1.x += hh * w1.x; ae1.y += hh * w1.y; ae1.z += hh * w1.z; ae1.w += hh * w1.w; \
                    ae2.x += hh * w2.x; ae2.y += hh * w2.y; ae2.z += hh * w2.z; ae2.w += hh * w2.w; \
                    ae3.x += hh * w3.x; ae3.y += hh * w3.y; ae3.z += hh * w3.z; ae3.w += hh * w3.w; }
#define RT_VEC(V, J) RT_ONE(V.x, 4 * (lane + 64 * J)) RT_ONE(V.y, 4 * (lane + 64 * J) + 1) RT_ONE(V.z, 4 * (lane + 64 * J) + 2) RT_ONE(V.w, 4 * (lane + 64 * J) + 3)
            RT_VEC(v0, 0) RT_VEC(v1, 1) RT_VEC(v2, 2) RT_VEC(v3, 3)
#undef RT_VEC
#undef RT_ONE
            ag.x = wsum(ag.x); ag.y = wsum(ag.y); ag.z = wsum(ag.z); ag.w = wsum(ag.w);
            ae0.x = wsum(ae0.x); ae0.y = wsum(ae0.y); ae0.z = wsum(ae0.z); ae0.w = wsum(ae0.w);
            ae1.x = wsum(ae1.x); ae1.y = wsum(ae1.y); ae1.z = wsum(ae1.z); ae1.w = wsum(ae1.w);
            ae2.x = wsum(ae2.x); ae2.y = wsum(ae2.y); ae2.z = wsum(ae2.z); ae2.w = wsum(ae2.w);
            ae3.x = wsum(ae3.x); ae3.y = wsum(ae3.y); ae3.z = wsum(ae3.z); ae3.w = wsum(ae3.w);
            if (lane == 0) {
                const float g0 = ag.x + p.b_rg[l * 4 + 0], g1 = ag.y + p.b_rg[l * 4 + 1], g2 = ag.z + p.b_rg[l * 4 + 2], g3 = ag.w + p.b_rg[l * 4 + 3];
                int gsel = 0; float gm = g0;
                if (g1 > gm) { gm = g1; gsel = 1; }
                if (g2 > gm) { gm = g2; gsel = 2; }
                if (g3 > gm) { gm = g3; gsel = 3; }
                const float gw_ = 1.0f / (expf(g0 - gm) + expf(g1 - gm) + expf(g2 - gm) + expf(g3 - gm));
                const float m0 = (gsel == 0) ? 1.f : 0.f, m1 = (gsel == 1) ? 1.f : 0.f, m2 = (gsel == 2) ? 1.f : 0.f, m3 = (gsel == 3) ? 1.f : 0.f;
                float4 es; es.x = m0 * ae0.x + m1 * ae1.x + m2 * ae2.x + m3 * ae3.x; es.y = m0 * ae0.y + m1 * ae1.y + m2 * ae2.y + m3 * ae3.y;
                es.z = m0 * ae0.z + m1 * ae1.z + m2 * ae2.z + m3 * ae3.z; es.w = m0 * ae0.w + m1 * ae1.w + m2 * ae2.w + m3 * ae3.w;
                const float4 be = *(const float4*)(p.b_re + l * 16 + gsel * 4);
                const float x0 = es.x + be.x, x1 = es.y + be.y, x2 = es.z + be.z, x3 = es.w + be.w;
                int i1 = 0; float e1 = x0;
                if (x1 > e1) { e1 = x1; i1 = 1; }
                if (x2 > e1) { e1 = x2; i1 = 2; }
                if (x3 > e1) { e1 = x3; i1 = 3; }
                int i2 = -1; float e2 = -3.0e38f;
                if (i1 != 0 && x0 > e2) { e2 = x0; i2 = 0; }
                if (i1 != 1 && x1 > e2) { e2 = x1; i2 = 1; }
                if (i1 != 2 && x2 > e2) { e2 = x2; i2 = 2; }
                if (i1 != 3 && x3 > e2) { e2 = x3; i2 = 3; }
                const float z = expf(e2 - e1); const float w1 = 1.0f / (1.0f + z), w2 = z / (1.0f + z);
                const int ex1 = gsel * 4 + i1, ex2 = gsel * 4 + i2;
                if (!p.dry) {
                const int p1 = atomicAdd(&p.CNT[l * 16 + ex1], 1); ST_AGENT(&p.LTOK[(long)ex1 * NTOK + p1], row); ST_AGENT(&p.LSLOT[(long)ex1 * NTOK + p1], 2 * row); ST_AGENT((int*)&p.LGATE[(long)ex1 * NTOK + p1], __float_as_int(w1 * gw_));
                const int p2 = atomicAdd(&p.CNT[l * 16 + ex2], 1); ST_AGENT(&p.LTOK[(long)ex2 * NTOK + p2], row); ST_AGENT(&p.LSLOT[(long)ex2 * NTOK + p2], 2 * row + 1); ST_AGENT((int*)&p.LGATE[(long)ex2 * NTOK + p2], __float_as_int(w2 * gw_)); }
            }
        }
    }
}

DEVI bool xcd_unit(int i, int tilesN, int& tm, int& tn) {
    if ((GDIMX & 7) != 0) { const int u = BIDX + i * GDIMX; if (u >= 128 * tilesN) return false; tm = u / tilesN; tn = u % tilesN; return true; }
    const int xcd = BIDX & 7, slot = BIDX >> 3, nslots = GDIMX >> 3, ul = slot + nslots * i;
    if (ul >= 16 * tilesN) return false;
    tm = xcd + 8 * (ul / tilesN); tn = ul % tilesN; return true;
}
DEVI void epi_inproj(const P& p, int l, const tile_t* T, int m0, int tn) {
    const int row = tidx() >> 2, q = tidx() & 3; const long t = m0 + row;
    if ((tn >= 8 && tn < 12) || (tn >= 22 && tn < 26)) {
        epi_store_vt(T, (tn < 12) ? p.VAT : p.VT, m0, ((tn < 12) ? (tn - 8) : (tn - 22)) * 128);
        return;
    }
    float v[8][4]; epi_load(T, v);
    if (tn < 4 || (tn >= 12 && tn < 16)) {
#pragma unroll
        for (int j = 0; j < 8; ++j)
#pragma unroll
            for (int i = 0; i < 4; ++i) v[j][i] = siluf(v[j][i]);
        epi_store_bf16(v, ((tn < 4) ? p.QA : p.GA) + t * 512 + (tn & 3) * 128);
    } else if (tn < 8) {
        epi_store_bf16(v, p.ZF + t * 512 + (tn - 4) * 128);
    } else if (tn < 18) {
        epi_store_bf16(v, p.QL + t * 256 + (tn - 16) * 128);
    } else if (tn < 22) {
        norm_rope128(v, p.b_knorm + l * 128, (float)p.pos[t], 1.0f, true);
        epi_store_bf16(v, p.KB + t * 512 + (tn - 18) * 128);
    } else {
        float ss = 0.f;
#pragma unroll
        for (int j = 0; j < 4; ++j)
#pragma unroll
            for (int i = 0; i < 4; ++i) ss += v[j][i] * v[j][i];
        ss = quad_sum(ss); const float rstd = rsqrtf(ss * (1.0f / 64.0f) + EPS);
#pragma unroll
        for (int j = 0; j < 4; ++j) { const float4 g = *(const float4*)(p.b_kidx_norm + l * 64 + 16 * j + 4 * q); v[j][0] *= rstd * g.x; v[j][1] *= rstd * g.y; v[j][2] *= rstd * g.z; v[j][3] *= rstd * g.w; }
        rope64(v, 0, (float)p.pos[t]);
#pragma unroll
        for (int j = 0; j < 4; ++j) *(uint2*)(p.KIDX + t * 64 + 16 * j + 4 * q) = make_uint2(pack2(v[j][0], v[j][1]), pack2(v[j][2], v[j][3]));
        *(float4*)(p.WIDX + t * 16 + 4 * q) = make_float4(v[4][0] * 0.03125f, v[4][1] * 0.03125f, v[4][2] * 0.03125f, v[4][3] * 0.03125f);
    }
}
DEVI void ph_inproj(const P& p, int l, float* lds) {
    for (int i = 0;; ++i) {
        int tm, tn2, tn; if (!xcd_unit(i, 14, tm, tn2)) break;
        ATile at{p.H, DM, nullptr, NTOK};
        gemm_unit8(at, tm * 256, p.WIN + ((long)l * 3584 + tn2 * 256) * DM, DM, lds, [&](const tile_t* T, int mr0) __attribute__((always_inline)) NOPK { if (tn < 27) epi_inproj(p, l, T, mr0, tn); }, tn, 2 * tn2, p.dry >= 2 ? p.dry : 0);
    }
}

DEVI void hgrn_state_units(const P& p, int l, float* lds);
DEVI void ph_h1(const P& p, int l, float* lds) {
    const int tid = tidx(), lane = tid & 63;
    if (!p.dry) {
        const int gw = BIDX * 8 + (tid >> 6), nw = GDIMX * 8;
        for (int row = gw; row < NTOK; row += nw) {
            bf16_t* rp = p.QL + (long)row * 256 + 4 * lane; const uint2 u = *(const uint2*)rp;
            float a = bflo(u.x), b = bfhi(u.x), c = bflo(u.y), d = bfhi(u.y);
            float ss = wsum(a * a + b * b + c * c + d * d); const float rstd = rsqrtf(ss * (1.0f / 256.0f) + EPS);
            const float4 g = *(const float4*)(p.b_qlat_gain + l * 256 + 4 * lane);
            *(uint2*)rp = make_uint2(pack2(a * rstd * g.x, b * rstd * g.y), pack2(c * rstd * g.z, d * rstd * g.w));
        }
    }
    hgrn_state_units(p, l, lds);
}
struct HgCol { float b[16]; float kg[16]; float m, bl; };
DEVI void hgrn_cumsum(const P& p, int l, long t0, int h, float* tot  , HgCol& c) {
    const int tid = tidx(), k = tid & 127, sg = tid >> 7;
    const bf16_t* zp = p.ZF + (t0 + 16 * sg) * 512 + h * 128 + k;
    const float lb = p.LB[l * 512 + h * 128 + k];
    bf16_t zr[16];
#pragma unroll
    for (int i = 0; i < 16; ++i) zr[i] = zp[(long)i * 512];
    float run = 0.f;
#pragma unroll
    for (int i = 0; i < 16; ++i) {
        const float z = bf2f(zr[i]);
        const float e = __expf(-fabsf(z)), r1 = __builtin_amdgcn_rcpf(1.0f + e);
        const float sp = (z >= 0.f) ? r1 : e * r1, sn = (z >= 0.f) ? e * r1 : r1;
        const float lf = (lb > 0.f) ? __logf(lb + (1.0f - lb) * sp) : (fminf(z, 0.f) - __logf(1.0f + e));
        c.kg[i] = (1.0f - lb) * sn;
        run += lf; c.b[i] = run;
    }
    __syncthreads();
    tot[sg * 128 + k] = run;
    __syncthreads();
    const float t0_ = tot[k], t1_ = tot[128 + k], t2_ = tot[256 + k], t3_ = tot[384 + k];
    const float off = (sg > 0 ? t0_ : 0.f) + (sg > 1 ? t1_ : 0.f) + (sg > 2 ? t2_ : 0.f);
#pragma unroll
    for (int i = 0; i < 16; ++i) c.b[i] += off;
    c.m = t0_ + t1_; c.bl = (t0_ + t1_) + (t2_ + t3_);
}
DEVI void hgrn_state_units(const P& p, int l, float* lds) {
    char* base = (char*)lds;
    const int tid = tidx(), lane = tid & 63, wv = tid >> 6, l31 = lane & 31, hl = lane >> 5, k = tid & 127, sg = tid >> 7;
    float* tot = (float*)(base + 16384);
    for (int u = BIDX; u < 2048; u += GDIMX) {
        const int bh = u >> 7, c = u & 127, b = bh >> 2, h = bh & 3; const long t0 = (long)b * SEQ + c * 64;
        const bf16_t* vp = p.VAT + (((long)(b * 128 + c) * 512 + h * 128 + 32 * (wv >> 1) + l31) * 64 + 8 * hl);
        const bf16x8 vf0 = *(const bf16x8*)vp, vf1 = *(const bf16x8*)(vp + 16), vf2 = *(const bf16x8*)(vp + 32), vf3 = *(const bf16x8*)(vp + 48);
        HgCol col; hgrn_cumsum(p, l, t0, h, tot, col);
        {
            float kv[16];
#pragma unroll
            for (int i = 0; i < 16; ++i) kv[i] = col.kg[i] * __expf(col.bl - col.b[i]);
            uint4 w0, w1;
            w0.x = pack2(kv[0], kv[1]); w0.y = pack2(kv[2], kv[3]); w0.z = pack2(kv[8], kv[9]); w0.w = pack2(kv[10], kv[11]);
            w1.x = pack2(kv[4], kv[5]); w1.y = pack2(kv[6], kv[7]); w1.z = pack2(kv[12], kv[13]); w1.w = pack2(kv[14], kv[15]);
            *(uint4*)(base + swz(k, 2 * sg)) = w0; *(uint4*)(base + swz(k, 2 * sg + 1)) = w1;
            if (sg == 0) p.DEC[u * 128 + k] = __expf(col.bl);
        }
        __syncthreads();
        {
            const int vt = wv >> 1, kt0 = 2 * (wv & 1);
            f32x16 a0, a1;
#pragma unroll
            for (int r = 0; r < 16; ++r) { a0[r] = 0.f; a1[r] = 0.f; }
#pragma unroll
            for (int ks = 0; ks < 4; ++ks) {
                const bf16x8 vf = (ks == 0) ? vf0 : (ks == 1) ? vf1 : (ks == 2) ? vf2 : vf3;
                const bf16x8 k0 = *(const bf16x8*)(base + swz(32 * kt0 + l31, 2 * ks + hl)), k1 = *(const bf16x8*)(base + swz(32 * kt0 + 32 + l31, 2 * ks + hl));
                a0 = __builtin_amdgcn_mfma_f32_32x32x16_bf16(k0, vf, a0, 0, 0, 0);
                a1 = __builtin_amdgcn_mfma_f32_32x32x16_bf16(k1, vf, a1, 0, 0, 0);
            }
            bf16_t* up = p.UT + (long)u * 16384 + (32 * vt + l31) * 128 + 32 * kt0 + 4 * hl;
#pragma unroll
            for (int g = 0; g < 4; ++g) {
                *(uint2*)(up + 8 * g)      = make_uint2(pack2(a0[4 * g], a0[4 * g + 1]), pack2(a0[4 * g + 2], a0[4 * g + 3]));
                *(uint2*)(up + 32 + 8 * g) = make_uint2(pack2(a1[4 * g], a1[4 * g + 1]), pack2(a1[4 * g + 2], a1[4 * g + 3]));
            }
        }
    }
}
DEVI void ph_h2(const P& p) {
    const long gt = (long)BIDX * NT + tidx(), gs = (long)GDIMX * NT;
    for (long e = gt; e < 16 * 8192; e += gs) {
        const int bh = (int)(e >> 13), vk = (int)(e & 8191) * 2, k = vk & 127; float s0 = 0.f, s1 = 0.f;
        uint32_t* up = (uint32_t*)(p.UT + (long)bh * 128 * 16384 + vk); uint32_t* wp_ = p.dry ? (uint32_t*)(p.H + (long)bh * 128 * 16384 + vk) : up; const float* dp = p.DEC + (long)bh * 128 * 128 + k;
#pragma unroll 1
        for (int c0 = 0; c0 < 128; c0 += 16) {
            uint32_t uu[16]; float2 dd[16];
#pragma unroll
            for (int j = 0; j < 16; ++j) { uu[j] = up[(long)(c0 + j) * 8192]; dd[j] = *(const float2*)(dp + (c0 + j) * 128); }
#pragma unroll
            for (int j = 0; j < 16; ++j) { wp_[(long)(c0 + j) * 8192] = pack2(s0, s1); s0 = dd[j].x * s0 + bflo(uu[j]); s1 = dd[j].y * s1 + bfhi(uu[j]); }
        }
    }
}
DEVI void ph_h3(const P& p, int l, float* lds) {
    char* base = (char*)lds;
    const int tid = tidx(), lane = tid & 63, wv = tid >> 6, l31 = lane & 31, hl = lane >> 5, k = tid & 127, sg = tid >> 7;
    float* tot = (float*)(base + 49152); float* part = (float*)(base + 51200);
    for (int u = BIDX; u < 2048; u += GDIMX) {
        const int bh = u >> 7, c = u & 127, b = bh >> 2, h = bh & 3; const long t0 = (long)b * SEQ + c * 64;
        bf16_t qraw[16];
#pragma unroll
        for (int i = 0; i < 16; ++i) { const long gi = (t0 + 16 * sg + i) * 512 + h * 128 + k; qraw[i] = p.QA[gi]; }
        const int vt = wv >> 1, tt = wv & 1;
        const bf16_t* vp = p.VAT + (((long)(b * 128 + c) * 512 + h * 128 + 32 * vt + l31) * 64 + 8 * hl);
        const bf16_t* sp = p.UT + (long)u * 16384 + (32 * vt + l31) * 128 + 8 * hl;
        bf16x8 vfr[4], sfr[8];
        uint2 ggr[4]; float4 gnr[4];
#pragma unroll
        for (int g = 0; g < 4; ++g) { const int v0 = 32 * vt + 8 * g + 4 * hl; ggr[g] = *(const uint2*)(p.GA + (t0 + 32 * tt + l31) * 512 + h * 128 + v0); gnr[g] = *(const float4*)(p.a_gnorm + l * 128 + v0); }
#pragma unroll
        for (int i = 0; i < 4; ++i) vfr[i] = *(const bf16x8*)(vp + 16 * i);
#pragma unroll
        for (int i = 0; i < 8; ++i) sfr[i] = *(const bf16x8*)(sp + 16 * i);
        HgCol col; hgrn_cumsum(p, l, t0, h, tot, col);
#pragma unroll
        for (int i = 0; i < 16; ++i) {
            const int s = 16 * sg + i;
            const float q = bf2f(qraw[i]), ka = col.kg[i];
            const int o = s * 256 + ((((k >> 3) ^ (s & 15)) << 4) | ((k & 7) << 1));
            *(bf16_t*)(base + o)         = f2bf(q * __expf(col.b[i] - col.m));
            *(bf16_t*)(base + 16384 + o) = f2bf(ka * __expf(col.m - col.b[i]));
            *(bf16_t*)(base + 32768 + o) = f2bf(q * __expf(col.b[i]));
        }
        __syncthreads();
        f32x16 o;
#pragma unroll
        for (int r = 0; r < 16; ++r) o[r] = 0.f;
        const int tro = (32 * tt + l31) * 256, trx = l31 & 15;
#pragma unroll
        for (int st = 0; st < 2; ++st) {
            if (st <= tt) {
                f32x16 sacc;
#pragma unroll
                for (int r = 0; r < 16; ++r) sacc[r] = 0.f;
#pragma unroll
                for (int ks = 0; ks < 8; ++ks) {
                    const bf16x8 kf = *(const bf16x8*)(base + 16384 + (32 * st + l31) * 256 + (((2 * ks + hl) ^ trx) << 4));
                    const bf16x8 qf = *(const bf16x8*)(base + tro + (((2 * ks + hl) ^ trx) << 4));
                    sacc = __builtin_amdgcn_mfma_f32_32x32x16_bf16(kf, qf, sacc, 0, 0, 0);
                }
                float ps[16];
#pragma unroll
                for (int r = 0; r < 16; ++r) { const int sl = (r & 3) + 8 * (r >> 2) + 4 * hl; ps[r] = (st < tt || sl <= l31) ? sacc[r] : 0.f; }
#pragma unroll
                for (int s_ = 0; s_ < 2; ++s_) {
                    union { bf16x8 v; uint32_t w[4]; } pf;
#pragma unroll
                    for (int e = 0; e < 4; ++e) pf.w[e] = pack2(ps[8 * s_ + 2 * e], ps[8 * s_ + 2 * e + 1]);
                    const bf16x8 vf = vfr[2 * st + s_];
                    o = __builtin_amdgcn_mfma_f32_32x32x16_bf16(vf, pf.v, o, 0, 0, 0);
                }
            }
        }
        {
#pragma unroll
            for (int ks = 0; ks < 8; ++ks) {
                const bf16x8 sf = sfr[ks];
                const bf16x8 qf = *(const bf16x8*)(base + 32768 + tro + (((2 * ks + hl) ^ trx) << 4));
                o = __builtin_amdgcn_mfma_f32_32x32x16_bf16(sf, qf, o, 0, 0, 0);
            }
        }
        float ss = 0.f;
#pragma unroll
        for (int r = 0; r < 16; ++r) ss += o[r] * o[r];
        ss += __int_as_float(__builtin_amdgcn_ds_bpermute((lane ^ 32) << 2, __float_as_int(ss)));
        if (hl == 0) part[vt * 64 + 32 * tt + l31] = ss;
        __syncthreads();
        const int t = 32 * tt + l31;
        const float rstd = rsqrtf((part[t] + part[64 + t] + part[128 + t] + part[192 + t]) * (1.0f / 128.0f) + EPS);
#pragma unroll
        for (int g = 0; g < 4; ++g) {
            const int v0 = 32 * vt + 8 * g + 4 * hl;
            const float4 gn = gnr[g]; const uint2 gg = ggr[g];
            *(uint2*)(p.H + (t0 + t) * 1024 + h * 128 + v0) = make_uint2(pack2(o[4 * g] * rstd * gn.x * bflo(gg.x), o[4 * g + 1] * rstd * gn.y * bfhi(gg.x)),
                                                                        pack2(o[4 * g + 2] * rstd * gn.z * bflo(gg.y), o[4 * g + 3] * rstd * gn.w * bfhi(gg.y)));
        }
    }
}

DEVI void ph_qproj(const P& p, int l, float* lds) {
    for (int i = 0;; ++i) {
        int tm, tn2, tn; if (!xcd_unit(i, 6, tm, tn2)) break;
        ATile at{p.QL, 256, nullptr, NTOK};
        gemm_unit8(at, tm * 256, p.WQ + ((long)l * 1536 + tn2 * 256) * 256, 256, lds, [&](const tile_t* T, int mr0) __attribute__((always_inline)) NOPK {
            const int row = tidx() >> 2, q = tidx() & 3; const long t = mr0 + row;
            float v[8][4]; epi_load(T, v);
            if (tn < 4) {
                norm_rope128(v, p.b_qnorm + l * 128, (float)p.pos[t], QSCALE, true);
                epi_store_bf16(v, p.QB + t * 512 + tn * 128);
            } else {
                const float posf = (float)p.pos[t]; rope64(v, 0, posf); rope64(v, 4, posf);
                const int h0 = 2 * (tn - 4); const float w0 = p.WIDX[t * 16 + h0], w1 = p.WIDX[t * 16 + h0 + 1];
#pragma unroll
                for (int j = 0; j < 8; ++j)
#pragma unroll
                    for (int i = 0; i < 4; ++i) v[j][i] *= (j < 4) ? w0 : w1;
                epi_store_bf16(v, p.QIDX + t * 1024 + h0 * 64);
            }
        }, tn, 2 * tn2);
    }
}
constexpr int IXCAP = 624;
constexpr int IXSTR = IXCAP + 1;
constexpr int IX_QP = 0, IX_LIST = 69632, IX_CNT = IX_LIST + 32 * IXSTR * 4, IX_CNTN = IX_CNT + 128, IX_THR = IX_CNTN + 128;
typedef LAS unsigned* lds_u32p;
DEVI unsigned lds_add_rtn(unsigned* p, unsigned v) { return __hip_atomic_fetch_add((lds_u32p)p, v, __ATOMIC_RELAXED, __HIP_MEMORY_SCOPE_WORKGROUP); }
DEVI void lds_add(unsigned* p, unsigned v) { (void)__hip_atomic_fetch_add((lds_u32p)p, v, __ATOMIC_RELAXED, __HIP_MEMORY_SCOPE_WORKGROUP); }
DEVI void lds_or(unsigned* p, unsigned v) { (void)__hip_atomic_fetch_or((lds_u32p)p, v, __ATOMIC_RELAXED, __HIP_MEMORY_SCOPE_WORKGROUP); }
DEVI unsigned wmaxu(unsigned v) {
    v = max(v, (unsigned)DPP_I((int)v, (int)v, 0xB1, 0xF)); v = max(v, (unsigned)DPP_I((int)v, (int)v, 0x4E, 0xF)); v = max(v, (unsigned)DPP_I((int)v, (int)v, 0x141, 0xF)); v = max(v, (unsigned)DPP_I((int)v, (int)v, 0x140, 0xF));
    v = max(v, (unsigned)DPP_I((int)v, (int)v, 0x142, 0xA)); v = max(v, (unsigned)DPP_I((int)v, (int)v, 0x143, 0xC));
    return (unsigned)__builtin_amdgcn_readlane((int)v, 63);
}
DEVI unsigned prune_bis(unsigned* lst_, int n, int lane, int target, int hi, int& cnt_out) {
    lds_u32p lst = (lds_u32p)lst_;
    unsigned v[10];
#pragma unroll
    for (int j = 0; j < 10; ++j) v[j] = (lane + 64 * j < n) ? lst[lane + 64 * j] : 0u;
    unsigned mx = 0u, mn = 0u;
#pragma unroll
    for (int j = 0; j < 10; ++j) { mx = max(mx, v[j]); mn = max(mn, (lane + 64 * j < n) ? ~v[j] : 0u); }
    mx = wmaxu(mx); mn = ~wmaxu(mn);
    const unsigned diff = mx ^ mn;
    int bit = 31 - __builtin_clz(diff | 1u);
    unsigned thr = (bit >= 31) ? 0u : (mx & ~((2u << bit) - 1u));
    int cnt = n;
#pragma unroll 1
    for (; bit >= 0 && cnt > hi; --bit) {
        const unsigned trial = thr | (1u << bit); int c = 0;
#pragma unroll
        for (int j = 0; j < 10; ++j) c += __builtin_popcountll(__builtin_amdgcn_ballot_w64(v[j] >= trial));
        if (c >= target) { thr = trial; cnt = c; }
    }
    int basep = 0;
#pragma unroll
    for (int j = 0; j < 10; ++j) {
        const bool keep = v[j] >= thr; const unsigned long long m = __builtin_amdgcn_ballot_w64(keep);
        const int pos = basep + (int)__builtin_amdgcn_mbcnt_hi((unsigned)(m >> 32), __builtin_amdgcn_mbcnt_lo((unsigned)m, 0u));
        if (keep) lst[pos] = v[j];
        basep += __builtin_popcountll(m);
    }
    cnt_out = basep;
    return thr;
}
DEVI unsigned prune256(unsigned* lst_, int n, int lane, bool exact, int& cnt_out) { return prune_bis(lst_, n, lane, 256, exact ? 256 : 320, cnt_out); }
constexpr int IX_KEEP = IXCAP - 256;
DEVI unsigned prune_bucket(unsigned* lst_, int n, int lane, unsigned* hist  , int& cnt_out) {
    lds_u32p lst = (lds_u32p)lst_; lds_u32p hs = (lds_u32p)hist;
    unsigned v[10];
#pragma unroll
    for (int j = 0; j < 10; ++j) v[j] = (lane + 64 * j < n) ? lst[lane + 64 * j] : 0u;
    unsigned mx = 0u, mn = 0u;
#pragma unroll
    for (int j = 0; j < 10; ++j) { mx = max(mx, v[j]); mn = max(mn, (lane + 64 * j < n) ? ~v[j] : 0u); }
    mx = wmaxu(mx); mn = ~wmaxu(mn);
    const unsigned range = mx - mn;
    const int sh = max(0, 26 - (int)__builtin_clz(range | 1u));
    hs[lane] = 0u;
    __builtin_amdgcn_wave_barrier();
#pragma unroll
    for (int j = 0; j < 10; ++j) if (lane + 64 * j < n) lds_add((unsigned*)(hist + ((v[j] - mn) >> sh)), 1u);
    __builtin_amdgcn_wave_barrier();
    asm volatile("s_waitcnt lgkmcnt(0)" ::: "memory");
    const int suf = wscan_incl((int)hs[63 - lane]);
    const unsigned long long ok = __builtin_amdgcn_ballot_w64(suf >= 256);
    const int i0 = __builtin_ctzll(ok | (1ull << 63));
    const int kept = __builtin_amdgcn_readlane(suf, i0);
    if (kept > IX_KEEP) { return prune256(lst_, n, lane, false, cnt_out); }
    const unsigned thr = mn + ((unsigned)(63 - i0) << sh);
    int basep = 0;
#pragma unroll
    for (int j = 0; j < 10; ++j) {
        const bool keep = v[j] >= thr && (lane + 64 * j < n); const unsigned long long m = __builtin_amdgcn_ballot_w64(keep);
        const int pos = basep + (int)__builtin_amdgcn_mbcnt_hi((unsigned)(m >> 32), __builtin_amdgcn_mbcnt_lo((unsigned)m, 0u));
        if (keep) lst[pos] = v[j];
        basep += __builtin_popcountll(m);
    }
    cnt_out = basep;
    return thr;
}
#define IX_BAR() do { asm volatile("s_waitcnt lgkmcnt(0)\n\ts_barrier" ::: "memory"); if (PROBE_X == 2) asm volatile("s_waitcnt lgkmcnt(0)\n\ts_barrier" ::: "memory"); } while (0)
DEVI void ix_append(const unsigned (&pk)[16], unsigned* CNT, unsigned* LIST, unsigned* THR, int l31, int dry = 0) {
    if (dry >= 4) return;
    const unsigned thrq = THR[l31]; unsigned c2 = 0;
#pragma unroll
    for (int r = 0; r < 16; ++r) c2 += (pk[r] > thrq) ? 1u : 0u;
    if (c2) { unsigned pos = lds_add_rtn(&CNT[l31], c2); lds_u32p lq = (lds_u32p)(LIST + l31 * IXSTR);
#pragma unroll
        for (int r = 0; r < 16; ++r) if (pk[r] > thrq) { lq[dry ? (pos & 511u) : pos] = pk[r]; ++pos; } }
}
DEVI void ix_append_free(const unsigned (&pk)[16], unsigned* CNT, unsigned* LIST, unsigned thrq, unsigned* FAIL, int l31) {
    unsigned c2 = 0;
#pragma unroll
    for (int r = 0; r < 16; ++r) c2 += (pk[r] > thrq) ? 1u : 0u;
    if (c2) { unsigned pos = lds_add_rtn(&CNT[l31], c2);
        if (pos + c2 <= (unsigned)IXCAP) { lds_u32p lq = (lds_u32p)(LIST + l31 * IXSTR);
#pragma unroll
            for (int r = 0; r < 16; ++r) if (pk[r] > thrq) { lq[pos] = pk[r]; ++pos; } }
        else *FAIL = 1u; }
}
DEVI void index_unit(const P& p, int b, int q0, float* lds) {
    char* base = (char*)lds;
    const int tid = tidx(), lane = tid & 63, wv = tid >> 6, l31 = lane & 31, h = lane >> 5;
    const long t0 = (long)b * SEQ + q0; const int L = ((q0 >> 6) + 1) * 64, nw = L >> 5;
    if (L <= 256) { for (int e = tid; e < 32 * nw; e += NT) p.MASK[(t0 + e / nw) * 256 + (e % nw)] = 0xFFFFFFFFu; return; }
    unsigned* LIST = (unsigned*)(base + IX_LIST); unsigned* CNT = (unsigned*)(base + IX_CNT); unsigned* CNTN = (unsigned*)(base + IX_CNTN); unsigned* THR = (unsigned*)(base + IX_THR);
    unsigned* BIG = THR + 32; unsigned* FAIL = THR + 33; unsigned* HIST = THR + 64;
    __syncthreads();
#pragma unroll
    for (int i = 0; i < 8; ++i) { const int c = tid + 512 * i, qy = c >> 7, rem = c & 127, hd = rem >> 3, ch = rem & 7;
        *(uint4*)(base + IX_QP + swz(hd * 32 + qy, ch)) = *(const uint4*)(p.QIDX + (t0 + qy) * 1024 + hd * 64 + ch * 8); }
    if (tid < 256) {
        const int qy = tid >> 3, ch = tid & 7; float a[8];
#pragma unroll
        for (int e = 0; e < 8; ++e) a[e] = 0.f;
#pragma unroll 4
        for (int hd = 0; hd < 16; ++hd) { const uint4 w = *(const uint4*)(p.QIDX + (t0 + qy) * 1024 + hd * 64 + ch * 8);
            a[0] += bflo(w.x); a[1] += bfhi(w.x); a[2] += bflo(w.y); a[3] += bfhi(w.y); a[4] += bflo(w.z); a[5] += bfhi(w.z); a[6] += bflo(w.w); a[7] += bfhi(w.w); }
        uint4 o; o.x = pack2(a[0], a[1]); o.y = pack2(a[2], a[3]); o.z = pack2(a[4], a[5]); o.w = pack2(a[6], a[7]);
        *(uint4*)(base + IX_QP + swz(512 + qy, ch)) = o;
    }
    unsigned sgbits = 0u;
    { const float4* wp = (const float4*)(p.WIDX + (t0 + l31) * 16);
#pragma unroll
      for (int g = 0; g < 4; ++g) { const float4 w = wp[g]; sgbits |= (w.x < 0.f ? 1u : 0u) << (4 * g); sgbits |= (w.y < 0.f ? 2u : 0u) << (4 * g); sgbits |= (w.z < 0.f ? 4u : 0u) << (4 * g); sgbits |= (w.w < 0.f ? 8u : 0u) << (4 * g); } }
    const int ntile = (L + 511) >> 9;
    const bf16_t* kbase = p.KIDX + ((long)b * SEQ + 64 * wv + l31) * 64 + 8 * h;
    const int boff = IX_QP + l31 * 128, bx = (l31 >> 1) & 7;
    constexpr int IX_EXP = 425;
    const int k1 = (ntile >= 8) ? (IX_EXP * 512 + 2047) / 2048 : (IX_EXP * 512 + L - 1) / L, k2 = (IX_EXP * 2048 + L - 1) / L;
    bf16x8 a0, a1, a2, a3, e0, e1, e2, e3;
#pragma unroll 1
    for (int safe = (ntile <= 2 || p.dry >= 2) ? 1 : 0; safe < 2; ++safe) {
    if (tid < 32) { CNT[tid] = 0u; CNTN[tid] = 0u; THR[tid] = 0u; }
    if (tid == 0) { *BIG = 0u; *FAIL = 0u; }
    __syncthreads();
#define IX_LDA(KP) { const bf16_t* kp_ = (KP); a0 = *(const bf16x8*)kp_; a1 = *(const bf16x8*)(kp_ + 16); a2 = *(const bf16x8*)(kp_ + 32); a3 = *(const bf16x8*)(kp_ + 48); \
                     e0 = *(const bf16x8*)(kp_ + 2048); e1 = *(const bf16x8*)(kp_ + 2064); e2 = *(const bf16x8*)(kp_ + 2080); e3 = *(const bf16x8*)(kp_ + 2096); }
    if (64 * wv < L) IX_LDA(kbase)
#pragma unroll 1
    for (int kt = 0; kt < ntile; ++kt) {
        const int key0 = kt * 512 + 64 * wv; const bool active = key0 < L;
        const bf16x8 c0 = a0, c1 = a1, c2 = a2, c3 = a3, d0 = e0, d1 = e1, d2 = e2, d3 = e3;
        if (key0 + 512 < L) IX_LDA(kbase + (long)(kt + 1) * 512 * 64)
        unsigned pk0[16], pk1[16];
        int boffv = boff; asm volatile("" : "+v"(boffv));
        if (active) {
            f32x16 s0, s1;
#pragma unroll
            for (int r = 0; r < 16; ++r) { s0[r] = 0.f; s1[r] = 0.f; }
#define IX_CHAIN(ACC0, ACC1, BP) { const bf16x8 q0_ = *(const bf16x8*)((BP) + (((0 + h) ^ bx) << 4)), q1_ = *(const bf16x8*)((BP) + (((2 + h) ^ bx) << 4)); \
              const bf16x8 q2_ = *(const bf16x8*)((BP) + (((4 + h) ^ bx) << 4)), q3_ = *(const bf16x8*)((BP) + (((6 + h) ^ bx) << 4)); \
              ACC0 = __builtin_amdgcn_mfma_f32_32x32x16_bf16(c0, q0_, ACC0, 0, 0, 0); ACC1 = __builtin_amdgcn_mfma_f32_32x32x16_bf16(d0, q0_, ACC1, 0, 0, 0); \
              ACC0 = __builtin_amdgcn_mfma_f32_32x32x16_bf16(c1, q1_, ACC0, 0, 0, 0); ACC1 = __builtin_amdgcn_mfma_f32_32x32x16_bf16(d1, q1_, ACC1, 0, 0, 0); \
              ACC0 = __builtin_amdgcn_mfma_f32_32x32x16_bf16(c2, q2_, ACC0, 0, 0, 0); ACC1 = __builtin_amdgcn_mfma_f32_32x32x16_bf16(d2, q2_, ACC1, 0, 0, 0); \
              ACC0 = __builtin_amdgcn_mfma_f32_32x32x16_bf16(c3, q3_, ACC0, 0, 0, 0); ACC1 = __builtin_amdgcn_mfma_f32_32x32x16_bf16(d3, q3_, ACC1, 0, 0, 0); }
            IX_CHAIN(s0, s1, base + boffv + 16 * 4096)
#pragma unroll 2
            for (int hd = 0; hd < 16; ++hd) {
                const float sgf = ((sgbits >> hd) & 1u) ? -1.f : 1.f;
                f32x16 u0, u1;
#pragma unroll
                for (int r = 0; r < 16; ++r) { u0[r] = 0.f; u1[r] = 0.f; }
                IX_CHAIN(u0, u1, base + boffv + hd * 4096)
#pragma unroll
                for (int r = 0; r < 16; ++r) { s0[r] = __builtin_fmaf(sgf, __builtin_fabsf(u0[r]), s0[r]); s1[r] = __builtin_fmaf(sgf, __builtin_fabsf(u1[r]), s1[r]); }
            }
#undef IX_CHAIN
            if (p.dry == 2) { float mxs = s0[0];
#pragma unroll
                for (int r = 1; r < 16; ++r) mxs = fmaxf(mxs, fmaxf(s0[r], s1[r]));
                if (mxs == 1.2345e30f) p.MASK[0] = 1u; }
#pragma unroll
            for (int r = 0; r < 16; ++r) { const unsigned ko = (unsigned)(key0 + (r & 3) + 8 * (r >> 2) + 4 * h);
                pk0[r] = (ordf(s0[r]) & 0xFFFFE000u) | ko; pk1[r] = (ordf(s1[r]) & 0xFFFFE000u) | (ko + 32u); }
        } else {
#pragma unroll
            for (int r = 0; r < 16; ++r) { pk0[r] = 0u; pk1[r] = 0u; }
        }
        if (p.dry == 2) continue;
        if (!safe) {
            if (kt == 1 || (kt == 4 && ntile >= 8)) {
                IX_BAR();
#pragma unroll 1
                for (int qq = wv; qq < 32; qq += 8) {
                    const int n = (int)CNT[qq], k = (kt == 1) ? k1 : k2;
                    if (n > IXCAP) { if (lane == 0) *FAIL = 1u; }
                    else { int kept; const unsigned T = prune_bis(LIST + qq * IXSTR, n, lane, k, k + max(k >> 4, 2), kept); if (lane == 0) { CNT[qq] = (unsigned)kept; THR[qq] = max(THR[qq], T); } }
                }
                IX_BAR();
            }
            if (active) { const unsigned thrq = THR[l31]; ix_append_free(pk0, CNT, LIST, thrq, FAIL, l31); ix_append_free(pk1, CNT, LIST, thrq, FAIL, l31); }
            continue;
        }
        if (active) { const unsigned thrq = THR[l31]; unsigned c = 0;
#pragma unroll
            for (int r = 0; r < 16; ++r) { c += (pk0[r] > thrq) ? 1u : 0u; c += (pk1[r] > thrq) ? 1u : 0u; }
            if (c) lds_add(&CNTN[l31], c); }
        IX_BAR();
#pragma unroll 1
        for (int qq = wv; qq < 32; qq += 8) {
            const int n = (int)CNT[qq], nn = (int)CNTN[qq];
            if (n + nn > IXCAP && p.dry < 3) { int kept; unsigned T = prune_bucket(LIST + qq * IXSTR, n, lane, HIST + 64 * wv, kept); if (PROBE_X == 1) T = prune_bucket(LIST + qq * IXSTR, kept, lane, HIST + 64 * wv, kept); if (lane == 0) { CNT[qq] = (unsigned)kept; THR[qq] = T; if (nn > IXCAP - IX_KEEP) *BIG = 1u; } }
            if (lane == 0) CNTN[qq] = 0u;
        }
        IX_BAR();
        const unsigned big = *BIG;
        if (active) ix_append(pk0, CNT, LIST, THR, l31, p.dry >= 3 ? p.dry : 0);
        if (big) {
            if (active) { const unsigned thrq = THR[l31]; unsigned c = 0;
#pragma unroll
                for (int r = 0; r < 16; ++r) c += (pk1[r] > thrq) ? 1u : 0u;
                if (c) lds_add(&CNTN[l31], c); }
            IX_BAR();
#pragma unroll 1
            for (int qq = wv; qq < 32; qq += 8) {
                const int n = (int)CNT[qq], nn = (int)CNTN[qq];
                if (n + nn > IXCAP && p.dry < 3) { int kept; const unsigned T = prune_bucket(LIST + qq * IXSTR, n, lane, HIST + 64 * wv, kept); if (lane == 0) { CNT[qq] = (unsigned)kept; THR[qq] = T; } }
                if (lane == 0) CNTN[qq] = 0u;
            }
            if (tid == 0) *BIG = 0u;
            IX_BAR();
        }
        if (active) ix_append(pk1, CNT, LIST, THR, l31, p.dry >= 3 ? p.dry : 0);
    }
    __syncthreads();
    if (safe) break;
    { const unsigned cn = CNT[l31]; const bool bad = (*FAIL != 0u) || cn < 256u || cn > (unsigned)IXCAP;
      if (__builtin_amdgcn_ballot_w64(bad) == 0ull) break; }
    __syncthreads();
    }
#undef IX_LDA
    if (p.dry >= 2) return;
    if (p.dry == 1 && PROBE_DRY6 == 1 && (PROBE_MASK & 0x100000u)) return;
#pragma unroll 1
    for (int qq = wv; qq < 32; qq += 8) { const int n = (int)CNT[qq]; if (n > 256) { int kept; (void)prune256(LIST + qq * IXSTR, n, lane, true, kept); } }
    unsigned* MR = (unsigned*)(base + IX_QP);
    for (int e = tid; e < 32 * 256; e += NT) MR[e] = 0u;
    __syncthreads();
#pragma unroll 1
    for (int qq = wv; qq < 32; qq += 8) {
#pragma unroll
        for (int j = 0; j < 4; ++j) { const unsigned idx = LIST[qq * IXSTR + lane + 64 * j] & 0x1FFFu; lds_or(&MR[qq * 256 + (idx >> 5)], 1u << (idx & 31u)); }
    }
    __syncthreads();
    for (int e = tid; e < 32 * nw; e += NT) { const int qy = e / nw, w = e % nw; p.MASK[(t0 + qy) * 256 + w] = MR[qy * 256 + w]; }
}
DEVI void ph_indexer(const P& p, float* lds) {
    for (int w = BIDX; w < 256; w += GDIMX) {
        const int b = w >> 6, j = w & 63;
#pragma unroll 1
        for (int ui = 0; ui < 4; ++ui) {
            const int blk = (ui == 0) ? j : (ui == 1) ? 127 - j : (ui == 2) ? 128 + j : 255 - j;
            index_unit(p, b, blk * 32, lds);
        }
    }
}
DEVI float gain_bound(const float* gq, const float* gk) {
    float a = 0.f, b = 0.f;
    for (int i = 0; i < 128; ++i) { a = fmaxf(a, fabsf(gq[i])); b = fmaxf(b, fabsf(gk[i])); }
    return -(16.33f * a * b + 0.25f);
}
DEVI void attn_unit(const bf16_t* Qp, int ldq, const bf16_t* Kb, const bf16_t* VTb, const unsigned* maskp, bf16_t* Op, int ldo, int nt, int wave_nt, float negB, float* lds) {
    char* base = (char*)lds;
    const int tid = tidx(), lane = tid & 63, wv = tid >> 6, l31 = lane & 31, h = lane >> 5;
    bf16x8 qf[8];
    { const bf16_t* qr = Qp + (long)(32 * wv + l31) * ldq + 8 * h;
#pragma unroll
      for (int ks = 0; ks < 8; ++ks) qf[ks] = *(const bf16x8*)(qr + 16 * ks); }
    const unsigned* mrow = maskp ? maskp + (long)(32 * wv + l31) * 256 : nullptr;
    const bf16_t* kdp[4]; const bf16_t* vdp[2];
#pragma unroll
    for (int i = 0; i < 4; ++i) { const int row = 16 * wv + 4 * i + (lane >> 4), ch = (lane & 15) ^ (row & 15); kdp[i] = Kb + (long)row * 512 + ch * 8; }
#pragma unroll
    for (int i = 0; i < 2; ++i) { const int row = 16 * wv + 8 * i + (lane >> 3), ch = (lane & 7) ^ ((row >> 1) & 7); vdp[i] = VTb + (long)row * 64 + ch * 8; }
    const int kdo = wv * 4096 + lane * 16, vdo = 32768 + wv * 2048 + lane * 16;
    const int kr = l31 * 256, kx = l31 & 15;
    f32x16 o0, o1, o2, o3;
#pragma unroll
    for (int r = 0; r < 16; ++r) { o0[r] = 0.f; o1[r] = 0.f; o2[r] = 0.f; o3[r] = 0.f; }
    float rsum = 0.f;
    const int ns = nt >> 1;
#define ATT_DMA(S, ST) { const long ko_ = (long)(S) * 128 * 512, vo_ = (long)(S) * 2 * 512 * 64; \
        GLDS16(kdp[0] + ko_, base + (ST) + kdo); GLDS16(kdp[1] + ko_, base + (ST) + kdo + 1024); GLDS16(kdp[2] + ko_, base + (ST) + kdo + 2048); GLDS16(kdp[3] + ko_, base + (ST) + kdo + 3072); \
        GLDS16(vdp[0] + vo_, base + (ST) + vdo); GLDS16(vdp[1] + vo_, base + (ST) + vdo + 1024); \
        GLDS16(vdp[0] + vo_ + 512 * 64, base + (ST) + vdo + 16384); GLDS16(vdp[1] + vo_ + 512 * 64, base + (ST) + vdo + 16384 + 1024); }
    __syncthreads();
    ATT_DMA(0, 0)
    asm volatile("s_waitcnt vmcnt(0)\n\ts_barrier" ::: "memory");
    uint4 mwn = make_uint4(0xFFFFFFFFu, 0xFFFFFFFFu, 0xFFFFFFFFu, 0xFFFFFFFFu);
    if (mrow && wave_nt > 0) mwn = *(const uint4*)mrow;
#pragma unroll 1
    for (int sp = 0; sp < ns; ++sp) {
        const int st = (sp & 1) * 65536, sn = 65536 - st;
        const bool more = (sp + 1) < ns;
        const uint4 mw = mwn;
        if (mrow && 2 * (sp + 1) < wave_nt) mwn = *(const uint4*)(mrow + 4 * (sp + 1));
        if (more) ATT_DMA(sp + 1, sn)
#define ATT_BIAS(S, W) { _Pragma("unroll") for (int r = 0; r < 16; ++r) { const unsigned sel = (unsigned)__builtin_amdgcn_sbfe((int)(W), (r & 3) + 8 * (r >> 2), 1); \
                          S[r] = __uint_as_float((sel & __float_as_uint(negB)) | (~sel & 0xFF800000u)); } }
#define ATT_QK(S, KK, J) { _Pragma("unroll") for (int ks = 0; ks < 8; ++ks) { const bf16x8 kf = *(const bf16x8*)(base + st + (J) * 16384 + (KK) * 8192 + kr + (((2 * ks + h) ^ kx) << 4)); \
                          S = __builtin_amdgcn_mfma_f32_32x32x16_bf16(kf, qf[ks], S, 0, 0, 0); } }
#define ATT_PV(S, KK, J) { float ps[16]; _Pragma("unroll") for (int r = 0; r < 16; ++r) { ps[r] = __builtin_amdgcn_exp2f(S[r]); rsum += ps[r]; } \
                        _Pragma("unroll") for (int s_ = 0; s_ < 2; ++s_) { union { bf16x8 v; uint32_t u[4]; } pf; \
                            _Pragma("unroll") for (int e = 0; e < 4; ++e) pf.u[e] = pack2(ps[8 * s_ + 2 * e], ps[8 * s_ + 2 * e + 1]); \
                            const int vo = st + 32768 + (J) * 16384 + l31 * 128 + ((((2 * (2 * (KK) + s_) + h)) ^ ((l31 >> 1) & 7)) << 4); \
                            o0 = __builtin_amdgcn_mfma_f32_32x32x16_bf16(*(const bf16x8*)(base + vo), pf.v, o0, 0, 0, 0); \
                            o1 = __builtin_amdgcn_mfma_f32_32x32x16_bf16(*(const bf16x8*)(base + vo + 4096), pf.v, o1, 0, 0, 0); \
                            o2 = __builtin_amdgcn_mfma_f32_32x32x16_bf16(*(const bf16x8*)(base + vo + 8192), pf.v, o2, 0, 0, 0); \
                            o3 = __builtin_amdgcn_mfma_f32_32x32x16_bf16(*(const bf16x8*)(base + vo + 12288), pf.v, o3, 0, 0, 0); } }
#define ATT_SUB(J, W0, W1) if (2 * sp + (J) < wave_nt) { f32x16 sa, sb; \
            ATT_BIAS(sa, (W0) >> (4 * h)) ATT_BIAS(sb, (W1) >> (4 * h)) \
            __builtin_amdgcn_s_setprio(1); ATT_QK(sa, 0, J) ATT_QK(sb, 1, J) __builtin_amdgcn_s_setprio(0); \
            __builtin_amdgcn_sched_barrier(0); ATT_PV(sa, 0, J) __builtin_amdgcn_sched_barrier(0); ATT_PV(sb, 1, J) }
        ATT_SUB(0, mw.x, mw.y)
        ATT_SUB(1, mw.z, mw.w)
#undef ATT_SUB
#undef ATT_BIAS
#undef ATT_QK
#undef ATT_PV
        asm volatile("s_waitcnt vmcnt(0) lgkmcnt(0)\n\ts_barrier" ::: "memory");
    }
#undef ATT_DMA
    rsum += __int_as_float(__builtin_amdgcn_ds_bpermute((lane ^ 32) << 2, __float_as_int(rsum)));
    const float inv = 1.0f / rsum;
    bf16_t* orow = Op + (long)(32 * wv + l31) * ldo + 4 * h;
#pragma unroll
    for (int g = 0; g < 4; ++g) {
        *(uint2*)(orow + 8 * g)      = make_uint2(pack2(o0[4 * g] * inv, o0[4 * g + 1] * inv), pack2(o0[4 * g + 2] * inv, o0[4 * g + 3] * inv));
        *(uint2*)(orow + 32 + 8 * g) = make_uint2(pack2(o1[4 * g] * inv, o1[4 * g + 1] * inv), pack2(o1[4 * g + 2] * inv, o1[4 * g + 3] * inv));
        *(uint2*)(orow + 64 + 8 * g) = make_uint2(pack2(o2[4 * g] * inv, o2[4 * g + 1] * inv), pack2(o2[4 * g + 2] * inv, o2[4 * g + 3] * inv));
        *(uint2*)(orow + 96 + 8 * g) = make_uint2(pack2(o3[4 * g] * inv, o3[4 * g + 1] * inv), pack2(o3[4 * g + 2] * inv, o3[4 * g + 3] * inv));
    }
}
DEVI void ph_dsa_attn(const P& p, int l, float* lds) {
    const float negB = gain_bound(p.b_qnorm + l * 128, p.b_knorm + l * 128);
    const int wv = tidx() >> 6;
    for (int w = BIDX; w < 256; w += GDIMX) {
        const int combo = w & 15, b = combo >> 2, head = combo & 3, pr = w >> 4;
#pragma unroll 1
        for (int side = 0; side < 2; ++side) {
            const int qb = side ? 31 - pr : pr; const long t0 = (long)b * SEQ + qb * 256;
            attn_unit(p.QB + t0 * 512 + head * 128, 512, p.KB + (long)b * SEQ * 512 + head * 128, p.VT + ((long)b * 128 * 512 + head * 128) * 64, p.MASK + t0 * 256,
                      p.H + t0 * 1024 + 512 + head * 128, 1024, 4 * qb + 4, 4 * qb + (wv >> 1) + 1, negB, lds);
        }
    }
}
DEVI void ph_xattn(const P& p, int l, float* lds) {
    const float negB = gain_bound(p.x_qnorm + l * 128, p.x_knorm + l * 128);
    for (int u = BIDX; u < 512; u += GDIMX) {
        const int combo = u & 15, b = combo >> 2, head = combo & 3, qb = u >> 4; const long t0 = (long)b * SEQ + qb * 256;
        attn_unit(p.QX + t0 * 512 + head * 128, 512, p.XK + ((long)(l * 4 + b) * 256) * 512 + head * 128, p.XVT + ((long)(l * 4 + b) * 4 * 512 + head * 128) * 64, nullptr,
                  p.OX + t0 * 512 + head * 128, 512, 4, 4, negB, lds);
    }
}

DEVI void resid_epi_unit(const float* rsrc, float* dst, const tile_t* T, int m0, int tn_base) {
    const int row = tidx() >> 2, q = tidx() & 3;
    float4 cur[8], nxt[8];
    { const float* rp = rsrc + (long)(m0 + row) * DM + tn_base * 128 + 4 * q;
#pragma unroll
      for (int j = 0; j < 8; ++j) cur[j] = *(const float4*)(rp + 16 * j); }
#pragma unroll
    for (int sub = 0; sub < 4; ++sub) {
        if (sub < 3) { const int ns = sub + 1; const float* np = rsrc + (long)(m0 + 128 * (ns >> 1) + row) * DM + (tn_base + (ns & 1)) * 128 + 4 * q;
#pragma unroll
            for (int j = 0; j < 8; ++j) nxt[j] = *(const float4*)(np + 16 * j); }
        const tile_t* Ts = T + (sub >> 1) * 128 * TLD + 128 * (sub & 1);
        float* op = dst + (long)(m0 + 128 * (sub >> 1) + row) * DM + (tn_base + (sub & 1)) * 128 + 4 * q;
#pragma unroll
        for (int j = 0; j < 8; ++j) { const float4 t = t_ld4(Ts, row * TLD + 16 * j + 4 * q); float4 o = cur[j];
            o.x += t.x; o.y += t.y; o.z += t.z; o.w += t.w; *(float4*)(op + 16 * j) = o; }
#pragma unroll
        for (int j = 0; j < 8; ++j) cur[j] = nxt[j];
    }
}
DEVI void ph_outproj(const P& p, int l, float* lds) {
    for (int i = 0;; ++i) {
        int tm, tn2, tn; if (!xcd_unit(i, 4, tm, tn2)) break;
        ATile at{p.H, DM, nullptr, NTOK};
        gemm_unit8(at, tm * 256, p.WOUT + ((long)l * DM + tn2 * 256) * DM, DM, lds, [&](const tile_t* T, int mr0) __attribute__((always_inline)) NOPK {
            resid_epi_unit((l == 0) ? p.x : p.out, p.out, T, mr0, tn);
        }, tn, 2 * tn2, 0, true);
    }
}
DEVI void ph_xq(const P& p, int l, float* lds) {
    for (int i = 0;; ++i) {
        int tm, tn2, tn; if (!xcd_unit(i, 2, tm, tn2)) break;
        ATile at{p.H, DM, nullptr, NTOK};
        gemm_unit8(at, tm * 256, p.XWQ + ((long)l * 512 + tn2 * 256) * DM, DM, lds, [&](const tile_t* T, int mr0) __attribute__((always_inline)) NOPK {
            float v[8][4]; epi_load(T, v);
            norm_rope128(v, p.x_qnorm + l * 128, 0.f, QSCALE, false);
            epi_store_bf16(v, p.QX + (long)(mr0 + (tidx() >> 2)) * 512 + tn * 128);
        }, tn, 2 * tn2);
    }
}
DEVI void ph_xo(const P& p, int l, float* lds) {
    for (int i = 0;; ++i) {
        int tm, tn2, tn; if (!xcd_unit(i, 4, tm, tn2)) break;
        ATile at{p.OX, 512, nullptr, NTOK};
        gemm_unit8(at, tm * 256, p.XWO + ((long)l * DM + tn2 * 256) * 512, 512, lds, [&](const tile_t* T, int mr0) __attribute__((always_inline)) NOPK {
            resid_epi_unit(p.out, p.out, T, mr0, tn);
        }, tn, 2 * tn2, 0, true);
    }
}
DEVI bool moe_unit(const int* cnt, int u, int tilesN, int& e, int& tm, int& tn, int& base) {
    int acc = 0, rb = 0;
    for (int i = 0; i < 16; ++i) { const int tiles = (cnt[i] + 255) >> 8; if (u < acc + tiles * tilesN) { e = i; const int r = u - acc; tm = r / tilesN; tn = r % tilesN; base = rb; return true; } acc += tiles * tilesN; rb += tiles * 256; }
    return false;
}
DEVI void ph_moe_gu(const P& p, int l, float* lds) {
    const int* cnt = p.CNT + l * 16;
    for (int u = BIDX;; u += GDIMX) {
        int e, tm, tn2, tn, base; if (!moe_unit(cnt, u, 2, e, tm, tn2, base)) break;
        const int ce = cnt[e];
        ATile at{p.H, DM, p.LTOK + (long)e * NTOK, ce};
        gemm_unit8(at, tm * 256, p.WGU + (((long)l * 16 + e) * 512 + tn2 * 256) * DM, DM, lds, [&](const tile_t* T, int mr0) __attribute__((always_inline)) NOPK {
            const int row = tidx() >> 2, q = tidx() & 3, r = mr0 + row;
            const float gate = (r < ce) ? p.LGATE[(long)e * NTOK + r] : 0.f;
            bf16_t* op = p.ACT + (long)(base + r) * 256 + tn * 64;
#pragma unroll
            for (int j = 0; j < 4; ++j) { const float4 g = t_ld4(T, row * TLD + 16 * j + 4 * q), uu = t_ld4(T, row * TLD + 64 + 16 * j + 4 * q);
                *(uint2*)(op + 16 * j + 4 * q) = make_uint2(pack2(siluf(g.x) * uu.x * gate, siluf(g.y) * uu.y * gate), pack2(siluf(g.z) * uu.z * gate, siluf(g.w) * uu.w * gate)); }
        }, tn, 2 * tn2);
    }
}
DEVI void ph_moe_dn(const P& p, int l, float* lds) {
    const int* cnt = p.CNT + l * 16;
    for (int u = BIDX;; u += GDIMX) {
        int e, tm, tn2, tn, base; if (!moe_unit(cnt, u, 4, e, tm, tn2, base)) break;
        const int ce = cnt[e];
        ATile at{p.ACT + (long)base * 256, 256, nullptr, ((ce + 255) >> 8) * 256};
        gemm_unit8(at, tm * 256, p.WDN + (((long)l * 16 + e) * DM + tn2 * 256) * 256, 256, lds, [&](const tile_t* T, int mr0) __attribute__((always_inline)) NOPK {
            const int row = tidx() >> 2, q = tidx() & 3, r = mr0 + row;
            if (r < ce) { bf16_t* op = p.Y + (long)p.LSLOT[(long)e * NTOK + r] * DM + tn * 128;
#pragma unroll
                for (int j = 0; j < 8; ++j) { const float4 t = t_ld4(T, row * TLD + 16 * j + 4 * q);
                    *(uint2*)(op + 16 * j + 4 * q) = make_uint2(pack2(t.x, t.y), pack2(t.z, t.w)); } }
        }, tn, 2 * tn2);
    }
}

DEVI void ph_final(const P& p) {
    const long gt = (long)BIDX * NT + tidx(), gs = (long)GDIMX * NT;
    for (long i = gt; i < (long)NTOK * DM / 4; i += gs) {
        const long row = i >> 8; const int c4 = (int)(i & 255);
        float4 v = ((const float4*)p.out)[i];
        const uint2 a = ((const uint2*)(p.Y + (2 * row) * DM))[c4], b = ((const uint2*)(p.Y + (2 * row + 1) * DM))[c4];
        v.x = (v.x + bflo(a.x)) + bflo(b.x); v.y = (v.y + bfhi(a.x)) + bfhi(b.x); v.z = (v.z + bflo(a.y)) + bflo(b.y); v.w = (v.w + bfhi(a.y)) + bfhi(b.y);
        ((float4*)p.out)[i] = v;
    }
}
constexpr int NPH_PRO = 2, NPH_LAYER = 15;
#ifndef PHSEL
#define PHSEL 0xFFFFFFFFu
#endif
template <int PH> DEVI void run_phase(int l, float* lds, int dry = 0) {
    if (PH < 32 && !((PHSEL >> PH) & 1u)) return;
    asm volatile("; PHASE_BEGIN %0" :: "n"(PH));
    P p = make_P(kargs()); p.dry = dry; if (dry && (PH == 8 || PH == 12)) p.out = p.out_dry;
    if (PH == 100) ph_pro_a(p, lds);
    if (PH == 101) ph_pro_b(p, lds);
    if (PH == 0) { if (l == 0) ph_norm<false, false, true>(p, p.norm_mix + l * DM, l); else if (p.dry) ph_norm<false, false>(p, p.norm_mix + l * DM, l); else ph_norm<false, true>(p, p.norm_mix + l * DM, l); }
    if (PH == 16) ph_final(p);
    if (PH == 1) ph_inproj(p, l, lds);
    if (PH == 2) ph_h1(p, l, lds);
    if (PH == 3) ph_h2(p);
    if (PH == 4) ph_h3(p, l, lds);
    if (PH == 5) ph_qproj(p, l, lds);
    if (PH == 6) ph_indexer(p, lds);
    if (PH == 7) ph_dsa_attn(p, l, lds);
    if (PH == 8) ph_outproj(p, l, lds);
    if (PH == 9) ph_norm<false>(p, p.norm_x + l * DM, l);
    if (PH == 10) ph_xq(p, l, lds);
    if (PH == 11) ph_xattn(p, l, lds);
    if (PH == 12) ph_xo(p, l, lds);
    if (PH == 13) ph_norm<true>(p, p.norm_ffn + l * DM, l);
    if (PH == 14) ph_moe_gu(p, l, lds);
    if (PH == 15) ph_moe_dn(p, l, lds);
}

DEVI void grid_sync(float* lds) {
    XcdBarrier b; b.bar = (unsigned*)(kargs()->ws + WS_BAR); b.x = xb_xcc_id(); b.st = (volatile LAS unsigned*)(lds + (LDS_BYTES / 4) - 4);
    xcd_barrier(b);
}
#if MK_LAUNCHES == 0
template <int PH> __global__ void NOPK __launch_bounds__(NT, 2) k_phase(KArgs a, int l) {
    extern __shared__ __attribute__((aligned(16))) float lds[];
    (void)a;
    run_phase<PH>(l, lds);
}
#else

__global__ void NOPK __launch_bounds__(NT, 2) k_mega(KArgs a) {
    extern __shared__ __attribute__((aligned(16))) float lds[];
    (void)a;
    uint4* xbw = (uint4*)(lds + (LDS_BYTES / 4) - 4);
    if (tidx() == 0) *xbw = make_uint4(0u, 0u, 0u, 0u);
    __syncthreads();
    (void)xcd_barrier_post((unsigned*)(kargs()->ws + WS_BAR), (volatile LAS unsigned*)xbw);
    run_phase<100>(0, lds); grid_sync(lds); if (PROBE_MASK & (1u << 16)) { run_phase<100>(0, lds, 0); grid_sync(lds); }
    run_phase<101>(0, lds); if (PROBE_MASK & (1u << 17)) { grid_sync(lds); run_phase<101>(0, lds, 0); }
    for (int l = 0; l < 2; ++l) {
        run_phase<0>(l, lds); grid_sync(lds); if (PROBE_MASK & (1u << 0)) { run_phase<0>(l, lds, 1); grid_sync(lds); }
        run_phase<1>(l, lds); grid_sync(lds); if (PROBE_MASK & (1u << 1)) { run_phase<1>(l, lds, PROBE_DRY6); grid_sync(lds); }
        run_phase<2>(l, lds); grid_sync(lds); if (PROBE_MASK & (1u << 2)) { run_phase<2>(l, lds, 1); grid_sync(lds); }
        run_phase<3>(l, lds); grid_sync(lds); if (PROBE_MASK & (1u << 3)) { run_phase<3>(l, lds, 1); grid_sync(lds); }
        run_phase<4>(l, lds); grid_sync(lds); if (PROBE_MASK & (1u << 4)) { run_phase<4>(l, lds, 1); grid_sync(lds); }
        run_phase<5>(l, lds); grid_sync(lds); if (PROBE_MASK & (1u << 5)) { run_phase<5>(l, lds, 1); grid_sync(lds); }
        run_phase<6>(l, lds); grid_sync(lds); if (PROBE_MASK & (1u << 6)) { run_phase<6>(l, lds, PROBE_DRY6); grid_sync(lds); }
        run_phase<7>(l, lds); grid_sync(lds); if (PROBE_MASK & (1u << 7)) { run_phase<7>(l, lds, 1); grid_sync(lds); }
        run_phase<8>(l, lds); grid_sync(lds); if (PROBE_MASK & (1u << 8)) { run_phase<8>(l, lds, 1); grid_sync(lds); }
        run_phase<9>(l, lds); grid_sync(lds); if (PROBE_MASK & (1u << 9)) { run_phase<9>(l, lds, 1); grid_sync(lds); }
        run_phase<10>(l, lds); grid_sync(lds); if (PROBE_MASK & (1u << 10)) { run_phase<10>(l, lds, 1); grid_sync(lds); }
        run_phase<11>(l, lds); grid_sync(lds); if (PROBE_MASK & (1u << 11)) { run_phase<11>(l, lds, 1); grid_sync(lds); }
        run_phase<12>(l, lds); grid_sync(lds); if (PROBE_MASK & (1u << 12)) { run_phase<12>(l, lds, 1); grid_sync(lds); }
        run_phase<13>(l, lds); grid_sync(lds); if (PROBE_MASK & (1u << 13)) { run_phase<13>(l, lds, 1); grid_sync(lds); }
        run_phase<14>(l, lds); grid_sync(lds); if (PROBE_MASK & (1u << 14)) { run_phase<14>(l, lds, 1); grid_sync(lds); }
        run_phase<15>(l, lds); grid_sync(lds); if (PROBE_MASK & (1u << 15)) { run_phase<15>(l, lds, 1); grid_sync(lds); }
    }
    run_phase<16>(1, lds);
}
#endif

template <int PH> static void launch_phase(const KArgs& p, int l, hipStream_t stream);

extern "C" void kernel_launch(void* const* d_in, const int* in_sizes, int n_in, void* d_out, int out_size, void* d_ws, size_t ws_size, hipStream_t stream) {
    (void)in_sizes; (void)out_size;
    if (n_in != 29) { fprintf(stderr, "kernel_launch: expected 29 inputs, got %d\n", n_in); return; }
    KArgs p; memset(&p, 0, sizeof(p));
    for (int i = 0; i < 29; ++i) p.in[i] = d_in[i];
    p.out = (float*)d_out; p.ws = (char*)d_ws;
    if (WS_END > ws_size) { fprintf(stderr, "kernel_launch: workspace too small: need %zu, have %zu\n", (size_t)WS_END, ws_size); return; }
    (void)hipMemsetAsync((char*)d_ws + WS_BAR, 0, XCD_BAR_WORDS * 4, stream);
#if MK_LAUNCHES == 0
    launch_phase<100>(p, 0, stream); launch_phase<101>(p, 0, stream);
    for (int l = 0; l < 2; ++l) {
        launch_phase<0>(p, l, stream); launch_phase<1>(p, l, stream); launch_phase<2>(p, l, stream); launch_phase<3>(p, l, stream);
        launch_phase<4>(p, l, stream); launch_phase<5>(p, l, stream); launch_phase<6>(p, l, stream); launch_phase<7>(p, l, stream);
        launch_phase<8>(p, l, stream); launch_phase<9>(p, l, stream); launch_phase<10>(p, l, stream); launch_phase<11>(p, l, stream);
        launch_phase<12>(p, l, stream); launch_phase<13>(p, l, stream); launch_phase<14>(p, l, stream); launch_phase<15>(p, l, stream);
    }
    launch_phase<16>(p, 1, stream);
#else
    static int grid = 0;
    if (grid == 0) {
        int dev = 0, cus = 0;
        if (hipGetDevice(&dev) != hipSuccess || hipDeviceGetAttribute(&cus, hipDeviceAttributeMultiprocessorCount, dev) != hipSuccess) { fprintf(stderr, "kernel_launch: device query failed\n"); grid = -1; return; }
        if (hipFuncSetAttribute((const void*)k_mega, hipFuncAttributeMaxDynamicSharedMemorySize, LDS_BYTES) != hipSuccess) { fprintf(stderr, "kernel_launch: hipFuncSetAttribute failed\n"); grid = -1; return; }
        int per_cu = 0;
        if (hipOccupancyMaxActiveBlocksPerMultiprocessor(&per_cu, (const void*)k_mega, NT, LDS_BYTES) != hipSuccess || per_cu < 1) { fprintf(stderr, "kernel_launch: occupancy query says %d blocks per CU\n", per_cu); (void)hipGetLastError(); }
        grid = cus;
    }
    if (grid < 0) return;
    hipLaunchKernelGGL(k_mega, dim3(grid), dim3(NT), LDS_BYTES, stream, p);
#endif
}
#if MK_LAUNCHES == 0
template <int PH> static void launch_phase(const KArgs& p, int l, hipStream_t stream) {
    static bool once = false;
    if (!once) { (void)hipFuncSetAttribute((const void*)k_phase<PH>, hipFuncAttributeMaxDynamicSharedMemorySize, LDS_BYTES); once = true; }
    hipLaunchKernelGGL(k_phase<PH>, dim3(256), dim3(NT), LDS_BYTES, stream, p, l);
}
#endif
#if defined(__HIP_DEVICE_COMPILE__)
#pragma clang attribute pop
#endif
```
